# Optimizing an MI355X kernel written in HIP

```python
import jax, jax.numpy as jnp
from jax import lax
import numpy as np

D_MODEL = 1024
BATCH = 2
SEQ = 8192
DEPTH = 2

CONV_W = D_MODEL // 2
CONV_K = 31
CONV_LN_EPS = 1e-5
RWKV_HEAD_DIM = 64
RWKV_HEADS = (D_MODEL // 2) // RWKV_HEAD_DIM
RWKV_W = RWKV_HEADS * RWKV_HEAD_DIM
LORA_DECAY = 64
LORA_ICLR = 64
LORA_GATE = 128
RWKV_GN_EPS = RWKV_HEAD_DIM * 1e-5
RWKV_IN = 3 * RWKV_W + LORA_DECAY + LORA_ICLR + LORA_GATE
RWKV_SPLITS = (RWKV_W, 2 * RWKV_W, 3 * RWKV_W, 3 * RWKV_W + LORA_DECAY, 3 * RWKV_W + LORA_DECAY + LORA_ICLR)
AB_IN = 2 * CONV_W + RWKV_IN
AB_OUT = CONV_W + RWKV_W
HEAD_DIM = 64
N_HEADS = D_MODEL // HEAD_DIM
N_KV_HEADS = 4
GROUP = N_HEADS // N_KV_HEADS
WINDOW = 128
BLOCK = 128
ROT_DIM = HEAD_DIM // 4
ROPE_THETA = 500000.0
QKV_W = (N_HEADS + 2 * N_KV_HEADS) * HEAD_DIM
D_FF = 2816
FFN_CONV_K = 3
NORM_EPS = 1e-6
N_EVEN = (DEPTH + 1) // 2
N_ODD = DEPTH // 2

kernel_name = 'hybrid_conformer_rwkv7_swa_sink_convffn'


def rms_norm(x, g):
    xf = x.astype(jnp.float32)
    y = xf * lax.rsqrt(jnp.mean(xf * xf, axis=-1, keepdims=True) + NORM_EPS)
    return (y * g.astype(jnp.float32)).astype(x.dtype)


def layer_norm(x, g, b, eps):
    xf = x.astype(jnp.float32)
    mu = jnp.mean(xf, axis=-1, keepdims=True)
    xc = xf - mu
    var = jnp.mean(xc * xc, axis=-1, keepdims=True)
    return (xc * lax.rsqrt(var + eps) * g.astype(jnp.float32) + b.astype(jnp.float32)).astype(x.dtype)


def causal_dwconv(x, w, b):
    k = w.shape[0]
    y = lax.conv_general_dilated(x, w[:, None, :].astype(x.dtype), window_strides=(1,),
                                 padding=[(k - 1, 0)], dimension_numbers=('NWC', 'WIO', 'NWC'),
                                 feature_group_count=x.shape[-1])
    return y + b


def token_shift(p):
    return jnp.pad(p, ((0, 0), (1, 0), (0, 0)))[:, :-1]


def partial_rope(x, positions):
    half = ROT_DIM // 2
    inv_freq = ROPE_THETA ** (-(jnp.arange(half, dtype=jnp.float32) * 2.0) / ROT_DIM)
    ang = positions.astype(jnp.float32)[..., None] * inv_freq
    cos = jnp.cos(ang)[:, :, None, :]
    sin = jnp.sin(ang)[:, :, None, :]
    xf = x.astype(jnp.float32)
    x1 = xf[..., :half]
    x2 = xf[..., half:ROT_DIM]
    out = jnp.concatenate([x1 * cos - x2 * sin, x2 * cos + x1 * sin, xf[..., ROT_DIM:]], axis=-1)
    return out.astype(x.dtype)


def rwkv7_recurrence(r, w, k, v, a, b):
    bsz, _, h, n = r.shape

    def step(s, inp):
        r_t, w_t, k_t, v_t, a_t, b_t = inp
        sa = jnp.einsum('bhij,bhj->bhi', s, a_t)
        s = s * w_t[:, :, None, :] + sa[..., None] * b_t[:, :, None, :] + v_t[..., None] * k_t[:, :, None, :]
        return s, jnp.einsum('bhij,bhj->bhi', s, r_t)

    xs = tuple(jnp.moveaxis(t, 1, 0) for t in (r, w, k, v, a, b))
    s0 = jnp.zeros((bsz, h, n, n), jnp.float32)
    _, ys = lax.scan(step, s0, xs)
    return jnp.moveaxis(ys, 0, 1)


def conv_rwkv_mixer(x, norm_g, w_in, conv_in_b, conv_dw_w, conv_dw_b, conv_ln_g, conv_ln_b,
                    rwkv_mu, rwkv_w0, rwkv_w2, rwkv_a0, rwkv_a2, rwkv_g2, rwkv_k_k, rwkv_k_a,
                    rwkv_r_k, rwkv_ln_g, rwkv_ln_b, w_out):
    bsz, t, _ = x.shape
    f32 = jnp.float32
    h = rms_norm(x, norm_g)
    p = h @ w_in
    c = p[..., :2 * CONV_W] + conv_in_b
    c = c[..., :CONV_W] * jax.nn.sigmoid(c[..., CONV_W:])
    c = causal_dwconv(c, conv_dw_w, conv_dw_b)
    c = jax.nn.silu(layer_norm(c, conv_ln_g, conv_ln_b, CONV_LN_EPS))
    rw = p[..., 2 * CONV_W:]
    rw = (rw + (token_shift(rw) - rw) * rwkv_mu).astype(f32)
    r, k, v, wd, ad, gd = jnp.split(rw, RWKV_SPLITS, axis=-1)
    w = -jax.nn.softplus(-(rwkv_w0 + jnp.tanh(wd) @ rwkv_w2)) - 0.5
    decay = jnp.exp(-jnp.exp(w))
    a = jax.nn.sigmoid(rwkv_a0 + ad @ rwkv_a2)
    gate = jax.nn.sigmoid(gd) @ rwkv_g2
    hs = lambda z: z.reshape(bsz, t, RWKV_HEADS, RWKV_HEAD_DIM)
    kk = hs(k * rwkv_k_k)
    kk = kk / jnp.maximum(jnp.sqrt(jnp.sum(kk * kk, axis=-1, keepdims=True)), 1e-12)
    k = k * (1.0 + (a - 1.0) * rwkv_k_a)
    rh, kh, vh = hs(r), hs(k), hs(v)
    y = rwkv7_recurrence(rh, hs(decay), kh, vh, -kk, kk * hs(a))
    mu = jnp.mean(y, axis=-1, keepdims=True)
    yc = y - mu
    y = yc * lax.rsqrt(jnp.mean(yc * yc, axis=-1, keepdims=True) + RWKV_GN_EPS)
    ln_g = rwkv_ln_g.astype(f32).reshape(RWKV_HEADS, RWKV_HEAD_DIM)
    ln_b = rwkv_ln_b.astype(f32).reshape(RWKV_HEADS, RWKV_HEAD_DIM)
    y = y * ln_g + ln_b
    y = y + jnp.sum(rh * kh * rwkv_r_k, axis=-1, keepdims=True) * vh
    y = y.reshape(bsz, t, RWKV_W) * gate
    return jnp.concatenate([c, y.astype(c.dtype)], axis=-1) @ w_out


def sliding_window_sink_attention(x, positions, norm_g, w_qkv, b_qkv, q_norm_g, k_norm_g, sinks, w_o, b_o):
    bsz, t, _ = x.shape
    nb = t // BLOCK
    h = rms_norm(x, norm_g)
    qkv = h @ w_qkv + b_qkv
    qd, kd = N_HEADS * HEAD_DIM, N_KV_HEADS * HEAD_DIM
    q = qkv[..., :qd].reshape(bsz, t, N_HEADS, HEAD_DIM)
    k = qkv[..., qd:qd + kd].reshape(bsz, t, N_KV_HEADS, HEAD_DIM)
    v = qkv[..., qd + kd:].reshape(bsz, t, N_KV_HEADS, HEAD_DIM)
    q = partial_rope(rms_norm(q, q_norm_g), positions)
    k = partial_rope(rms_norm(k, k_norm_g), positions)
    q = q.reshape(bsz, nb, BLOCK, N_KV_HEADS, GROUP, HEAD_DIM)

    def with_prev(z):
        zb = z.reshape(bsz, nb, BLOCK, N_KV_HEADS, HEAD_DIM)
        prev = jnp.pad(zb, ((0, 0), (1, 0), (0, 0), (0, 0), (0, 0)))[:, :-1]
        return jnp.concatenate([prev, zb], axis=2)

    kc, vc = with_prev(k), with_prev(v)
    s = jnp.einsum('bnqhgd,bnkhd->bnhgqk', q, kc).astype(jnp.float32) * (HEAD_DIM ** -0.5)
    qi = jnp.arange(BLOCK)[:, None]
    kj = jnp.arange(2 * BLOCK)[None, :]
    rel = qi + BLOCK - kj
    band = (rel >= 0) & (rel < WINDOW)
    kpos = jnp.arange(nb)[:, None, None] * BLOCK - BLOCK + kj[None]
    valid = band[None] & (kpos >= 0)
    s = jnp.where(valid[None, :, None, None], s, -jnp.inf)
    sink = sinks.astype(jnp.float32).reshape(N_KV_HEADS, GROUP)[None, None, :, :, None, None]
    m = jnp.maximum(jnp.max(s, axis=-1, keepdims=True), sink)
    pr = jnp.exp(s - m)
    pr = pr / (jnp.sum(pr, axis=-1, keepdims=True) + jnp.exp(sink - m))
    o = jnp.einsum('bnhgqk,bnkhd->bnqhgd', pr.astype(vc.dtype), vc)
    return o.reshape(bsz, t, N_HEADS * HEAD_DIM) @ w_o + b_o


def conv_glu_ffn(x, norm_g, w_up, conv_w, conv_b, w_down):
    h = rms_norm(x, norm_g)
    u = h @ w_up
    gate = causal_dwconv(u[..., :D_FF], conv_w, conv_b)
    return (jax.nn.silu(gate) * u[..., D_FF:]) @ w_down


def setup_inputs(seed: int = 0) -> dict:
    key = jax.random.key(seed)
    ks = iter(jax.random.split(key, 40))
    f32 = jnp.float32

    def nrm(shape, scale):
        return scale * jax.random.normal(next(ks), shape, f32)

    def gain(shape):
        return 1.0 + nrm(shape, 0.02)

    e, o, l = N_EVEN, N_ODD, DEPTH
    return {
        'x': jax.random.normal(next(ks), (BATCH, SEQ, D_MODEL), f32),
        'positions': jnp.broadcast_to(jnp.arange(SEQ, dtype=jnp.int32), (BATCH, SEQ)),
        'ab_norm_g': gain((e, D_MODEL)),
        'ab_w_in': nrm((e, D_MODEL, AB_IN), D_MODEL ** -0.5),
        'conv_in_b': nrm((e, 2 * CONV_W), 0.02),
        'conv_dw_w': nrm((e, CONV_K, CONV_W), CONV_K ** -0.5),
        'conv_dw_b': nrm((e, CONV_W), 0.02),
        'conv_ln_g': gain((e, CONV_W)),
        'conv_ln_b': nrm((e, CONV_W), 0.02),
        'rwkv_mu': jax.random.uniform(next(ks), (e, RWKV_IN), f32),
        'rwkv_w0': jax.random.uniform(next(ks), (e, RWKV_W), f32, -6.0, -1.0),
        'rwkv_w2': nrm((e, LORA_DECAY, RWKV_W), 0.1 * LORA_DECAY ** -0.5),
        'rwkv_a0': nrm((e, RWKV_W), 0.1),
        'rwkv_a2': nrm((e, LORA_ICLR, RWKV_W), 0.3 * LORA_ICLR ** -0.5),
        'rwkv_g2': nrm((e, LORA_GATE, RWKV_W), LORA_GATE ** -0.5),
        'rwkv_k_k': 0.85 + nrm((e, RWKV_W), 0.1),
        'rwkv_k_a': 1.0 + nrm((e, RWKV_W), 0.1),
        'rwkv_r_k': nrm((e, RWKV_HEADS, RWKV_HEAD_DIM), 0.1),
        'rwkv_ln_g': gain((e, RWKV_W)),
        'rwkv_ln_b': nrm((e, RWKV_W), 0.02),
        'ab_w_out': nrm((e, AB_OUT, D_MODEL), 0.5 * AB_OUT ** -0.5),
        'attn_norm_g': gain((o, D_MODEL)),
        'attn_w_qkv': nrm((o, D_MODEL, QKV_W), D_MODEL ** -0.5),
        'attn_b_qkv': nrm((o, QKV_W), 0.02),
        'attn_q_norm_g': gain((o, HEAD_DIM)),
        'attn_k_norm_g': gain((o, HEAD_DIM)),
        'attn_sinks': nrm((o, N_HEADS), 0.5),
        'attn_w_o': nrm((o, N_HEADS * HEAD_DIM, D_MODEL), 0.5 * (N_HEADS * HEAD_DIM) ** -0.5),
        'attn_b_o': nrm((o, D_MODEL), 0.02),
        'ffn_norm_g': gain((l, D_MODEL)),
        'ffn_w_up': nrm((l, D_MODEL, 2 * D_FF), D_MODEL ** -0.5),
        'ffn_conv_w': nrm((l, FFN_CONV_K, D_FF), FFN_CONV_K ** -0.5),
        'ffn_conv_b': nrm((l, D_FF), 0.02),
        'ffn_w_down': nrm((l, D_FF, D_MODEL), 0.5 * D_FF ** -0.5),
    }


def reference(x, positions, ab_norm_g, ab_w_in, conv_in_b, conv_dw_w, conv_dw_b, conv_ln_g, conv_ln_b,
              rwkv_mu, rwkv_w0, rwkv_w2, rwkv_a0, rwkv_a2, rwkv_g2, rwkv_k_k, rwkv_k_a, rwkv_r_k,
              rwkv_ln_g, rwkv_ln_b, ab_w_out, attn_norm_g, attn_w_qkv, attn_b_qkv, attn_q_norm_g,
              attn_k_norm_g, attn_sinks, attn_w_o, attn_b_o, ffn_norm_g, ffn_w_up, ffn_conv_w,
              ffn_conv_b, ffn_w_down):
    for layer in range(DEPTH):
        i = layer // 2
        if layer % 2 == 0:
            mix = conv_rwkv_mixer(x, ab_norm_g[i], ab_w_in[i], conv_in_b[i], conv_dw_w[i], conv_dw_b[i],
                                  conv_ln_g[i], conv_ln_b[i], rwkv_mu[i], rwkv_w0[i], rwkv_w2[i],
                                  rwkv_a0[i], rwkv_a2[i], rwkv_g2[i], rwkv_k_k[i], rwkv_k_a[i],
                                  rwkv_r_k[i], rwkv_ln_g[i], rwkv_ln_b[i], ab_w_out[i])
        else:
            mix = sliding_window_sink_attention(x, positions, attn_norm_g[i], attn_w_qkv[i], attn_b_qkv[i],
                                                attn_q_norm_g[i], attn_k_norm_g[i], attn_sinks[i],
                                                attn_w_o[i], attn_b_o[i])
        x = x + mix.astype(x.dtype)
        x = x + conv_glu_ffn(x, ffn_norm_g[layer], ffn_w_up[layer], ffn_conv_w[layer],
                             ffn_conv_b[layer], ffn_w_down[layer]).astype(x.dtype)
    return x
```

```cpp
#include <hip/hip_runtime.h>
#include <hip/hip_cooperative_groups.h>
#include <cstdio>
#include <cstdint>
namespace cg = cooperative_groups;
namespace pg8 {
#define PG8_LAS __attribute__((address_space(3)))
typedef unsigned short bf16_t;
typedef short bf16x8 __attribute__((ext_vector_type(8)));
typedef float f32x4 __attribute__((ext_vector_type(4)));
typedef unsigned u32x4 __attribute__((ext_vector_type(4)));
constexpr int BM = 256, BK = 64, HALF = 128, HTB = HALF * BK * 2  , STAGE_BYTES = 8 * HTB, NXCD = 8, WGM = 8;

__host__ __device__ __forceinline__ int lds_byte(int r, int c) { const int st = (r >> 4) * 2 + (c >> 5), rr = r & 15, cc = c & 31, ob = rr * 64 + cc * 2; return st * 1024 + (ob ^ (((ob >> 9) & 1) << 5)); }
__host__ __device__ __forceinline__ void stage_rc(int b, int& R, int& C) { const int st = b / 1024, sb = b % 1024, swz = sb ^ (((sb >> 9) & 1) << 5); R = (st >> 1) * 16 + swz / 64; C = (st & 1) * 32 + (swz % 64) / 2; }
__host__ __device__ __forceinline__ int perm32(int rho) { const int n = rho >> 4, i = rho & 15; return 8 * (i >> 2) + 4 * n + (i & 3); }

struct Unit { int pm, pn; };
struct Gemm { const bf16_t* A; const bf16_t* Bt; int M, N, K, lda; };

struct StaticOrder {
    int nM, nN, nwg, G, c;
    __host__ __device__ void init(int M, int N, int G_, int c_) { nM = M / BM; nN = N / BM; nwg = nM * nN; G = G_; c = c_; }
    __host__ __device__ bool next(int i, Unit& u) const {
        const long L = (long)i * G + c; if (L >= nwg) return false;
        int wgid = (int)L; { const int q = nwg / NXCD, r = nwg % NXCD, xcd = wgid % NXCD, off = wgid / NXCD; wgid = (xcd < r ? xcd * (q + 1) : r * (q + 1) + (xcd - r) * q) + off; }
        const int nig = WGM * nN, gid = wgid / nig, fm = gid * WGM, gsz = (nM - fm) < WGM ? (nM - fm) : WGM;
        u.pm = fm + ((wgid % nig) % gsz); u.pn = (wgid % nig) / gsz; return true;
    }
    __device__ __forceinline__ void a_ready(const Unit&) const {}
    __device__ __forceinline__ void done(const Unit&) const {}
};

__device__ __forceinline__ unsigned cvt_pk_bf16(float lo, float hi) { unsigned r; asm volatile("v_cvt_pk_bf16_f32 %0, %1, %2" : "=v"(r) : "v"(lo), "v"(hi)); return r; }
typedef float f32x2 __attribute__((ext_vector_type(2)));

template <class Epi, class Sched, bool ALIGN_EPI = false, bool SP2 = false>
__device__ __forceinline__ void gemm_phase(PG8_LAS unsigned char* lds, const Gemm g, const Sched& S, const Epi& E) {
    const int tid = threadIdx.x, wid = __builtin_amdgcn_readfirstlane(tid >> 6), lane = tid & 63, wr = wid >> 2, wc = wid & 3, fr = lane & 15, fq = lane >> 4;
    const int K = g.K, nt = K / BK;
    unsigned voffA[2], voffB[2];
#pragma unroll
    for (int i = 0; i < 2; ++i) { int R, C; stage_rc(tid * 16 + i * 8192, R, C); const int Rb = Epi::PERM ? ((R & ~31) + perm32(R & 31)) : R;
        voffA[i] = (unsigned)(R * g.lda + C) * 2u; voffB[i] = (unsigned)(Rb * K + C) * 2u; }
    const size_t kstep = (size_t)(BK * 2);
    const size_t hstep = (size_t)HALF * K * 2;
    const size_t tstep = 2 * hstep; const size_t hstepA = (size_t)HALF * g.lda * 2, tstepA = 2 * hstepA;
    const unsigned ldsw = (unsigned)wid * 1024u;
    const int aoff = lds_byte(wr * 64 + fr, fq * 8), boff = lds_byte(wc * 32 + fr, fq * 8);
#define PG8_SA(b, h) (((b) * 2 + (h)) * HTB)
#define PG8_SB(b, h) ((4 + (b) * 2 + (h)) * HTB)
#define PG8_STAGE(bufoff, gbase, voff) do { _Pragma("unroll") for (int _i = 0; _i < 2; ++_i) \
        __builtin_amdgcn_global_load_lds((const unsigned*)((const char*)(gbase) + (voff)[_i]), (PG8_LAS unsigned*)(lds + (bufoff) + ldsw + _i * 8192), 16, 0, 0); } while (0)
#define PG8_LDA(dst, b, h) do { _Pragma("unroll") for (int m = 0; m < 4; ++m) _Pragma("unroll") for (int k = 0; k < 2; ++k) dst[m][k] = *(const PG8_LAS bf16x8*)(lds + PG8_SA(b, h) + aoff + m * 2048 + k * 1024); } while (0)
#define PG8_LDB(dst, b, h) do { _Pragma("unroll") for (int n = 0; n < 2; ++n) _Pragma("unroll") for (int k = 0; k < 2; ++k) dst[n][k] = *(const PG8_LAS bf16x8*)(lds + PG8_SB(b, h) + boff + n * 2048 + k * 1024); } while (0)
#define PG8_MMA(ai, bj, At, Bt) do { __builtin_amdgcn_s_setprio(1); _Pragma("unroll") for (int m = 0; m < 4; ++m) _Pragma("unroll") for (int n = 0; n < 2; ++n) _Pragma("unroll") for (int k = 0; k < 2; ++k) \
        acc[ai][bj][m][n] = __builtin_amdgcn_mfma_f32_16x16x32_bf16(Bt[n][k], At[m][k], acc[ai][bj][m][n], 0, 0, 0); __builtin_amdgcn_s_setprio(0); } while (0)
#define PG8_WAIT_V(n) asm volatile("s_waitcnt vmcnt(" #n ")" ::: "memory")
#define PG8_WAIT_L(n) asm volatile("s_waitcnt lgkmcnt(" #n ")" ::: "memory")
#define PG8_BAR __builtin_amdgcn_s_barrier()
#define PG8_SCHED __builtin_amdgcn_sched_barrier(0)
    Unit cur, nxt; int ui = 0;
    if (!S.next(0, cur)) return;
    f32x4 acc[2][2][4][2];
#pragma unroll
    for (int a = 0; a < 2; ++a)
#pragma unroll
        for (int b = 0; b < 2; ++b)
#pragma unroll
            for (int m = 0; m < 4; ++m)
#pragma unroll
                for (int n = 0; n < 2; ++n) acc[a][b][m][n] = (f32x4){0.f, 0.f, 0.f, 0.f};
    bf16x8 At[4][2], B0[2][2], B1[2][2];
    const char* cA = (const char*)g.A + (size_t)cur.pm * tstepA; const char* cB = (const char*)g.Bt + (size_t)cur.pn * tstep;
    S.a_ready(cur);
    if constexpr (SP2) {
        PG8_STAGE(PG8_SB(0, 0), cB, voffB); PG8_STAGE(PG8_SB(0, 1), cB + hstep, voffB); PG8_STAGE(PG8_SA(0, 0), cA, voffA); PG8_STAGE(PG8_SA(0, 1), cA + hstepA, voffA);
        if (wr == 1) PG8_BAR;
        PG8_WAIT_V(2); PG8_BAR;
        PG8_STAGE(PG8_SB(1, 0), cB + kstep, voffB); PG8_STAGE(PG8_SA(1, 0), cA + kstep, voffA); PG8_STAGE(PG8_SB(1, 1), cB + hstep + kstep, voffB);
        PG8_WAIT_V(6); PG8_BAR;
    } else {
        PG8_STAGE(PG8_SB(0, 0), cB, voffB); PG8_STAGE(PG8_SA(0, 0), cA, voffA); PG8_STAGE(PG8_SB(0, 1), cB + hstep, voffB); PG8_STAGE(PG8_SA(0, 1), cA + hstepA, voffA);
        if (wr == 1) PG8_BAR;
        PG8_WAIT_V(4); PG8_BAR;
        PG8_STAGE(PG8_SB(1, 0), cB + kstep, voffB); PG8_STAGE(PG8_SA(1, 0), cA + kstep, voffA); PG8_STAGE(PG8_SB(1, 1), cB + hstep + kstep, voffB);
        PG8_WAIT_V(6); PG8_BAR;
    }
    for (;;) {
        const bool has_next = S.next(ui + 1, nxt);
        const char* nA = has_next ? (const char*)g.A + (size_t)nxt.pm * tstepA : cA; const char* nB = has_next ? (const char*)g.Bt + (size_t)nxt.pn * tstep : cB;
        for (int t = 0; t < nt; t += 2) {
            const bool last = (t == nt - 2);
            const char* a1 = cA + (size_t)(t + 1) * kstep;
            const char* a2 = last ? nA : cA + (size_t)(t + 2) * kstep; const char* b2 = last ? nB : cB + (size_t)(t + 2) * kstep;
            const char* a3 = a2 + kstep; const char* b3 = b2 + kstep;
            if (last && has_next) S.a_ready(nxt);
            if constexpr (SP2) {
            PG8_LDB(B0, 0, 0); PG8_LDB(B1, 0, 1); PG8_SCHED; PG8_LDA(At, 0, 0); PG8_STAGE(PG8_SA(1, 1), a1 + hstepA, voffA);
            PG8_WAIT_V(8); PG8_WAIT_L(0); PG8_BAR; PG8_MMA(0, 0, At, B0); PG8_MMA(0, 1, At, B1); PG8_BAR; PG8_SCHED;
            PG8_LDA(At, 0, 1); PG8_STAGE(PG8_SB(0, 0), b2, voffB); PG8_STAGE(PG8_SB(0, 1), b2 + hstep, voffB); PG8_STAGE(PG8_SA(0, 0), a2, voffA);
            PG8_WAIT_V(8); PG8_WAIT_L(0); PG8_BAR; PG8_MMA(1, 0, At, B0); PG8_MMA(1, 1, At, B1); PG8_BAR; PG8_SCHED;
            PG8_LDB(B0, 1, 0); PG8_LDB(B1, 1, 1); PG8_SCHED; PG8_LDA(At, 1, 0); PG8_STAGE(PG8_SA(0, 1), a2 + hstepA, voffA);
            PG8_WAIT_V(8); PG8_WAIT_L(0); PG8_BAR; PG8_MMA(0, 0, At, B0); PG8_MMA(0, 1, At, B1); PG8_BAR; PG8_SCHED;
            PG8_LDA(At, 1, 1); PG8_STAGE(PG8_SB(1, 0), b3, voffB); PG8_STAGE(PG8_SB(1, 1), b3 + hstep, voffB); PG8_STAGE(PG8_SA(1, 0), a3, voffA);
            PG8_WAIT_V(8); PG8_WAIT_L(0); PG8_BAR; PG8_MMA(1, 0, At, B0); PG8_MMA(1, 1, At, B1); PG8_BAR; PG8_SCHED;
            } else {
            PG8_LDB(B0, 0, 0); PG8_SCHED; PG8_LDA(At, 0, 0); PG8_STAGE(PG8_SA(1, 1), a1 + hstepA, voffA);
            PG8_WAIT_L(8); PG8_BAR; PG8_WAIT_L(0); PG8_MMA(0, 0, At, B0); PG8_BAR; PG8_SCHED;
            PG8_LDB(B1, 0, 1); PG8_STAGE(PG8_SB(0, 0), b2, voffB);
            PG8_BAR; PG8_WAIT_L(0); PG8_MMA(0, 1, At, B1); PG8_BAR;
            PG8_LDA(At, 0, 1); PG8_STAGE(PG8_SA(0, 0), a2, voffA);
            PG8_BAR; PG8_WAIT_L(0); PG8_MMA(1, 0, At, B0); PG8_BAR; PG8_SCHED;
            PG8_STAGE(PG8_SB(0, 1), b2 + hstep, voffB);
            PG8_WAIT_V(6); PG8_BAR; PG8_MMA(1, 1, At, B1); PG8_BAR;
            PG8_LDB(B0, 1, 0); PG8_SCHED; PG8_LDA(At, 1, 0); PG8_STAGE(PG8_SA(0, 1), a2 + hstepA, voffA);
            PG8_WAIT_L(8); PG8_BAR; PG8_WAIT_L(0); PG8_MMA(0, 0, At, B0); PG8_BAR; PG8_SCHED;
            PG8_LDB(B1, 1, 1); PG8_STAGE(PG8_SB(1, 0), b3, voffB);
            PG8_BAR; PG8_WAIT_L(0); PG8_MMA(0, 1, At, B1); PG8_BAR;
            PG8_LDA(At, 1, 1); PG8_STAGE(PG8_SA(1, 0), a3, voffA);
            PG8_BAR; PG8_WAIT_L(0); PG8_MMA(1, 0, At, B0); PG8_BAR; PG8_SCHED;
            PG8_STAGE(PG8_SB(1, 1), b3 + hstep, voffB);
            PG8_WAIT_V(6); PG8_BAR; PG8_MMA(1, 1, At, B1); PG8_BAR;
            }
        }
        if constexpr (ALIGN_EPI) { if (wr == 0) PG8_BAR; }
        if constexpr (!Epi::AFTER_DRAIN) { E(acc, cur, wr, wc, fr, fq); S.done(cur); }
        if (!has_next) break;
#pragma unroll
        for (int a = 0; a < 2; ++a)
#pragma unroll
            for (int b = 0; b < 2; ++b)
#pragma unroll
                for (int m = 0; m < 4; ++m)
#pragma unroll
                    for (int n = 0; n < 2; ++n) acc[a][b][m][n] = (f32x4){0.f, 0.f, 0.f, 0.f};
        cur = nxt; cA = nA; cB = nB; ++ui;
        if constexpr (ALIGN_EPI) { if (wr == 1) PG8_BAR; }
    }
    PG8_WAIT_V(0);
    if constexpr (!ALIGN_EPI) { if (wr == 0) PG8_BAR; }
    PG8_BAR;
    if constexpr (Epi::AFTER_DRAIN) { E.fused(acc, cur, wr, wc, fr, fq, lds, wid, lane); S.done(cur); }
#undef PG8_SA
#undef PG8_SB
#undef PG8_STAGE
#undef PG8_LDA
#undef PG8_LDB
#undef PG8_MMA
#undef PG8_WAIT_V
#undef PG8_WAIT_L
#undef PG8_BAR
#undef PG8_SCHED
}
}

namespace pg8 {
struct EpiBf16X {
    static constexpr bool PERM = true, AFTER_DRAIN = false;
    bf16_t* O0; int ld0; bf16_t* O1; int ld1; int split; const float* bias; int segw; size_t segstride; const float* ss;
    __device__ __forceinline__ void operator()(const f32x4 (&acc)[2][2][4][2], const Unit& u, int wr, int wc, int fr, int fq) const {
        const int row0 = u.pm * BM + wr * 64 + fr; const int colt = u.pn * BM;
        bf16_t* base; int ldc, cb;
        if (colt < split) { base = O0; ldc = ld0; cb = colt; } else { const int rel = colt - split, sg = rel / segw; base = O1 + (size_t)sg * segstride; ldc = ld1; cb = rel - sg * segw; }
        const int col0 = cb + wc * 32 + 8 * fq, bcol0 = colt + wc * 32 + 8 * fq;
        f32x4 bv[2][2];
#pragma unroll
        for (int bj = 0; bj < 2; ++bj)
#pragma unroll
            for (int n = 0; n < 2; ++n) bv[bj][n] = bias ? *(const f32x4*)(bias + bcol0 + bj * HALF + 4 * n) : (f32x4){0.f, 0.f, 0.f, 0.f};
#pragma unroll
        for (int ai = 0; ai < 2; ++ai)
#pragma unroll
            for (int m = 0; m < 4; ++m) { bf16_t* rowp = base + (size_t)(row0 + ai * HALF + m * 16) * ldc + col0;
                const float rs = ss ? __builtin_amdgcn_rsqf(ss[row0 + ai * HALF + m * 16] * (1.f / 1024.f) + 1e-6f) : 1.f;
#pragma unroll
                for (int bj = 0; bj < 2; ++bj) { const f32x4 v0 = acc[ai][bj][m][0] * rs + bv[bj][0], v1 = acc[ai][bj][m][1] * rs + bv[bj][1];
                    u32x4 w; w.x = cvt_pk_bf16(v0[0], v0[1]); w.y = cvt_pk_bf16(v0[2], v0[3]); w.z = cvt_pk_bf16(v1[0], v1[1]); w.w = cvt_pk_bf16(v1[2], v1[3]);
                    *(u32x4*)(rowp + bj * HALF) = w; } }
    }
};
struct EpiRes {
    static constexpr bool PERM = false, AFTER_DRAIN = false;
    const float* base; float* out; int ldc; const float* bias; bf16_t* xb; float* ss;
    __device__ __forceinline__ void operator()(const f32x4 (&acc)[2][2][4][2], const Unit& u, int wr, int wc, int fr, int fq) const {
        const int col0 = u.pn * BM + wc * 32 + 4 * fq;
        f32x4 bv[2][2];
#pragma unroll
        for (int bj = 0; bj < 2; ++bj)
#pragma unroll
            for (int n = 0; n < 2; ++n) bv[bj][n] = bias ? *(const f32x4*)(bias + col0 + bj * HALF + n * 16) : (f32x4){0.f, 0.f, 0.f, 0.f};
#pragma unroll
        for (int ai = 0; ai < 2; ++ai)
#pragma unroll
            for (int m = 0; m < 4; ++m) { const int row = u.pm * BM + ai * HALF + wr * 64 + m * 16 + fr; const size_t off = (size_t)row * ldc + col0; float sq = 0.f;
#pragma unroll
                for (int bj = 0; bj < 2; ++bj)
#pragma unroll
                    for (int n = 0; n < 2; ++n) { const size_t o = off + bj * HALF + n * 16; const f32x4 bs = *(const f32x4*)(base + o);
                        const f32x4 v = bs + acc[ai][bj][m][n] + bv[bj][n]; *(f32x4*)(out + o) = v;
                        if (xb) { sq += (v[0] * v[0] + v[1] * v[1]) + (v[2] * v[2] + v[3] * v[3]);
                            typedef unsigned u32x2_ __attribute__((ext_vector_type(2))); u32x2_ w; w.x = cvt_pk_bf16(v[0], v[1]); w.y = cvt_pk_bf16(v[2], v[3]); *(u32x2_*)(xb + o) = w; } }
                if (xb) { sq += __shfl_xor(sq, 16); sq += __shfl_xor(sq, 32); if (fq == 0) atomicAdd(ss + row, sq); } }
    }
};
struct EpiGlu {
    static constexpr bool PERM = true, AFTER_DRAIN = false;
    bf16_t* H; const float* cw; const float* cb; float* HG; float* HV; float* TG; const float* ss;
    __device__ __forceinline__ void operator()(const f32x4 (&acc)[2][2][4][2], const Unit& u, int wr, int wc, int fr, int fq) const {
        constexpr int DFF_ = 2816;
        const int gc0 = u.pn * 128 + wc * 32 + 8 * fq;
        float w0[8], w1[8], w2[8], bb[8];
#pragma unroll
        for (int h = 0; h < 2; ++h) { const f32x4 a0 = *(const f32x4*)(cw + gc0 + 4 * h), a1 = *(const f32x4*)(cw + DFF_ + gc0 + 4 * h), a2 = *(const f32x4*)(cw + 2 * DFF_ + gc0 + 4 * h), a3 = *(const f32x4*)(cb + gc0 + 4 * h);
#pragma unroll
            for (int e = 0; e < 4; ++e) { w0[4 * h + e] = a0[e]; w1[4 * h + e] = a1[e]; w2[4 * h + e] = a2[e]; bb[4 * h + e] = a3[e]; } }
        const int l1 = (fq << 4) | ((fr + 15) & 15), l2 = (fq << 4) | ((fr + 14) & 15);
#pragma unroll
        for (int ai = 0; ai < 2; ++ai) {
            const int rbase = u.pm * BM + ai * HALF + wr * 64; const int blk = rbase >> 6;
            float rs[4];
#pragma unroll
            for (int m = 0; m < 4; ++m) rs[m] = __builtin_amdgcn_rsqf(ss[rbase + m * 16 + fr] * (1.f / 1024.f) + 1e-6f);
#pragma unroll
            for (int m = 0; m < 4; ++m) {
                float g[8], gp[8], vl[8], o[8];
#pragma unroll
                for (int n = 0; n < 2; ++n)
#pragma unroll
                    for (int e = 0; e < 4; ++e) { g[4 * n + e] = acc[ai][0][m][n][e] * rs[m]; vl[4 * n + e] = acc[ai][1][m][n][e] * rs[m]; gp[4 * n + e] = m > 0 ? acc[ai][0][m - 1][n][e] * rs[m - 1] : 0.f; }
#pragma unroll
                for (int e = 0; e < 8; ++e) { const float s1 = fr == 15 ? gp[e] : g[e], s2 = fr >= 14 ? gp[e] : g[e];
                    const float p1 = __shfl(s1, l1), p2 = __shfl(s2, l2);
                    const float x = w0[e] * p2 + w1[e] * p1 + w2[e] * g[e] + bb[e];
                    o[e] = x * __builtin_amdgcn_rcpf(1.f + __expf(-x)) * vl[e]; }
                const int row = rbase + m * 16 + fr;
                if (m == 0 && fr < 2) {
                    float* hg = HG + ((size_t)blk * 2 + fr) * DFF_ + gc0; float* hv = HV + ((size_t)blk * 2 + fr) * DFF_ + gc0;
                    *(f32x4*)hg = (f32x4){g[0], g[1], g[2], g[3]}; *(f32x4*)(hg + 4) = (f32x4){g[4], g[5], g[6], g[7]};
                    *(f32x4*)hv = (f32x4){vl[0], vl[1], vl[2], vl[3]}; *(f32x4*)(hv + 4) = (f32x4){vl[4], vl[5], vl[6], vl[7]};
                } else {
                    u32x4 w; w.x = cvt_pk_bf16(o[0], o[1]); w.y = cvt_pk_bf16(o[2], o[3]); w.z = cvt_pk_bf16(o[4], o[5]); w.w = cvt_pk_bf16(o[6], o[7]);
                    *(u32x4*)(H + (size_t)row * DFF_ + gc0) = w;
                }
                if (m == 3 && fr >= 14) { float* tg = TG + ((size_t)blk * 2 + (fr - 14)) * DFF_ + gc0;
                    *(f32x4*)tg = (f32x4){g[0], g[1], g[2], g[3]}; *(f32x4*)(tg + 4) = (f32x4){g[4], g[5], g[6], g[7]}; }
            }
        }
    }
};
}

constexpr int NWAVES = 8, NTHR = 512;
constexpr int BATCH = 2, T = 8192, D = 1024, M = BATCH * T;
constexpr int ABIN = 2816, PRW = 1792, DFF = 2816, UW = 5632, QKVW = 1536, LOW = 1536, LINW = 256, NH = 8;
constexpr size_t MiB = 1u << 20;
constexpr size_t WS_BON = 1 * MiB, WS_BIASP = 1 * MiB + 768 * 1024;
constexpr size_t WS_WIN = 2 * MiB, WS_WL = 8 * MiB, WS_WOUT = 254 * MiB, WS_LOW = 13 * MiB, WS_LOA = 29 * MiB, WS_LOG = 45 * MiB, WS_ST = 13 * MiB, WS_CAT = 61 * MiB, WS_SEQ = 93 * MiB;
constexpr size_t WS_XN1 = 93 * MiB, WS_PC = 125 * MiB, WS_LIN = 157 * MiB;
constexpr size_t WS_ROPE = 253 * MiB;
constexpr size_t DO_PR = 0, DO_ST = 56 * MiB;
constexpr size_t WS_WUP0 = 2 * MiB, WS_WDN0 = 13 * MiB, WS_WQKV = 19 * MiB, WS_WO = 22 * MiB, WS_WUP1 = 24 * MiB, WS_WDN1 = 35 * MiB;
constexpr size_t WS_H = 41 * MiB, WS_HG = 130 * MiB, WS_HV = 136 * MiB, WS_TG = 142 * MiB, WS_QKV = 41 * MiB, WS_O = 89 * MiB, WS_XB = 219 * MiB, WS_END = 256 * MiB;
constexpr size_t WS_SS = 1 * MiB + 512 * 1024;
constexpr int LDS_BYTES = 147456;

#define LAS __attribute__((address_space(3)))
typedef unsigned short bf16;
typedef float f32x4 __attribute__((ext_vector_type(4)));
typedef unsigned v4u __attribute__((ext_vector_type(4)));
typedef unsigned v2u __attribute__((ext_vector_type(2)));
typedef short bf16x8 __attribute__((ext_vector_type(8)));
typedef float f32x16 __attribute__((ext_vector_type(16)));
typedef float f32x2 __attribute__((ext_vector_type(2)));
#define LDS_WAIT() asm volatile("s_waitcnt lgkmcnt(0)" ::: "memory")

typedef __bf16 bf16x2_hw __attribute__((ext_vector_type(2)));
__device__ __forceinline__ unsigned pk2(float lo, float hi) { const f32x2 v = {lo, hi}; return __builtin_bit_cast(unsigned, __builtin_convertvector(v, bf16x2_hw)); }
__device__ __forceinline__ unsigned f2bf(float f) { return pk2(f, 0.f) & 0xffffu; }
__device__ __forceinline__ float bf2f(unsigned h) { return __builtin_bit_cast(float, h << 16); }
__device__ __forceinline__ float bflo(unsigned w) { return __builtin_bit_cast(float, w << 16); }
__device__ __forceinline__ float bfhi(unsigned w) { return __builtin_bit_cast(float, w & 0xffff0000u); }
__device__ __forceinline__ float wave_sum(float v) {
#pragma unroll
    for (int o = 1; o < 64; o <<= 1) v += __shfl_xor(v, o);
    return v;
}
__device__ __forceinline__ float sigm(float x) { return __builtin_amdgcn_rcpf(1.f + __expf(-x)); }
__device__ __forceinline__ float tanh_fast(float x) { return 1.f - 2.f * __builtin_amdgcn_rcpf(__expf(2.f * x) + 1.f); }

struct Args { const float* in[34]; float* out; unsigned char* ws; int ph_lo, ph_hi; };
#define CAS __attribute__((address_space(4)))
__device__ __forceinline__ const CAS char* kargs_ptr() { const CAS char* kp = (const CAS char*)__builtin_amdgcn_kernarg_segment_ptr(); asm volatile("" : "+s"(kp)); return kp; }
#define KIN(i) (*(const float* const CAS*)(kp_ + 8 * (i)))
#define KOUT (*(float* const CAS*)(kp_ + 8 * 34))
#define KWS (*(unsigned char* const CAS*)(kp_ + 8 * 35))
enum { I_X = 0, I_POS, I_ABG, I_WIN, I_CINB, I_DWW, I_DWB, I_CLNG, I_CLNB, I_MU, I_W0, I_W2, I_A0, I_A2, I_G2, I_KK, I_KA, I_RK, I_RLNG, I_RLNB, I_WOUT,
       I_ATG, I_WQKV, I_BQKV, I_QNG, I_KNG, I_SINK, I_WO, I_BO, I_FNG, I_WUP, I_FCW, I_FCB, I_WDN };

__device__ __forceinline__ void transpose_item(const float* W, int K, int N, bf16* WT, LAS float* scr, int item, int lane, const float* gain, int glu) {
    const int nblk = N / 32, kb = item / nblk, nb = item % nblk, k0 = 64 * kb, n0 = 32 * nb;
#pragma unroll 8
    for (int i = 0; i < 32; ++i) { const int kk = 2 * i + (lane >> 5); const float gk = gain ? gain[k0 + kk] : 1.f; scr[kk * 33 + (lane & 31)] = W[(size_t)(k0 + kk) * N + n0 + (lane & 31)] * gk; }
    LDS_WAIT(); asm volatile("" ::: "memory");
    const int c = lane & 7;
#pragma unroll
    for (int j = 0; j < 4; ++j) { const int n = (lane >> 3) + 8 * j; const LAS float* s = scr + (8 * c) * 33 + n;
        v4u o; o.x = pk2(s[0 * 33], s[1 * 33]); o.y = pk2(s[2 * 33], s[3 * 33]); o.z = pk2(s[4 * 33], s[5 * 33]); o.w = pk2(s[6 * 33], s[7 * 33]);
        const int nn = n0 + n; const int dr = glu ? (nn < DFF ? (nn >> 7) * 256 + (nn & 127) : ((nn - DFF) >> 7) * 256 + 128 + ((nn - DFF) & 127)) : nn;
        *(v4u*)(WT + (size_t)dr * K + k0 + 8 * c) = o; }
    LDS_WAIT(); asm volatile("" ::: "memory");
}
__device__ __forceinline__ void transpose_mat(const float* W, int K, int N, bf16* WT, LAS float* scr, int gw, int NGW, int lane, const float* gain = nullptr, int glu = 0) {
    const int nitems = (K / 64) * (N / 32);
    for (int it = gw; it < nitems; it += NGW) transpose_item(W, K, N, WT, scr, it, lane, gain, glu);
}
__device__ __forceinline__ void rms_rows(const float* src, const float* g, bf16* dst, int gw, int NGW, int lane) {
    for (int m = gw; m < M; m += NGW) {
        const f32x4* xr = (const f32x4*)(src + (size_t)m * D) + lane; const f32x4* gr = (const f32x4*)g + lane;
        f32x4 v[4]; float s = 0.f;
#pragma unroll
        for (int j = 0; j < 4; ++j) { v[j] = xr[64 * j]; s += (v[j].x * v[j].x + v[j].y * v[j].y) + (v[j].z * v[j].z + v[j].w * v[j].w); }
        const float rstd = __builtin_amdgcn_rsqf(wave_sum(s) * (1.f / D) + 1e-6f);
        unsigned long long* o8 = (unsigned long long*)(dst + (size_t)m * D) + lane;
#pragma unroll
        for (int j = 0; j < 4; ++j) { const f32x4 gg = gr[64 * j];
            o8[64 * j] = (unsigned long long)pk2(v[j].x * rstd * gg.x, v[j].y * rstd * gg.y) | ((unsigned long long)pk2(v[j].z * rstd * gg.z, v[j].w * rstd * gg.w) << 32); }
    }
}

__device__ __forceinline__ void p0_prologue(const Args& a, LAS unsigned char* lds, int tid, int lane, int wave) {
    const CAS char* kp_ = kargs_ptr();
    LAS float* scr = (LAS float*)(lds + wave * 16384);
    const int G = gridDim.x, gw = blockIdx.x * NWAVES + wave, NGW = G * NWAVES, gt = blockIdx.x * NTHR + tid, NGT = G * NTHR;
    transpose_mat(KIN(I_WIN), D, ABIN, (bf16*)(KWS + WS_WIN), scr, gw, NGW, lane);
    { float* bp = (float*)(KWS + WS_BIASP); for (int i = gt; i < ABIN; i += NGT) bp[i] = i < 1024 ? KIN(I_CINB)[i] : 0.f; }
    rms_rows(KIN(I_X), KIN(I_ABG), (bf16*)(KWS + WS_XN1), gw, NGW, lane);
}

__device__ __forceinline__ void p2_prep(const Args& a, LAS unsigned char* lds, int tid, int lane, int wave) {
    const CAS char* kp_ = kargs_ptr();
    const bf16* PC = (const bf16*)(KWS + WS_PC); const bf16* PR = (const bf16*)((unsigned char*)KOUT + DO_PR);
    bf16* CAT = (bf16*)(KWS + WS_CAT); bf16* LIN = (bf16*)(KWS + WS_LIN);
    LAS float* ybuf = (LAS float*)lds;
    const int c = tid;
    float wv[31];
#pragma unroll
    for (int j = 0; j < 31; ++j) wv[j] = KIN(I_DWW)[j * 512 + c];
    const float bc = KIN(I_DWB)[c];
    for (int tile = blockIdx.x; tile < M / 32; tile += gridDim.x) {
        const int b = tile / (T / 32), tt0 = (tile % (T / 32)) * 32;
        float g[62];
        if (tt0 >= 30) {
            const bf16* rowp = PC + (size_t)(b * T + tt0 - 30) * 1024 + c;
#pragma unroll
            for (int i = 0; i < 62; ++i) { const float x1 = bf2f(rowp[i * 1024]), x2 = bf2f(rowp[i * 1024 + 512]); g[i] = x1 * sigm(x2); }
        } else {
#pragma unroll
            for (int i = 0; i < 62; ++i) { const int t = tt0 - 30 + i; float v = 0.f;
                if (t >= 0) { const size_t o = (size_t)(b * T + t) * 1024 + c; const float x1 = bf2f(PC[o]), x2 = bf2f(PC[o + 512]); v = x1 * sigm(x2); }
                g[i] = v; }
        }
#pragma unroll
        for (int tt = 0; tt < 32; ++tt) { float y = bc;
#pragma unroll
            for (int j = 0; j < 31; ++j) y += wv[j] * g[tt + j];
            ybuf[tt * 512 + c] = y; }
        __syncthreads();
#pragma unroll
        for (int q = 0; q < 4; ++q) { const int tt = wave * 4 + q; const LAS f32x4* yr = (const LAS f32x4*)(ybuf + tt * 512 + lane * 8);
            const f32x4 y0 = yr[0], y1 = yr[1];
            const float mean = wave_sum((y0.x + y0.y) + (y0.z + y0.w) + (y1.x + y1.y) + (y1.z + y1.w)) * (1.f / 512.f);
            const f32x4 d0 = y0 - mean, d1 = y1 - mean;
            const float var = wave_sum((d0.x * d0.x + d0.y * d0.y) + (d0.z * d0.z + d0.w * d0.w) + (d1.x * d1.x + d1.y * d1.y) + (d1.z * d1.z + d1.w * d1.w)) * (1.f / 512.f);
            const float rstd = __builtin_amdgcn_rsqf(var + 1e-5f);
            const f32x4 g0 = *(const f32x4*)(KIN(I_CLNG) + lane * 8), g1 = *(const f32x4*)(KIN(I_CLNG) + lane * 8 + 4);
            const f32x4 b0 = *(const f32x4*)(KIN(I_CLNB) + lane * 8), b1 = *(const f32x4*)(KIN(I_CLNB) + lane * 8 + 4);
            f32x4 o0 = d0 * rstd * g0 + b0, o1 = d1 * rstd * g1 + b1;
            o0.x *= sigm(o0.x); o0.y *= sigm(o0.y); o0.z *= sigm(o0.z); o0.w *= sigm(o0.w); o1.x *= sigm(o1.x); o1.y *= sigm(o1.y); o1.z *= sigm(o1.z); o1.w *= sigm(o1.w);
            v4u w; w.x = pk2(o0.x, o0.y); w.y = pk2(o0.z, o0.w); w.z = pk2(o1.x, o1.y); w.w = pk2(o1.z, o1.w);
            *(v4u*)(CAT + (size_t)(b * T + tt0 + tt) * 1024 + lane * 8) = w; }
        __syncthreads();
    }
    const int gt = blockIdx.x * NTHR + tid, NGT = gridDim.x * NTHR;
    for (int w = gt; w < (M / 32) * LINW; w += NGT) { const int j = w & 255, m_start = (w >> 8) * 32;
        const bf16* p = PR + (size_t)m_start * PRW + 1536 + j; bf16* o = LIN + (size_t)m_start * LINW + j;
        const float mu = KIN(I_MU)[1536 + j];
        float prev = (m_start & (T - 1)) != 0 ? bf2f(p[-PRW]) : 0.f;
#pragma unroll 8
        for (int i = 0; i < 32; ++i) { const float p1 = bf2f(p[i * PRW]); const float xs = p1 + (prev - p1) * mu; prev = p1;
            const float v = j < 64 ? tanh_fast(xs) : (j < 128 ? xs : sigm(xs));
            o[i * LINW] = (bf16)f2bf(v); }
    }
}

constexpr int SLABB = 2048, RUNL = 64;
constexpr size_t WS_WLC = 256 * 1024;
struct SlabRegs { v4u p1, p2; };
__device__ __forceinline__ void slab_load(SlabRegs& r, const unsigned char* slab, int lane) {
    r.p1 = *(const v4u*)(slab + lane * 16); r.p2 = *(const v4u*)(slab + 1024 + lane * 16);
}
__device__ __forceinline__ void slab_piece(const v4u q, LAS float* dst, int p) {
    LAS float* d = dst + (p >> 5) * 256 + ((p >> 3) & 3) * 64 + (p & 7) * 8;
    *(LAS f32x4*)d = (f32x4){bflo(q.x), bfhi(q.x), bflo(q.y), bfhi(q.y)}; *(LAS f32x4*)(d + 4) = (f32x4){bflo(q.z), bfhi(q.z), bflo(q.w), bfhi(q.w)};
}
__device__ __forceinline__ void slab_store(const SlabRegs& r, LAS float* dst, int lane) { slab_piece(r.p1, dst, lane); slab_piece(r.p2, dst, lane + 64); }
__device__ __forceinline__ void p4_rwkv_prep(const Args& a, int lane, int wave) {
    const CAS char* kp_ = kargs_ptr();
    const bf16* PR = (const bf16*)((unsigned char*)KOUT + DO_PR); const bf16* LOWp = (const bf16*)(KWS + WS_LOW); const bf16* LOAp = (const bf16*)(KWS + WS_LOA);
    unsigned char* SEQ = KWS + WS_SEQ; float* BON = (float*)(KWS + WS_BON); float* WLC = (float*)(KWS + WS_WLC);
    const int gw = blockIdx.x * NWAVES + wave, NGW = gridDim.x * NWAVES;
    constexpr int RUN = 64, U = 4;
    for (int run = gw; run < (M / RUN) * NH; run += NGW) { const int h = run & 7, mbase = (run >> 3) * RUN, c = h * 64 + lane, b = mbase / T;
        const float mur = KIN(I_MU)[c], muk = KIN(I_MU)[512 + c], w0 = KIN(I_W0)[c], a0 = KIN(I_A0)[c], kkc = KIN(I_KK)[c], kac = KIN(I_KA)[c], rkc = KIN(I_RK)[c];
        float rp = 0.f, kp_ = 0.f, Wc = 1.f;
        if ((mbase & (T - 1)) != 0) { rp = bf2f(PR[(size_t)(mbase - 1) * PRW + c]); kp_ = bf2f(PR[(size_t)(mbase - 1) * PRW + 512 + c]); }
        for (int i0 = 0; i0 < RUN; i0 += U) {
            float r1[U], k1[U], lw[U], la[U];
#pragma unroll
            for (int u = 0; u < U; ++u) { const size_t m = (size_t)(mbase + i0 + u); r1[u] = bf2f(PR[m * PRW + c]); k1[u] = bf2f(PR[m * PRW + 512 + c]); lw[u] = bf2f(LOWp[m * 512 + c]); la[u] = bf2f(LOAp[m * 512 + c]); }
            float kkr[U], kpv[U], rr[U], dec[U], agv[U], n2[U], bn[U];
#pragma unroll
            for (int u = 0; u < U; ++u) {
                const float r = r1[u] + (rp - r1[u]) * mur, k = k1[u] + (kp_ - k1[u]) * muk; rp = r1[u]; kp_ = k1[u];
                const float z = -(w0 + lw[u]);
                const float sp = fmaxf(z, 0.f) + __logf(1.f + __expf(-fabsf(z)));
                dec[u] = __expf(-__expf(-sp - 0.5f));
                const float ag = sigm(a0 + la[u]); agv[u] = ag;
                kkr[u] = k * kkc; n2[u] = kkr[u] * kkr[u];
                kpv[u] = k * (1.f + (ag - 1.f) * kac); rr[u] = r; bn[u] = r * kpv[u] * rkc; }
#pragma unroll
            for (int o = 1; o < 64; o <<= 1)
#pragma unroll
                for (int u = 0; u < U; ++u) { n2[u] += __shfl_xor(n2[u], o); bn[u] += __shfl_xor(bn[u], o); }
#pragma unroll
            for (int u = 0; u < U; ++u) { const int m = mbase + i0 + u, t = m & (T - 1);
                const float kk = kkr[u] * __builtin_amdgcn_rsqf(fmaxf(n2[u], 1e-24f));
                unsigned char* sl_ = SEQ + ((size_t)(b * NH + h) * (T / 4) + (t >> 2)) * SLABB; const int st_ = t & 3;
                const float ap = -kk * Wc; Wc *= dec[u]; const float iW = __builtin_amdgcn_rcpf(Wc);
                bf16* hb = (bf16*)(sl_ + st_ * 512) + lane;
                hb[0] = (bf16)f2bf(ap); hb[64] = (bf16)f2bf(kk * agv[u] * iW); hb[128] = (bf16)f2bf(kpv[u] * iW); hb[192] = (bf16)f2bf(rr[u] * Wc);
                if (lane == 0) BON[(size_t)m * NH + h] = bn[u]; }
        }
        WLC[((size_t)(b * NH + h) * (T / RUNL) + (mbase & (T - 1)) / RUNL) * 64 + lane] = Wc;
    }
}

__device__ __forceinline__ int crow(int r, int hi) { return (r & 3) + 8 * (r >> 2) + 4 * hi; }
constexpr int SLAB = 4, SLABF = SLAB * 256;
constexpr int NCH = 64, CL = T / NCH;
template <int MODE>
__device__ __forceinline__ void scan_task(const Args& a, LAS float* wl, int lane, int chain, int ck) {
    const CAS char* kp_ = kargs_ptr();
    const bf16* PR = (const bf16*)((unsigned char*)KOUT + DO_PR); const bf16* LOGp = (const bf16*)(KWS + WS_LOG);
    const unsigned char* SEQ = KWS + WS_SEQ; const float* BON = (const float*)(KWS + WS_BON); bf16* CAT = (bf16*)(KWS + WS_CAT);
    float* ST = (float*)(KWS + WS_ST);
    const int b = chain >> 3, h = chain & 7, c = h * 64 + lane, t0 = ck * CL;
    const float muv = KIN(I_MU)[1024 + c];
    float lng = 0.f, lnb = 0.f;
    if constexpr (MODE == 2) { lng = KIN(I_RLNG)[c]; lnb = KIN(I_RLNB)[c]; }
    f32x2 S[32];
#pragma unroll
    for (int j = 0; j < 32; ++j) S[j] = (f32x2){0.f, 0.f};
    if constexpr (MODE == 3) {
#pragma unroll
        for (int j = 0; j < 32; ++j) S[j] = (f32x2){lane == 2 * j ? 1.f : 0.f, lane == 2 * j + 1 ? 1.f : 0.f};
    }
    if constexpr (MODE == 2) {
        if (ck > 0) { const f32x4* sp = (const f32x4*)(ST + ((size_t)(chain * NCH + ck - 1) * 2) * 4096 + lane * 64);
#pragma unroll
            for (int j = 0; j < 16; ++j) { const f32x4 q = sp[j]; S[2 * j] = q.xy; S[2 * j + 1] = q.zw; } }
    }
    const unsigned char* sq = SEQ + ((size_t)chain * (T / SLAB) + t0 / SLAB) * SLABB;
    const size_t m0 = (size_t)b * T + t0;
    float pprev = 0.f;
    if constexpr (MODE != 3) pprev = t0 > 0 ? bf2f(PR[(m0 - 1) * PRW + 1024 + c]) : 0.f;
    SlabRegs pre; unsigned pvn[SLAB], gtn[SLAB]; float bnn[SLAB];
    slab_load(pre, sq, lane);
#pragma unroll
    for (int s = 0; s < SLAB; ++s) { const size_t m = m0 + s; if constexpr (MODE != 3) pvn[s] = PR[m * PRW + 1024 + c]; if constexpr (MODE == 2) { gtn[s] = LOGp[m * 512 + c]; bnn[s] = BON[m * NH + h]; } }
    slab_store(pre, wl, lane);
    for (int sl = 0; sl < CL / SLAB; ++sl) {
        const int buf = sl & 1; const LAS float* ob = wl + buf * SLABF;
        if (sl == RUNL / SLAB) {
            const f32x4* wq = (const f32x4*)((const float*)(KWS + WS_WLC) + ((size_t)chain * (T / RUNL) + t0 / RUNL) * 64);
#pragma unroll
            for (int j = 0; j < 16; ++j) { const f32x4 q = wq[j]; S[2 * j] *= q.xy; S[2 * j + 1] *= q.zw; } }
        unsigned pvc[SLAB], gtc[SLAB]; float bnc[SLAB];
#pragma unroll
        for (int s = 0; s < SLAB; ++s) { if constexpr (MODE != 3) pvc[s] = pvn[s]; if constexpr (MODE == 2) { gtc[s] = gtn[s]; bnc[s] = bnn[s]; } }
        const int sn = (sl + 1 < CL / SLAB) ? sl + 1 : sl;
        slab_load(pre, sq + (size_t)sn * SLABB, lane);
#pragma unroll
        for (int s = 0; s < SLAB; ++s) { const size_t m = m0 + (size_t)sn * SLAB + s; if constexpr (MODE != 3) pvn[s] = PR[m * PRW + 1024 + c]; if constexpr (MODE == 2) { gtn[s] = LOGp[m * 512 + c]; bnn[s] = BON[m * NH + h]; } }
        __builtin_amdgcn_sched_barrier(0);
        float ys[SLAB], vs[SLAB];
        constexpr int NIT = 20, NQ = (MODE == 2 ? 3 : (MODE == 1 ? 2 : 1));
        f32x4 ring[8][4];
        const LAS f32x4* o4b = (const LAS f32x4*)ob;
#define SCAN_LD(it_) do { const int st_ = (it_) / NIT, lc_ = (it_) % NIT; const LAS f32x4* o4_ = o4b + st_ * 64; \
            if (lc_ < 4) { _Pragma("unroll") for (int q_ = 0; q_ < 4; ++q_) ring[(it_) & 7][q_] = o4_[4 * lc_ + q_]; } \
            else { _Pragma("unroll") for (int q_ = 0; q_ < NQ; ++q_) ring[(it_) & 7][q_] = o4_[16 * (q_ + 1) + (lc_ - 4)]; } } while (0)
        SCAN_LD(0); SCAN_LD(1); SCAN_LD(2); SCAN_LD(3); SCAN_LD(4); SCAN_LD(5);
        f32x2 sa0 = {0.f, 0.f}, sa1 = {0.f, 0.f}, y0 = {0.f, 0.f}, y1 = {0.f, 0.f}, sav = {0.f, 0.f}, vv = {0.f, 0.f};
#pragma unroll
        for (int it = 0; it < SLAB * NIT; ++it) {
            const int st = it / NIT, lc = it % NIT;
            if (it + 6 < SLAB * NIT) SCAN_LD(it + 6);
            if (lc == 0) { float v = 0.f;
                if constexpr (MODE != 3) { const float pv = bf2f(pvc[st]); v = pv + (pprev - pv) * muv; pprev = pv; }
                vs[st] = v; vv = (f32x2){v, v}; sa0 = (f32x2){0.f, 0.f}; sa1 = (f32x2){0.f, 0.f}; y0 = (f32x2){0.f, 0.f}; y1 = (f32x2){0.f, 0.f}; }
            if (lc < 4) {
#pragma unroll
                for (int q = 0; q < 4; ++q) { const f32x4 a4 = ring[it & 7][q]; sa0 += S[8 * lc + 2 * q] * a4.xy; sa1 += S[8 * lc + 2 * q + 1] * a4.zw; }
                if (lc == 3) { const float sa = (sa0.x + sa0.y) + (sa1.x + sa1.y); sav = (f32x2){sa, sa}; }
            } else { const int j = lc - 4; const f32x4 b4 = ring[it & 7][0];
                f32x2 n0 = S[2 * j] + sav * b4.xy, n1 = S[2 * j + 1] + sav * b4.zw;
                if constexpr (MODE != 3) { const f32x4 k4 = ring[it & 7][1]; n0 += vv * k4.xy; n1 += vv * k4.zw; }
                S[2 * j] = n0; S[2 * j + 1] = n1;
                if constexpr (MODE == 2) { const f32x4 r4 = ring[it & 7][2]; y0 += n0 * r4.xy; y1 += n1 * r4.zw; if (lc == NIT - 1) ys[st] = (y0.x + y0.y) + (y1.x + y1.y); }
            }
            __builtin_amdgcn_sched_barrier(0);
        }
#undef SCAN_LD
        if constexpr (MODE == 2) {
            float mu4[SLAB], d4[SLAB], q4[SLAB];
#pragma unroll
            for (int s = 0; s < SLAB; ++s) mu4[s] = ys[s];
#pragma unroll
            for (int o = 1; o < 64; o <<= 1)
#pragma unroll
                for (int s = 0; s < SLAB; ++s) mu4[s] += __shfl_xor(mu4[s], o);
#pragma unroll
            for (int s = 0; s < SLAB; ++s) { d4[s] = ys[s] - mu4[s] * (1.f / 64.f); q4[s] = d4[s] * d4[s]; }
#pragma unroll
            for (int o = 1; o < 64; o <<= 1)
#pragma unroll
                for (int s = 0; s < SLAB; ++s) q4[s] += __shfl_xor(q4[s], o);
#pragma unroll
            for (int s = 0; s < SLAB; ++s) { float yn = d4[s] * __builtin_amdgcn_rsqf(q4[s] * (1.f / 64.f) + 64e-5f) * lng + lnb;
                yn += bnc[s] * vs[s]; yn *= bf2f(gtc[s]);
                CAT[(m0 + (size_t)sl * SLAB + s) * 1024 + 512 + c] = (bf16)f2bf(yn); }
        }
        slab_store(pre, wl + (buf ^ 1) * SLABF, lane);
    }
    if constexpr (MODE != 2) {
        f32x4* dm = (f32x4*)(ST + ((size_t)(chain * NCH + ck) * 2 + (MODE == 1 ? 1 : 0)) * 4096 + lane * 64);
#pragma unroll
        for (int j = 0; j < 16; ++j) { f32x4 q; q.xy = S[2 * j]; q.zw = S[2 * j + 1]; dm[j] = q; }
    }
}
__device__ __forceinline__ void scan_task_p1(const Args& a, LAS float* wl, int lane, int chain, int ck, int rh) {
    const CAS char* kp_ = kargs_ptr();
    const bf16* PR = (const bf16*)((unsigned char*)KOUT + DO_PR); const unsigned char* SEQ = KWS + WS_SEQ; float* ST = (float*)(KWS + WS_ST);
    const int b = chain >> 3, h = chain & 7, r32 = lane & 31, kh = lane >> 5, row = 32 * rh + r32, c = h * 64 + row, t0 = ck * CL;
    const float muv = KIN(I_MU)[1024 + c];
    f32x2 Sn[16], Sm[16];
#pragma unroll
    for (int j = 0; j < 16; ++j) { Sn[j] = (f32x2){0.f, 0.f}; Sm[j] = (f32x2){row == 32 * kh + 2 * j ? 1.f : 0.f, row == 32 * kh + 2 * j + 1 ? 1.f : 0.f}; }
    const unsigned char* sq = SEQ + ((size_t)chain * (T / SLAB) + t0 / SLAB) * SLABB;
    const size_t m0 = (size_t)b * T + t0;
    float pprev = t0 > 0 ? bf2f(PR[(m0 - 1) * PRW + 1024 + c]) : 0.f;
    SlabRegs pre; unsigned pvn[SLAB];
    slab_load(pre, sq, lane);
#pragma unroll
    for (int s = 0; s < SLAB; ++s) pvn[s] = PR[(m0 + s) * PRW + 1024 + c];
    slab_store(pre, wl, lane);
    for (int sl = 0; sl < CL / SLAB; ++sl) {
        const int buf = sl & 1; const LAS float* ob = wl + buf * SLABF;
        if (sl == RUNL / SLAB) {
            const f32x4* wq = (const f32x4*)((const float*)(KWS + WS_WLC) + ((size_t)chain * (T / RUNL) + t0 / RUNL) * 64 + 32 * kh);
#pragma unroll
            for (int j = 0; j < 8; ++j) { const f32x4 q = wq[j]; Sn[2 * j] *= q.xy; Sn[2 * j + 1] *= q.zw; Sm[2 * j] *= q.xy; Sm[2 * j + 1] *= q.zw; } }
        unsigned pvc[SLAB];
#pragma unroll
        for (int s = 0; s < SLAB; ++s) pvc[s] = pvn[s];
        const int sn = (sl + 1 < CL / SLAB) ? sl + 1 : sl;
        slab_load(pre, sq + (size_t)sn * SLABB, lane);
#pragma unroll
        for (int s = 0; s < SLAB; ++s) pvn[s] = PR[(m0 + (size_t)sn * SLAB + s) * PRW + 1024 + c];
        __builtin_amdgcn_sched_barrier(0);
        constexpr int NIT = 10;
        f32x4 ring[4][4];
        const LAS f32x4* o4b = (const LAS f32x4*)ob + 8 * kh;
#define P1_LD(it_) do { const int st_ = (it_) / NIT, lc_ = (it_) % NIT; const LAS f32x4* o4_ = o4b + st_ * 64; \
            if (lc_ < 2) { _Pragma("unroll") for (int q_ = 0; q_ < 4; ++q_) ring[(it_) & 3][q_] = o4_[4 * lc_ + q_]; } \
            else { _Pragma("unroll") for (int q_ = 0; q_ < 2; ++q_) ring[(it_) & 3][q_] = o4_[16 * (q_ + 1) + (lc_ - 2)]; } } while (0)
        P1_LD(0); P1_LD(1); P1_LD(2);
        f32x2 an0 = {0.f, 0.f}, an1 = {0.f, 0.f}, am0 = {0.f, 0.f}, am1 = {0.f, 0.f}, sanv = {0.f, 0.f}, samv = {0.f, 0.f}, vv = {0.f, 0.f};
#pragma unroll
        for (int it = 0; it < SLAB * NIT; ++it) {
            const int st = it / NIT, lc = it % NIT;
            if (it + 3 < SLAB * NIT) P1_LD(it + 3);
            if (lc == 0) { const float pv = bf2f(pvc[st]); const float v = pv + (pprev - pv) * muv; pprev = pv; vv = (f32x2){v, v};
                an0 = (f32x2){0.f, 0.f}; an1 = (f32x2){0.f, 0.f}; am0 = (f32x2){0.f, 0.f}; am1 = (f32x2){0.f, 0.f}; }
            if (lc < 2) {
#pragma unroll
                for (int q = 0; q < 4; ++q) { const f32x4 a4 = ring[it & 3][q];
                    an0 += Sn[8 * lc + 2 * q] * a4.xy; an1 += Sn[8 * lc + 2 * q + 1] * a4.zw; am0 += Sm[8 * lc + 2 * q] * a4.xy; am1 += Sm[8 * lc + 2 * q + 1] * a4.zw; }
                if (lc == 1) { float san = (an0.x + an0.y) + (an1.x + an1.y), sam = (am0.x + am0.y) + (am1.x + am1.y);
                    san += __shfl_xor(san, 32); sam += __shfl_xor(sam, 32); sanv = (f32x2){san, san}; samv = (f32x2){sam, sam}; }
            } else { const int j = lc - 2; const f32x4 b4 = ring[it & 3][0], k4 = ring[it & 3][1];
                Sn[2 * j] = Sn[2 * j] + sanv * b4.xy + vv * k4.xy; Sn[2 * j + 1] = Sn[2 * j + 1] + sanv * b4.zw + vv * k4.zw;
                Sm[2 * j] = Sm[2 * j] + samv * b4.xy;              Sm[2 * j + 1] = Sm[2 * j + 1] + samv * b4.zw;
            }
            __builtin_amdgcn_sched_barrier(0);
        }
#undef P1_LD
        slab_store(pre, wl + (buf ^ 1) * SLABF, lane);
    }
    f32x4* dm = (f32x4*)(ST + ((size_t)(chain * NCH + ck) * 2) * 4096 + row * 64 + 32 * kh); f32x4* dn = dm + 1024;
    const f32x4* wq = (const f32x4*)((const float*)(KWS + WS_WLC) + ((size_t)chain * (T / RUNL) + t0 / RUNL + 1) * 64 + 32 * kh);
#pragma unroll
    for (int j = 0; j < 8; ++j) { const f32x4 w4 = wq[j]; f32x4 q; q.xy = Sm[2 * j] * w4.xy; q.zw = Sm[2 * j + 1] * w4.zw; dm[j] = q; f32x4 p; p.xy = Sn[2 * j] * w4.xy; p.zw = Sn[2 * j + 1] * w4.zw; dn[j] = p; }
}
__device__ __forceinline__ void scan_pass1(const Args& a, LAS unsigned char* lds, int lane, int wave) {
    LAS float* wl = (LAS float*)(lds + wave * (2 * SLABF * 4));
    const int ntask = 2 * BATCH * NH * (NCH - 1);
    for (int wk = wave * gridDim.x + blockIdx.x; wk < ntask; wk += NWAVES * gridDim.x) {
        const int rh = wk & 1, chain = (wk >> 1) & 15, ck = wk >> 5;
        scan_task_p1(a, wl, lane, chain, ck, rh);
    }
}
__device__ __forceinline__ void scan_pass2(const Args& a, LAS unsigned char* lds, int lane, int wave) {
    LAS float* wl = (LAS float*)(lds + wave * (2 * SLABF * 4));
    for (int wk = wave * gridDim.x + blockIdx.x; wk < BATCH * NH * NCH; wk += NWAVES * gridDim.x) scan_task<2>(a, wl, lane, wk & 15, wk >> 4);
}
constexpr int GS = 8, NG = NCH / GS;
__device__ __forceinline__ f32x16 mm_acc(const LAS float* X, const LAS float* Mm, f32x16 acc, int ti, int tn, int kh, int l31, int hi) {
    const LAS float* sb = X + (32 * ti + l31) * 65 + 32 * kh + hi;
    const LAS float* mb = Mm + (32 * kh + hi) * 64 + 32 * tn + l31;
#pragma unroll
    for (int kk = 0; kk < 16; ++kk) acc = __builtin_amdgcn_mfma_f32_32x32x2f32(sb[2 * kk], mb[2 * kk * 64], acc, 0, 0, 0);
    return acc;
}
__device__ __forceinline__ void comb_a(const Args& a, LAS unsigned char* lds, int tid, int lane, int wave) {
    const CAS char* kp_ = kargs_ptr();
    if (blockIdx.x >= BATCH * NH * NG) return;
    const int chain = blockIdx.x & 15, g = blockIdx.x >> 4, c0 = g * GS;
    float* ST = (float*)(KWS + WS_ST);
    LAS float* XM = (LAS float*)lds;
    LAS float* XN = XM + 2 * 4160;
    LAS float* Mb = XN + 2 * 4160;
    LAS float* Nb = Mb + 4096;
    LAS float* Pb = Nb + 4096;
    const int l31 = lane & 31, hi = lane >> 5, tile = wave & 3, ti = tile >> 1, tn = tile & 1, kh = wave >> 2;
    const int jmax = (c0 + GS - 1 <= NCH - 2) ? GS - 1 : NCH - 2 - c0;
    f32x4 rq[4];
    { const f32x4* gm = (const f32x4*)(ST + ((size_t)(chain * NCH + c0) * 2) * 4096);
#pragma unroll
      for (int e = 0; e < 2; ++e) { const int idx = tid + 512 * e; const f32x4 m = gm[idx], n = gm[1024 + idx]; const int r = idx >> 4, cc = (idx & 15) * 4;
#pragma unroll
          for (int q = 0; q < 4; ++q) { XM[r * 65 + cc + q] = m[q]; XN[r * 65 + cc + q] = n[q]; } }
      const f32x4* g1 = gm + 2048;
      rq[0] = g1[tid]; rq[1] = g1[tid + 512]; rq[2] = g1[1024 + tid]; rq[3] = g1[1024 + tid + 512]; }
    int cur = 0;
    for (int j = 1; j <= jmax; ++j) {
#pragma unroll
        for (int e = 0; e < 2; ++e) { const int idx = tid + 512 * e; *(LAS f32x4*)(Mb + idx * 4) = rq[e]; *(LAS f32x4*)(Nb + idx * 4) = rq[2 + e]; }
        { const int cn = (j + 1 <= jmax) ? c0 + j + 1 : c0 + j; const f32x4* gm = (const f32x4*)(ST + ((size_t)(chain * NCH + cn) * 2) * 4096);
          rq[0] = gm[tid]; rq[1] = gm[tid + 512]; rq[2] = gm[1024 + tid]; rq[3] = gm[1024 + tid + 512]; }
        __syncthreads();
        f32x16 am, an;
#pragma unroll
        for (int r = 0; r < 16; ++r) { am[r] = 0.f; an[r] = kh == 0 ? Nb[(32 * ti + crow(r, hi)) * 64 + 32 * tn + l31] : 0.f; }
        am = mm_acc(XM + cur * 4160, Mb, am, ti, tn, kh, l31, hi);
        an = mm_acc(XN + cur * 4160, Mb, an, ti, tn, kh, l31, hi);
        if (kh == 1) {
#pragma unroll
            for (int r = 0; r < 16; ++r) { Pb[(tile * 16 + r) * 64 + lane] = am[r]; Pb[4096 + (tile * 16 + r) * 64 + lane] = an[r]; }
        }
        __syncthreads();
        if (kh == 0) {
            float* gs = ST + ((size_t)(chain * NCH + c0 + j) * 2) * 4096;
#pragma unroll
            for (int r = 0; r < 16; ++r) { const float vm = am[r] + Pb[(tile * 16 + r) * 64 + lane], vn = an[r] + Pb[4096 + (tile * 16 + r) * 64 + lane]; const int row = 32 * ti + crow(r, hi), col = 32 * tn + l31;
                XM[(cur ^ 1) * 4160 + row * 65 + col] = vm; XN[(cur ^ 1) * 4160 + row * 65 + col] = vn; gs[row * 64 + col] = vm; gs[4096 + row * 64 + col] = vn; }
        }
        cur ^= 1;
    }
}
__device__ __forceinline__ void comb_b(const Args& a, LAS unsigned char* lds, int tid, int lane, int wave) {
    const CAS char* kp_ = kargs_ptr();
    if (blockIdx.x >= BATCH * NH) return;
    const int chain = blockIdx.x;
    float* ST = (float*)(KWS + WS_ST);
    LAS float* Sb = (LAS float*)lds;
    LAS float* Mb = Sb + 2 * 4160;
    LAS float* Nb = Mb + 4096;
    LAS float* Pb = Nb + 4096;
    const int l31 = lane & 31, hi = lane >> 5, tile = wave & 3, ti = tile >> 1, tn = tile & 1, kh = wave >> 2;
    for (int i = tid; i < 2 * 4160; i += NTHR) Sb[i] = 0.f;
    f32x4 rq[4];
    { const f32x4* gm = (const f32x4*)(ST + ((size_t)(chain * NCH + GS - 1) * 2) * 4096); rq[0] = gm[tid]; rq[1] = gm[tid + 512]; rq[2] = gm[1024 + tid]; rq[3] = gm[1024 + tid + 512]; }
    int cur = 0;
    for (int g = 0; g < NG - 1; ++g) {
        const int c = g * GS + GS - 1;
#pragma unroll
        for (int e = 0; e < 2; ++e) { const int idx = tid + 512 * e; *(LAS f32x4*)(Mb + idx * 4) = rq[e]; *(LAS f32x4*)(Nb + idx * 4) = rq[2 + e]; }
        { const int cn = (g + 1 < NG - 1) ? c + GS : c; const f32x4* gm = (const f32x4*)(ST + ((size_t)(chain * NCH + cn) * 2) * 4096);
          rq[0] = gm[tid]; rq[1] = gm[tid + 512]; rq[2] = gm[1024 + tid]; rq[3] = gm[1024 + tid + 512]; }
        __syncthreads();
        f32x16 acc;
#pragma unroll
        for (int r = 0; r < 16; ++r) acc[r] = kh == 0 ? Nb[(32 * ti + crow(r, hi)) * 64 + 32 * tn + l31] : 0.f;
        acc = mm_acc(Sb + cur * 4160, Mb, acc, ti, tn, kh, l31, hi);
        if (kh == 1) {
#pragma unroll
            for (int r = 0; r < 16; ++r) Pb[(tile * 16 + r) * 64 + lane] = acc[r];
        }
        __syncthreads();
        if (kh == 0) {
            float* gs = ST + ((size_t)(chain * NCH + c) * 2) * 4096;
#pragma unroll
            for (int r = 0; r < 16; ++r) { const float v = acc[r] + Pb[(tile * 16 + r) * 64 + lane]; const int row = 32 * ti + crow(r, hi), col = 32 * tn + l31;
                Sb[(cur ^ 1) * 4160 + row * 65 + col] = v; gs[row * 64 + col] = v; }
        }
        cur ^= 1;
    }
}
__device__ __forceinline__ void comb_c(const Args& a, LAS unsigned char* lds, int tid, int lane, int wave) {
    const CAS char* kp_ = kargs_ptr();
    float* ST = (float*)(KWS + WS_ST);
    LAS float* Sb = (LAS float*)lds;
    LAS float* Mb = Sb + 4160;
    LAS float* Nb = Mb + 4096;
    LAS float* Pb = Nb + 4096;
    const int l31 = lane & 31, hi = lane >> 5, tile = wave & 3, ti = tile >> 1, tn = tile & 1, kh = wave >> 2;
    for (int task = blockIdx.x; task < BATCH * NH * NG * (GS - 1); task += gridDim.x) {
        const int chain = task & 15, g = (task >> 4) & (NG - 1), j = task >> 7, c = g * GS + j;
        { const f32x4* gm = (const f32x4*)(ST + ((size_t)(chain * NCH + c) * 2) * 4096);
          const f32x4* gx = (const f32x4*)(ST + ((size_t)(chain * NCH + (g > 0 ? (g * GS - 1) : 0)) * 2) * 4096);
#pragma unroll
          for (int e = 0; e < 2; ++e) { const int idx = tid + 512 * e; *(LAS f32x4*)(Mb + idx * 4) = gm[idx]; *(LAS f32x4*)(Nb + idx * 4) = gm[1024 + idx];
              const f32x4 x = g > 0 ? gx[idx] : (f32x4){0.f, 0.f, 0.f, 0.f}; const int r = idx >> 4, cc = (idx & 15) * 4;
#pragma unroll
              for (int q = 0; q < 4; ++q) Sb[r * 65 + cc + q] = x[q]; } }
        __syncthreads();
        f32x16 acc;
#pragma unroll
        for (int r = 0; r < 16; ++r) acc[r] = kh == 0 ? Nb[(32 * ti + crow(r, hi)) * 64 + 32 * tn + l31] : 0.f;
        acc = mm_acc(Sb, Mb, acc, ti, tn, kh, l31, hi);
        if (kh == 1) {
#pragma unroll
            for (int r = 0; r < 16; ++r) Pb[(tile * 16 + r) * 64 + lane] = acc[r];
        }
        __syncthreads();
        if (kh == 0) {
            float* gs = ST + ((size_t)(chain * NCH + c) * 2) * 4096;
#pragma unroll
            for (int r = 0; r < 16; ++r) gs[(32 * ti + crow(r, hi)) * 64 + 32 * tn + l31] = acc[r] + Pb[(tile * 16 + r) * 64 + lane];
        }
        __syncthreads();
    }
}

__device__ __forceinline__ void glu_fixup(const Args& a, int layer, int tid) {
    const CAS char* kp_ = kargs_ptr();
    bf16* H = (bf16*)(KWS + WS_H); const float* HG = (const float*)(KWS + WS_HG); const float* HV = (const float*)(KWS + WS_HV); const float* TG = (const float*)(KWS + WS_TG);
    const float* cw = KIN(I_FCW) + (size_t)layer * 3 * DFF; const float* cb = KIN(I_FCB) + (size_t)layer * DFF;
    const int gt = blockIdx.x * NTHR + tid, NGT = gridDim.x * NTHR;
    for (int i = gt; i < (M / 64) * 2 * DFF; i += NGT) { const int c = i % DFF, bj = i / DFF, j = bj & 1, blk = bj >> 1;
        const bool first = (blk & (T / 64 - 1)) == 0;
        const float g2 = HG[(size_t)bj * DFF + c];
        const float t1 = first ? 0.f : TG[((size_t)(blk - 1) * 2 + 1) * DFF + c], t0 = first ? 0.f : TG[((size_t)(blk - 1) * 2) * DFF + c];
        const float g1 = j == 1 ? HG[((size_t)blk * 2) * DFF + c] : t1, g0 = j == 1 ? t1 : t0;
        const float x = cw[c] * g0 + cw[DFF + c] * g1 + cw[2 * DFF + c] * g2 + cb[c];
        H[(size_t)(blk * 64 + j) * DFF + c] = (bf16)f2bf(x * sigm(x) * HV[(size_t)bj * DFF + c]); }
}

constexpr int KS_PITCH = 144, VT_PITCH = 528, KS_BYTES = 256 * KS_PITCH;
__device__ __forceinline__ void p14_attn(const Args& a, LAS unsigned char* lds, int tid, int lane, int wave) {
    const CAS char* kp_ = kargs_ptr();
    const bf16* QKV = (const bf16*)(KWS + WS_QKV); bf16* O = (bf16*)(KWS + WS_O); const float* TAB = (const float*)(KWS + WS_ROPE);
    LAS unsigned char* Ks = lds; LAS unsigned char* Vt = lds + KS_BYTES;
    const int q = lane & 31, hi = lane >> 5;
    for (int u = blockIdx.x; u < BATCH * (T / 128) * 4; u += gridDim.x) {
        const int g = u & 3, qb = (u >> 2) & 63, b = u >> 8; const int tok0 = b * T + qb * 128;
        const int hq = g * 4 + (wave >> 1);
        v4u qcur[4];
        { const bf16* qp = QKV + (size_t)(tok0 + 64 * (wave & 1) + q) * QKVW + hq * 64 + 8 * hi;
#pragma unroll
          for (int ks = 0; ks < 4; ++ks) qcur[ks] = *(const v4u*)(qp + 16 * ks); }
        if (tid < 256) {
            const int kj = tid; const bool valid = (qb > 0) || (kj >= 128); const int token = tok0 - 128 + kj;
            float x[64];
            if (valid) { const v4u* src = (const v4u*)(QKV + (size_t)token * QKVW + 1024 + g * 64);
#pragma unroll
                for (int s = 0; s < 8; ++s) { const v4u w = src[s]; x[8 * s] = bflo(w.x); x[8 * s + 1] = bfhi(w.x); x[8 * s + 2] = bflo(w.y); x[8 * s + 3] = bfhi(w.y); x[8 * s + 4] = bflo(w.z); x[8 * s + 5] = bfhi(w.z); x[8 * s + 6] = bflo(w.w); x[8 * s + 7] = bfhi(w.w); }
                float ss = 0.f;
#pragma unroll
                for (int d = 0; d < 64; ++d) ss += x[d] * x[d];
                const float rstd = 1.0f / sqrtf(ss * (1.f / 64.f) + 1e-6f);
#pragma unroll
                for (int d = 0; d < 64; ++d) x[d] = x[d] * rstd * KIN(I_KNG)[d];
#pragma unroll
                for (int i = 0; i < 8; ++i) { const float cs = TAB[(size_t)token * 16 + i], sn = TAB[(size_t)token * 16 + 8 + i]; const float x1 = x[i], x2 = x[i + 8]; x[i] = x1 * cs - x2 * sn; x[i + 8] = x2 * cs + x1 * sn; }
            } else {
#pragma unroll
                for (int d = 0; d < 64; ++d) x[d] = 0.f;
            }
#pragma unroll
            for (int s = 0; s < 8; ++s) { v4u w; w.x = pk2(x[8 * s], x[8 * s + 1]); w.y = pk2(x[8 * s + 2], x[8 * s + 3]); w.z = pk2(x[8 * s + 4], x[8 * s + 5]); w.w = pk2(x[8 * s + 6], x[8 * s + 7]);
                *(LAS v4u*)(Ks + kj * KS_PITCH + s * 16) = w; }
        } else {
            const int tv = tid - 256;
#pragma unroll
            for (int rep = 0; rep < 4; ++rep) { const int item = tv + 256 * rep, kp = item >> 3, seg = item & 7; const int k0 = 2 * kp; const bool valid = (qb > 0) || (k0 >= 128);
                v4u w0 = {0, 0, 0, 0}, w1 = {0, 0, 0, 0};
                if (valid) { const size_t o = (size_t)(tok0 - 128 + k0) * QKVW + 1280 + g * 64 + seg * 8; w0 = *(const v4u*)(QKV + o); w1 = *(const v4u*)(QKV + o + QKVW); }
                const unsigned e0[4] = {w0.x, w0.y, w0.z, w0.w}, e1[4] = {w1.x, w1.y, w1.z, w1.w};
#pragma unroll
                for (int p = 0; p < 4; ++p) { const int d = seg * 8 + 2 * p;
                    *(LAS unsigned*)(Vt + d * VT_PITCH + k0 * 2) = (e0[p] & 0xffffu) | (e1[p] << 16);
                    *(LAS unsigned*)(Vt + (d + 1) * VT_PITCH + k0 * 2) = (e0[p] >> 16) | (e1[p] & 0xffff0000u); }
            }
        }
        __syncthreads();
        const float sink = KIN(I_SINK)[hq];
#pragma unroll 1
        for (int sb = 0; sb < 2; ++sb) {
            v4u qnext[4];
            { const bf16* qp = QKV + (size_t)(tok0 + 64 * (wave & 1) + 32 + q) * QKVW + hq * 64 + 8 * hi;
#pragma unroll
              for (int ks = 0; ks < 4; ++ks) qnext[ks] = *(const v4u*)(qp + 16 * ks); }
            const int qi0 = 64 * (wave & 1) + 32 * sb; const int token = tok0 + qi0 + q;
            float qv[4][8];
            { float ss = 0.f;
#pragma unroll
              for (int ks = 0; ks < 4; ++ks) { const v4u w = qcur[ks];
                  qv[ks][0] = bflo(w.x); qv[ks][1] = bfhi(w.x); qv[ks][2] = bflo(w.y); qv[ks][3] = bfhi(w.y); qv[ks][4] = bflo(w.z); qv[ks][5] = bfhi(w.z); qv[ks][6] = bflo(w.w); qv[ks][7] = bfhi(w.w);
#pragma unroll
                  for (int j = 0; j < 8; ++j) ss += qv[ks][j] * qv[ks][j]; }
              ss += __shfl_xor(ss, 32);
              const float rstd = 1.0f / sqrtf(ss * (1.f / 64.f) + 1e-6f);
#pragma unroll
              for (int ks = 0; ks < 4; ++ks)
#pragma unroll
                  for (int j = 0; j < 8; ++j) qv[ks][j] = qv[ks][j] * rstd * KIN(I_QNG)[16 * ks + 8 * hi + j];
#pragma unroll
              for (int j = 0; j < 8; ++j) { const float other = __shfl_xor(qv[0][j], 32); const float cs = TAB[(size_t)token * 16 + j], sn = TAB[(size_t)token * 16 + 8 + j];
                  qv[0][j] = hi == 0 ? qv[0][j] * cs - other * sn : qv[0][j] * cs + other * sn; }
            }
            bf16x8 qf[4];
#pragma unroll
            for (int ks = 0; ks < 4; ++ks) { v4u w; w.x = pk2(qv[ks][0] * 0.125f, qv[ks][1] * 0.125f); w.y = pk2(qv[ks][2] * 0.125f, qv[ks][3] * 0.125f); w.z = pk2(qv[ks][4] * 0.125f, qv[ks][5] * 0.125f); w.w = pk2(qv[ks][6] * 0.125f, qv[ks][7] * 0.125f);
                qf[ks] = __builtin_bit_cast(bf16x8, w); }
            const int kt0 = qi0 >> 5;
            f32x16 sc[5];
#pragma unroll
            for (int i = 0; i < 5; ++i) {
#pragma unroll
                for (int r = 0; r < 16; ++r) sc[i][r] = 0.f;
#pragma unroll
                for (int ks = 0; ks < 4; ++ks) { const bf16x8 kf = *(const LAS bf16x8*)(Ks + (32 * (kt0 + i) + q) * KS_PITCH + (16 * ks + 8 * hi) * 2);
                    sc[i] = __builtin_amdgcn_mfma_f32_32x32x16_bf16(kf, qf[ks], sc[i], 0, 0, 0); }
            }
            const int qi = qi0 + q; float mx = sink;
#pragma unroll
            for (int i = 0; i < 5; ++i)
#pragma unroll
                for (int r = 0; r < 16; ++r) { const int kj = 32 * (kt0 + i) + crow(r, hi); const int rel = qi + 128 - kj; const bool ok = (rel >= 0) && (rel < 128) && ((qb > 0) || (kj >= 128));
                    sc[i][r] = ok ? sc[i][r] : -INFINITY; mx = fmaxf(mx, sc[i][r]); }
            mx = fmaxf(mx, __shfl_xor(mx, 32));
            float sum = 0.f;
#pragma unroll
            for (int i = 0; i < 5; ++i)
#pragma unroll
                for (int r = 0; r < 16; ++r) { const float p = __expf(sc[i][r] - mx); sc[i][r] = p; sum += p; }
            sum += __shfl_xor(sum, 32);
            const float inv = 1.0f / (sum + __expf(sink - mx));
            f32x16 oa[2];
#pragma unroll
            for (int dt = 0; dt < 2; ++dt)
#pragma unroll
                for (int r = 0; r < 16; ++r) oa[dt][r] = 0.f;
#pragma unroll
            for (int i = 0; i < 5; ++i)
#pragma unroll
                for (int s2 = 0; s2 < 2; ++s2) { v4u pw; pw.x = pk2(sc[i][8 * s2], sc[i][8 * s2 + 1]); pw.y = pk2(sc[i][8 * s2 + 2], sc[i][8 * s2 + 3]); pw.z = pk2(sc[i][8 * s2 + 4], sc[i][8 * s2 + 5]); pw.w = pk2(sc[i][8 * s2 + 6], sc[i][8 * s2 + 7]);
                    const bf16x8 pb = __builtin_bit_cast(bf16x8, pw);
#pragma unroll
                    for (int dt = 0; dt < 2; ++dt) { const LAS unsigned char* vp = Vt + (q + 32 * dt) * VT_PITCH + (32 * (kt0 + i) + 16 * s2 + 4 * hi) * 2;
                        const v2u lo = *(const LAS v2u*)vp, hh = *(const LAS v2u*)(vp + 16); v4u vw; vw.x = lo.x; vw.y = lo.y; vw.z = hh.x; vw.w = hh.y;
                        oa[dt] = __builtin_amdgcn_mfma_f32_32x32x16_bf16(__builtin_bit_cast(bf16x8, vw), pb, oa[dt], 0, 0, 0); } }
            bf16* op = O + (size_t)token * 1024 + hq * 64 + 4 * hi;
#pragma unroll
            for (int dt = 0; dt < 2; ++dt)
#pragma unroll
                for (int rg = 0; rg < 4; ++rg) { v2u w; w.x = pk2(oa[dt][4 * rg] * inv, oa[dt][4 * rg + 1] * inv); w.y = pk2(oa[dt][4 * rg + 2] * inv, oa[dt][4 * rg + 3] * inv);
                    *(v2u*)(op + 32 * dt + 8 * rg) = w; }
#pragma unroll
            for (int ks = 0; ks < 4; ++ks) qcur[ks] = qnext[ks];
        }
        __syncthreads();
    }
}

__device__ __forceinline__ void p8_prep2(const Args& a, LAS unsigned char* lds, int lane, int wave, int vb, int nb) {
    const CAS char* kp_ = kargs_ptr();
    LAS float* scr = (LAS float*)(lds + wave * 16384);
    const int gw = vb * NWAVES + wave, NGW = nb * NWAVES;
    transpose_mat(KIN(I_WUP), D, UW, (bf16*)(KWS + WS_WUP0), scr, gw, NGW, lane, KIN(I_FNG), 1);
}
__device__ __forceinline__ void tail_g10(const Args& a, LAS unsigned char* lds, int lane, int wave, int vb, int nb) {
    const CAS char* kp_ = kargs_ptr();
    LAS float* scr = (LAS float*)(lds + wave * 16384);
    const int gw = vb * NWAVES + wave, NGW = nb * NWAVES;
    transpose_mat(KIN(I_WDN), DFF, D, (bf16*)(KWS + WS_WDN0), scr, gw, NGW, lane);
    transpose_mat(KIN(I_WQKV), D, QKVW, (bf16*)(KWS + WS_WQKV), scr, gw, NGW, lane, KIN(I_ATG));
    transpose_mat(KIN(I_WO), D, D, (bf16*)(KWS + WS_WO), scr, gw, NGW, lane);
}
__device__ __forceinline__ void tail_g14(const Args& a, LAS unsigned char* lds, int lane, int wave, int vb, int nb) {
    const CAS char* kp_ = kargs_ptr();
    LAS float* scr = (LAS float*)(lds + wave * 16384);
    const int gw = vb * NWAVES + wave, NGW = nb * NWAVES;
    transpose_mat(KIN(I_WUP) + (size_t)D * UW, D, UW, (bf16*)(KWS + WS_WUP1), scr, gw, NGW, lane, KIN(I_FNG) + D, 1);
    transpose_mat(KIN(I_WDN) + (size_t)DFF * D, DFF, D, (bf16*)(KWS + WS_WDN1), scr, gw, NGW, lane);
}
__device__ __forceinline__ void tail_g1(const Args& a, LAS unsigned char* lds, int tid, int lane, int wave, int vb, int nb) {
    const CAS char* kp_ = kargs_ptr();
    LAS float* scr = (LAS float*)(lds + wave * 16384);
    const int gw = vb * NWAVES + wave, NGW = nb * NWAVES, gt = vb * NTHR + tid, NGT = nb * NTHR;
    transpose_mat(KIN(I_WOUT), D, D, (bf16*)(KWS + WS_WOUT), scr, gw, NGW, lane);
    {
        bf16* WL = (bf16*)(KWS + WS_WL);
        for (int i = gt; i < LOW * LINW; i += NGT) { const int n = i >> 8, k = i & 255; float v = 0.f;
            if (n < 512) { if (k < 64) v = KIN(I_W2)[k * 512 + n]; }
            else if (n < 1024) { if (k >= 64 && k < 128) v = KIN(I_A2)[(k - 64) * 512 + (n - 512)]; }
            else { if (k >= 128) v = KIN(I_G2)[(k - 128) * 512 + (n - 1024)]; }
            WL[i] = (bf16)f2bf(v); }
    }
    { float* ssz = (float*)(KWS + WS_SS); for (int i = gt; i < 3 * M; i += NGT) ssz[i] = 0.f; }
    {
        float* tab = (float*)(KWS + WS_ROPE); const int* pos = (const int*)KIN(I_POS);
        for (int i = gt; i < M * 8; i += NGT) { const int m = i >> 3, f = i & 7;
            double inv;
            switch (f) { case 0: inv = 1.0; break; case 1: inv = 0.19392274474868576; break; case 2: inv = 0.03760603093086393; break; case 3: inv = 0.007292664737217109; break;
                         case 4: inv = 0.001414213562373095; break; case 5: inv = 0.0002742481756762073; break; case 6: inv = 5.318295896944988e-05; break; default: inv = 1.031338537721246e-05; break; }
            const double rev = (double)pos[m] * inv * 0.15915494309189535; const float fr = (float)(rev - __builtin_rint(rev));
            tab[m * 16 + f] = __builtin_amdgcn_cosf(fr); tab[m * 16 + 8 + f] = __builtin_amdgcn_sinf(fr); }
    }
}

#define XB_TMO      128
#define XB_XCNT(j)  (256  + 64 * (j))
#define XB_XSUB(j)  (1280 + 64 * (j))
#define XB_XGEN(j)  (2304 + 64 * (j))
#define XB_TOP      3328
#define XB_TOPGEN   3392
#define XCD_BAR_WORDS 3456
#define XB_SPIN_CAP (1u << 18)

__device__ __forceinline__ unsigned xb_ld(unsigned* p)              { return __hip_atomic_load(p, __ATOMIC_RELAXED, __HIP_MEMORY_SCOPE_AGENT); }
__device__ __forceinline__ unsigned xb_add(unsigned* p, unsigned v) { return __hip_atomic_fetch_add(p, v, __ATOMIC_RELAXED, __HIP_MEMORY_SCOPE_AGENT); }
__device__ __forceinline__ unsigned xb_xcc_id() { return (unsigned)__builtin_amdgcn_s_getreg((3 << 11) | 20) & 0xFu; }
#define XB_SPIN(cond, bar) do { unsigned _sp = 0; while (cond) { __builtin_amdgcn_s_sleep(1); \
    if ((++_sp & 255u) == 0u) { if (xb_ld(&(bar)[XB_TMO])) break; if (_sp > XB_SPIN_CAP) { atomicAdd(&(bar)[XB_TMO], 1u); break; } } } } while (0)

struct XcdBarrier {
    unsigned* bar; unsigned x;
    volatile LAS unsigned* st;
};

__device__ __forceinline__ XcdBarrier xcd_barrier_post(unsigned* bar, volatile LAS unsigned* st) {
    XcdBarrier b; b.bar = bar; b.x = xb_xcc_id(); b.st = st;
    if (threadIdx.x == 0) (void)xb_add(&bar[XB_XCNT(b.x)], 1u);
    return b;
}
__device__ __forceinline__ void xcd_barrier_complete(unsigned* bar, unsigned x, unsigned& nloc, unsigned& nx) {
    const unsigned G = gridDim.x * gridDim.y * gridDim.z;
    unsigned sum, cnt, mine, sp = 0u;
    for (;;) {
        sum = 0u; cnt = 0u; mine = 0u;
#pragma unroll
        for (unsigned j = 0; j < 16; ++j) { const unsigned c = xb_ld(&bar[XB_XCNT(j)]); sum += c; cnt += (c > 0u) ? 1u : 0u; mine = (j == x) ? c : mine; }
        if (sum == G) break;
        __builtin_amdgcn_s_sleep(1);
        if ((++sp & 255u) == 0u) { if (xb_ld(&bar[XB_TMO])) break; if (sp > XB_SPIN_CAP) { atomicAdd(&bar[XB_TMO], 1u); break; } }
    }
    nloc = mine > 0u ? mine : 1u; nx = cnt > 0u ? cnt : 1u;
}

__device__ __forceinline__ void xcd_barrier(const XcdBarrier& b) {
    asm volatile("s_waitcnt vmcnt(0)" ::: "memory");
    __syncthreads();
    if (threadIdx.x == 0) {
        unsigned* bar = b.bar;
        __builtin_amdgcn_s_waitcnt(0);
        unsigned nloc = b.st[0], nx = b.st[1];
        if (nloc == 0u) { xcd_barrier_complete(bar, b.x, nloc, nx); b.st[0] = nloc; b.st[1] = nx; }
        const unsigned old = xb_add(&bar[XB_XSUB(b.x)], 1u);
        const unsigned gen = old / nloc;
        if (old + 1u == (gen + 1u) * nloc) {
            __builtin_amdgcn_fence(__ATOMIC_RELEASE, "agent");
            asm volatile("s_waitcnt vmcnt(0)" ::: "memory");
            const unsigned og = xb_add(&bar[XB_TOP], 1u);
            const unsigned tg = og / nx;
            if (og + 1u == (tg + 1u) * nx) xb_add(&bar[XB_TOPGEN], 1u);
            else XB_SPIN(xb_ld(&bar[XB_TOPGEN]) == tg, bar);
            __builtin_amdgcn_fence(__ATOMIC_ACQUIRE, "agent");
            xb_add(&bar[XB_XGEN(b.x)], 1u);
            asm volatile("s_waitcnt vmcnt(0)" ::: "memory");
        } else {
            XB_SPIN(xb_ld(&bar[XB_XGEN(b.x)]) == gen, bar);
            __builtin_amdgcn_fence(__ATOMIC_ACQUIRE, "agent");
            asm volatile("s_waitcnt vmcnt(0)" ::: "memory");
        }
    }
    __syncthreads();
}

constexpr int NPHASE = 21;
__global__ void __launch_bounds__(NTHR, 2) fwd_kernel(Args a) {
    extern __shared__ __attribute__((aligned(16))) unsigned char lds_raw[];
    LAS unsigned char* lds = (LAS unsigned char*)lds_raw;
    cg::grid_group grid = cg::this_grid();
    const int tid = threadIdx.x, lane = tid & 63, wave = __builtin_amdgcn_readfirstlane(tid >> 6);
    const int G = gridDim.x, gw = blockIdx.x * NWAVES + wave, NGW = G * NWAVES;
    const int lo = a.ph_lo, hi = a.ph_hi;
    volatile LAS unsigned* MISC = (volatile LAS unsigned*)(lds + LDS_BYTES - 256);
    if (tid < 32) MISC[tid] = 0u;
    __syncthreads();
    XcdBarrier bar = xcd_barrier_post((unsigned*)a.ws, MISC + 8);
    if (hi < 0) grid.sync();
#define PH_BEGIN(k) if (lo <= (k) && (k) < hi) { const CAS char* kp_ = kargs_ptr(); unsigned char* const ws = KWS; (void)ws;
#define PH_END(k) if ((k) + 1 < hi) xcd_barrier(bar); }
#define GEMM_BF(k, Aptr, lda_, Bptr, N_, K_, O0, ld0, O1, ld1, split, bias, segw, segstride, ssp, tail_) PH_BEGIN(k) { pg8::Gemm g{(const bf16*)(Aptr), (const bf16*)(Bptr), M, N_, K_, lda_}; pg8::EpiBf16X e{(bf16*)(O0), ld0, (bf16*)(O1), ld1, split, bias, segw, segstride, ssp}; \
        pg8::StaticOrder S; S.init(M, N_, G, (int)blockIdx.x); pg8::gemm_phase<pg8::EpiBf16X, pg8::StaticOrder, true, true>(lds, g, S, e); { tail_; } } PH_END(k)
#define GEMM_GLU(k, Aptr, Bptr, layer, ssp, tail_) PH_BEGIN(k) { pg8::Gemm g{(const bf16*)(Aptr), (const bf16*)(Bptr), M, UW, D, D}; \
        pg8::EpiGlu e{(bf16*)(ws + WS_H), KIN(I_FCW) + (size_t)(layer) * 3 * DFF, KIN(I_FCB) + (size_t)(layer) * DFF, (float*)(ws + WS_HG), (float*)(ws + WS_HV), (float*)(ws + WS_TG), ssp}; \
        pg8::StaticOrder S; S.init(M, UW, G, (int)blockIdx.x); pg8::gemm_phase<pg8::EpiGlu, pg8::StaticOrder, true, true>(lds, g, S, e); { tail_; } } PH_END(k)
#define GEMM_RES(k, Aptr, lda_, Bptr, N_, K_, base, bias, xbp, ssp) PH_BEGIN(k) { pg8::Gemm g{(const bf16*)(Aptr), (const bf16*)(Bptr), M, N_, K_, lda_}; pg8::EpiRes e{base, KOUT, D, bias, (bf16*)(xbp), ssp}; \
        pg8::StaticOrder S; S.init(M, N_, G, (int)blockIdx.x); pg8::gemm_phase<pg8::EpiRes, pg8::StaticOrder, true, true>(lds, g, S, e); } PH_END(k)
    PH_BEGIN(0) p0_prologue(a, lds, tid, lane, wave); PH_END(0)
    GEMM_BF(1, ws + WS_XN1, D, ws + WS_WIN, ABIN, D, ws + WS_PC, 1024, (unsigned char*)KOUT + DO_PR, PRW, 1024, (const float*)(ws + WS_BIASP), PRW, 0, nullptr, if (G == 256 && blockIdx.x >= 192) tail_g1(a, lds, tid, lane, wave, (int)blockIdx.x - 192, 64); else if (G != 256) tail_g1(a, lds, tid, lane, wave, (int)blockIdx.x, G))
    PH_BEGIN(2) p2_prep(a, lds, tid, lane, wave); PH_END(2)
    GEMM_BF(3, ws + WS_LIN, LINW, ws + WS_WL, LOW, LINW, ws + WS_LOW, 512, ws + WS_LOW, 512, 0, nullptr, 512, (size_t)M * 512, nullptr, (void)0)
    PH_BEGIN(4) p4_rwkv_prep(a, lane, wave); PH_END(4)
    PH_BEGIN(5) scan_pass1(a, lds, lane, wave); PH_END(5)
    PH_BEGIN(6) comb_a(a, lds, tid, lane, wave); if (G == 256 && blockIdx.x >= 128) p8_prep2(a, lds, lane, wave, (int)blockIdx.x - 128, 128); else if (G != 256) p8_prep2(a, lds, lane, wave, (int)blockIdx.x, G); PH_END(6)
    PH_BEGIN(6) comb_b(a, lds, tid, lane, wave); PH_END(6)
    PH_BEGIN(6) comb_c(a, lds, tid, lane, wave); PH_END(6)
    PH_BEGIN(7) scan_pass2(a, lds, lane, wave); PH_END(7)
    GEMM_RES(8, ws + WS_CAT, D, ws + WS_WOUT, D, D, KIN(I_X), nullptr, ws + WS_XB, (float*)(ws + WS_SS))
    GEMM_GLU(10, ws + WS_XB, ws + WS_WUP0, 0, (float*)(ws + WS_SS), if (G == 256 && blockIdx.x >= 128) tail_g10(a, lds, lane, wave, (int)blockIdx.x - 128, 128); else if (G != 256) tail_g10(a, lds, lane, wave, (int)blockIdx.x, G))
    PH_BEGIN(11) glu_fixup(a, 0, tid); PH_END(11)
    GEMM_RES(12, ws + WS_H, DFF, ws + WS_WDN0, D, DFF, KOUT, nullptr, ws + WS_XB, (float*)(ws + WS_SS) + M)
    GEMM_BF(14, ws + WS_XB, D, ws + WS_WQKV, QKVW, D, ws + WS_QKV, QKVW, ws + WS_QKV, QKVW, 1 << 30, KIN(I_BQKV), 256, 0, (float*)(ws + WS_SS) + M, if (G == 256 && blockIdx.x >= 128) tail_g14(a, lds, lane, wave, (int)blockIdx.x - 128, 128); else if (G != 256) tail_g14(a, lds, lane, wave, (int)blockIdx.x, G))
    PH_BEGIN(15) p14_attn(a, lds, tid, lane, wave); PH_END(15)
    GEMM_RES(16, ws + WS_O, D, ws + WS_WO, D, D, KOUT, KIN(I_BO), ws + WS_XB, (float*)(ws + WS_SS) + 2 * M)
    GEMM_GLU(18, ws + WS_XB, ws + WS_WUP1, 1, (float*)(ws + WS_SS) + 2 * M, (void)0)
    PH_BEGIN(19) glu_fixup(a, 1, tid); PH_END(19)
    GEMM_RES(20, ws + WS_H, DFF, ws + WS_WDN1, D, DFF, KOUT, nullptr, nullptr, nullptr)
}

#ifndef N_LAUNCH_MODE
#define N_LAUNCH_MODE 1
#endif
extern "C" void kernel_launch(void* const* d_in, const int* in_sizes, int n_in, void* d_out, int out_size, void* d_ws, size_t ws_size, hipStream_t stream) {
    static int grid = 0;
    if (grid == 0) {
        if (n_in != 34 || out_size != M * D || ws_size < WS_END) { fprintf(stderr, "kernel_launch: unexpected shapes n_in %d out %d ws %zu\n", n_in, out_size, ws_size); grid = -1; return; }
        int dev = 0, cus = 0, per_cu = 0;
        hipGetDevice(&dev); hipDeviceGetAttribute(&cus, hipDeviceAttributeMultiprocessorCount, dev);
        if (hipFuncSetAttribute((const void*)fwd_kernel, hipFuncAttributeMaxDynamicSharedMemorySize, LDS_BYTES) != hipSuccess) { fprintf(stderr, "kernel_launch: hipFuncSetAttribute failed\n"); grid = -1; return; }
        if (hipOccupancyMaxActiveBlocksPerMultiprocessor(&per_cu, (const void*)fwd_kernel, NTHR, LDS_BYTES) != hipSuccess || per_cu < 1) { fprintf(stderr, "kernel_launch: occupancy query says %d\n", per_cu); per_cu = 1; }
        (void)hipGetLastError();
        grid = cus * 1;
    }
    if (grid < 0) return;
    if (hipMemsetAsync(d_ws, 0, 16384, stream) != hipSuccess) { fprintf(stderr, "kernel_launch: memset of the barrier words failed\n"); return; }
    Args a{};
    for (int i = 0; i < 34; ++i) a.in[i] = (const float*)d_in[i];
    a.out = (float*)d_out; a.ws = (unsigned char*)d_ws;
#if N_LAUNCH_MODE == 1
    a.ph_lo = 0; a.ph_hi = NPHASE;
    { void* args[] = {&a}; hipError_t e = hipLaunchCooperativeKernel((const void*)fwd_kernel, dim3(grid), dim3(NTHR), args, LDS_BYTES, stream);
      if (e != hipSuccess) fprintf(stderr, "cooperative launch failed: %s (grid %d)\n", hipGetErrorString(e), grid); }
#else
    for (int ph = 0; ph < NPHASE; ++ph) { a.ph_lo = ph; a.ph_hi = ph + 1; void* args[] = {&a};
        hipError_t e = hipLaunchCooperativeKernel((const void*)fwd_kernel, dim3(grid), dim3(NTHR), args, LDS_BYTES, stream);
        if (e != hipSuccess) { fprintf(stderr, "launch %d failed: %s\n", ph, hipGetErrorString(e)); break; } }
#endif
}
```

```cpp
#include <hip/hip_runtime.h>
#include <hip/hip_cooperative_groups.h>
#include <cstdio>
#include <cstdint>
namespace cg = cooperative_groups;
namespace pg8 {
#define PG8_LAS __attribute__((address_space(3)))
typedef unsigned short bf16_t;
typedef short bf16x8 __attribute__((ext_vector_type(8)));
typedef float f32x4 __attribute__((ext_vector_type(4)));
typedef unsigned u32x4 __attribute__((ext_vector_type(4)));
constexpr int BM = 256, BK = 64, HALF = 128, HTB = HALF * BK * 2  , STAGE_BYTES = 8 * HTB, NXCD = 8, WGM = 8;

__host__ __device__ __forceinline__ int lds_byte(int r, int c) { const int st = (r >> 4) * 2 + (c >> 5), rr = r & 15, cc = c & 31, ob = rr * 64 + cc * 2; return st * 1024 + (ob ^ (((ob >> 9) & 1) << 5)); }
__host__ __device__ __forceinline__ void stage_rc(int b, int& R, int& C) { const int st = b / 1024, sb = b % 1024, swz = sb ^ (((sb >> 9) & 1) << 5); R = (st >> 1) * 16 + swz / 64; C = (st & 1) * 32 + (swz % 64) / 2; }
__host__ __device__ __forceinline__ int perm32(int rho) { const int n = rho >> 4, i = rho & 15; return 8 * (i >> 2) + 4 * n + (i & 3); }

struct Unit { int pm, pn; };
struct Gemm { const bf16_t* A; const bf16_t* Bt; int M, N, K, lda; };

struct StaticOrder {
    int nM, nN, nwg, G, c;
    __host__ __device__ void init(int M, int N, int G_, int c_) { nM = M / BM; nN = N / BM; nwg = nM * nN; G = G_; c = c_; }
    __host__ __device__ bool next(int i, Unit& u) const {
        const long L = (long)i * G + c; if (L >= nwg) return false;
        int wgid = (int)L; { const int q = nwg / NXCD, r = nwg % NXCD, xcd = wgid % NXCD, off = wgid / NXCD; wgid = (xcd < r ? xcd * (q + 1) : r * (q + 1) + (xcd - r) * q) + off; }
        const int nig = WGM * nN, gid = wgid / nig, fm = gid * WGM, gsz = (nM - fm) < WGM ? (nM - fm) : WGM;
        u.pm = fm + ((wgid % nig) % gsz); u.pn = (wgid % nig) / gsz; return true;
    }
    __device__ __forceinline__ void a_ready(const Unit&) const {}
    __device__ __forceinline__ void done(const Unit&) const {}
};

__device__ __forceinline__ unsigned cvt_pk_bf16(float lo, float hi) { unsigned r; asm volatile("v_cvt_pk_bf16_f32 %0, %1, %2" : "=v"(r) : "v"(lo), "v"(hi)); return r; }
typedef float f32x2 __attribute__((ext_vector_type(2)));

template <class Epi, class Sched, bool ALIGN_EPI = false, bool SP2 = false>
__device__ __forceinline__ void gemm_phase(PG8_LAS unsigned char* lds, const Gemm g, const Sched& S, const Epi& E) {
    const int tid = threadIdx.x, wid = __builtin_amdgcn_readfirstlane(tid >> 6), lane = tid & 63, wr = wid >> 2, wc = wid & 3, fr = lane & 15, fq = lane >> 4;
    const int K = g.K, nt = K / BK;
    unsigned voffA[2], voffB[2];
#pragma unroll
    for (int i = 0; i < 2; ++i) { int R, C; stage_rc(tid * 16 + i * 8192, R, C); const int Rb = Epi::PERM ? ((R & ~31) + perm32(R & 31)) : R;
        voffA[i] = (unsigned)(R * g.lda + C) * 2u; voffB[i] = (unsigned)(Rb * K + C) * 2u; }
    const size_t kstep = (size_t)(BK * 2);
    const size_t hstep = (size_t)HALF * K * 2;
    const size_t tstep = 2 * hstep; const size_t hstepA = (size_t)HALF * g.lda * 2, tstepA = 2 * hstepA;
    const unsigned ldsw = (unsigned)wid * 1024u;
    const int aoff = lds_byte(wr * 64 + fr, fq * 8), boff = lds_byte(wc * 32 + fr, fq * 8);
#define PG8_SA(b, h) (((b) * 2 + (h)) * HTB)
#define PG8_SB(b, h) ((4 + (b) * 2 + (h)) * HTB)
#define PG8_STAGE(bufoff, gbase, voff) do { _Pragma("unroll") for (int _i = 0; _i < 2; ++_i) \
        __builtin_amdgcn_global_load_lds((const unsigned*)((const char*)(gbase) + (voff)[_i]), (PG8_LAS unsigned*)(lds + (bufoff) + ldsw + _i * 8192), 16, 0, 0); } while (0)
#define PG8_LDA(dst, b, h) do { _Pragma("unroll") for (int m = 0; m < 4; ++m) _Pragma("unroll") for (int k = 0; k < 2; ++k) dst[m][k] = *(const PG8_LAS bf16x8*)(lds + PG8_SA(b, h) + aoff + m * 2048 + k * 1024); } while (0)
#define PG8_LDB(dst, b, h) do { _Pragma("unroll") for (int n = 0; n < 2; ++n) _Pragma("unroll") for (int k = 0; k < 2; ++k) dst[n][k] = *(const PG8_LAS bf16x8*)(lds + PG8_SB(b, h) + boff + n * 2048 + k * 1024); } while (0)
#define PG8_MMA(ai, bj, At, Bt) do { __builtin_amdgcn_s_setprio(1); _Pragma("unroll") for (int m = 0; m < 4; ++m) _Pragma("unroll") for (int n = 0; n < 2; ++n) _Pragma("unroll") for (int k = 0; k < 2; ++k) \
        acc[ai][bj][m][n] = __builtin_amdgcn_mfma_f32_16x16x32_bf16(Bt[n][k], At[m][k], acc[ai][bj][m][n], 0, 0, 0); __builtin_amdgcn_s_setprio(0); } while (0)
#define PG8_WAIT_V(n) asm volatile("s_waitcnt vmcnt(" #n ")" ::: "memory")
#define PG8_WAIT_L(n) asm volatile("s_waitcnt lgkmcnt(" #n ")" ::: "memory")
#define PG8_BAR __builtin_amdgcn_s_barrier()
#define PG8_SCHED __builtin_amdgcn_sched_barrier(0)
    Unit cur, nxt; int ui = 0;
    if (!S.next(0, cur)) return;
    f32x4 acc[2][2][4][2];
#pragma unroll
    for (int a = 0; a < 2; ++a)
#pragma unroll
        for (int b = 0; b < 2; ++b)
#pragma unroll
            for (int m = 0; m < 4; ++m)
#pragma unroll
                for (int n = 0; n < 2; ++n) acc[a][b][m][n] = (f32x4){0.f, 0.f, 0.f, 0.f};
    bf16x8 At[4][2], B0[2][2], B1[2][2];
    const char* cA = (const char*)g.A + (size_t)cur.pm * tstepA; const char* cB = (const char*)g.Bt + (size_t)cur.pn * tstep;
    S.a_ready(cur);
    if constexpr (SP2) {
        PG8_STAGE(PG8_SB(0, 0), cB, voffB); PG8_STAGE(PG8_SB(0, 1), cB + hstep, voffB); PG8_STAGE(PG8_SA(0, 0), cA, voffA); PG8_STAGE(PG8_SA(0, 1), cA + hstepA, voffA);
        if (wr == 1) PG8_BAR;
        PG8_WAIT_V(2); PG8_BAR;
        PG8_STAGE(PG8_SB(1, 0), cB + kstep, voffB); PG8_STAGE(PG8_SA(1, 0), cA + kstep, voffA); PG8_STAGE(PG8_SB(1, 1), cB + hstep + kstep, voffB);
        PG8_WAIT_V(6); PG8_BAR;
    } else {
        PG8_STAGE(PG8_SB(0, 0), cB, voffB); PG8_STAGE(PG8_SA(0, 0), cA, voffA); PG8_STAGE(PG8_SB(0, 1), cB + hstep, voffB); PG8_STAGE(PG8_SA(0, 1), cA + hstepA, voffA);
        if (wr == 1) PG8_BAR;
        PG8_WAIT_V(4); PG8_BAR;
        PG8_STAGE(PG8_SB(1, 0), cB + kstep, voffB); PG8_STAGE(PG8_SA(1, 0), cA + kstep, voffA); PG8_STAGE(PG8_SB(1, 1), cB + hstep + kstep, voffB);
        PG8_WAIT_V(6); PG8_BAR;
    }
    for (;;) {
        const bool has_next = S.next(ui + 1, nxt);
        const char* nA = has_next ? (const char*)g.A + (size_t)nxt.pm * tstepA : cA; const char* nB = has_next ? (const char*)g.Bt + (size_t)nxt.pn * tstep : cB;
        for (int t = 0; t < nt; t += 2) {
            const bool last = (t == nt - 2);
            const char* a1 = cA + (size_t)(t + 1) * kstep;
            const char* a2 = last ? nA : cA + (size_t)(t + 2) * kstep; const char* b2 = last ? nB : cB + (size_t)(t + 2) * kstep;
            const char* a3 = a2 + kstep; const char* b3 = b2 + kstep;
            if (last && has_next) S.a_ready(nxt);
            if constexpr (SP2) {
            PG8_LDB(B0, 0, 0); PG8_LDB(B1, 0, 1); PG8_SCHED; PG8_LDA(At, 0, 0); PG8_STAGE(PG8_SA(1, 1), a1 + hstepA, voffA);
            PG8_WAIT_V(8); PG8_WAIT_L(0); PG8_BAR; PG8_MMA(0, 0, At, B0); PG8_MMA(0, 1, At, B1); PG8_BAR; PG8_SCHED;
            PG8_LDA(At, 0, 1); PG8_STAGE(PG8_SB(0, 0), b2, voffB); PG8_STAGE(PG8_SB(0, 1), b2 + hstep, voffB); PG8_STAGE(PG8_SA(0, 0), a2, voffA);
            PG8_WAIT_V(8); PG8_WAIT_L(0); PG8_BAR; PG8_MMA(1, 0, At, B0); PG8_MMA(1, 1, At, B1); PG8_BAR; PG8_SCHED;
            PG8_LDB(B0, 1, 0); PG8_LDB(B1, 1, 1); PG8_SCHED; PG8_LDA(At, 1, 0); PG8_STAGE(PG8_SA(0, 1), a2 + hstepA, voffA);
            PG8_WAIT_V(8); PG8_WAIT_L(0); PG8_BAR; PG8_MMA(0, 0, At, B0); PG8_MMA(0, 1, At, B1); PG8_BAR; PG8_SCHED;
            PG8_LDA(At, 1, 1); PG8_STAGE(PG8_SB(1, 0), b3, voffB); PG8_STAGE(PG8_SB(1, 1), b3 + hstep, voffB); PG8_STAGE(PG8_SA(1, 0), a3, voffA);
            PG8_WAIT_V(8); PG8_WAIT_L(0); PG8_BAR; PG8_MMA(1, 0, At, B0); PG8_MMA(1, 1, At, B1); PG8_BAR; PG8_SCHED;
            } else {
            PG8_LDB(B0, 0, 0); PG8_SCHED; PG8_LDA(At, 0, 0); PG8_STAGE(PG8_SA(1, 1), a1 + hstepA, voffA);
            PG8_WAIT_L(8); PG8_BAR; PG8_WAIT_L(0); PG8_MMA(0, 0, At, B0); PG8_BAR; PG8_SCHED;
            PG8_LDB(B1, 0, 1); PG8_STAGE(PG8_SB(0, 0), b2, voffB);
            PG8_BAR; PG8_WAIT_L(0); PG8_MMA(0, 1, At, B1); PG8_BAR;
            PG8_LDA(At, 0, 1); PG8_STAGE(PG8_SA(0, 0), a2, voffA);
            PG8_BAR; PG8_WAIT_L(0); PG8_MMA(1, 0, At, B0); PG8_BAR; PG8_SCHED;
            PG8_STAGE(PG8_SB(0, 1), b2 + hstep, voffB);
            PG8_WAIT_V(6); PG8_BAR; PG8_MMA(1, 1, At, B1); PG8_BAR;
            PG8_LDB(B0, 1, 0); PG8_SCHED; PG8_LDA(At, 1, 0); PG8_STAGE(PG8_SA(0, 1), a2 + hstepA, voffA);
            PG8_WAIT_L(8); PG8_BAR; PG8_WAIT_L(0); PG8_MMA(0, 0, At, B0); PG8_BAR; PG8_SCHED;
            PG8_LDB(B1, 1, 1); PG8_STAGE(PG8_SB(1, 0), b3, voffB);
            PG8_BAR; PG8_WAIT_L(0); PG8_MMA(0, 1, At, B1); PG8_BAR;
            PG8_LDA(At, 1, 1); PG8_STAGE(PG8_SA(1, 0), a3, voffA);
            PG8_BAR; PG8_WAIT_L(0); PG8_MMA(1, 0, At, B0); PG8_BAR; PG8_SCHED;
            PG8_STAGE(PG8_SB(1, 1), b3 + hstep, voffB);
            PG8_WAIT_V(6); PG8_BAR; PG8_MMA(1, 1, At, B1); PG8_BAR;
            }
        }
        if constexpr (ALIGN_EPI) { if (wr == 0) PG8_BAR; }
        if constexpr (!Epi::AFTER_DRAIN) { E(acc, cur, wr, wc, fr, fq); S.done(cur); }
        if (!has_next) break;
#pragma unroll
        for (int a = 0; a < 2; ++a)
#pragma unroll
            for (int b = 0; b < 2; ++b)
#pragma unroll
                for (int m = 0; m < 4; ++m)
#pragma unroll
                    for (int n = 0; n < 2; ++n) acc[a][b][m][n] = (f32x4){0.f, 0.f, 0.f, 0.f};
        cur = nxt; cA = nA; cB = nB; ++ui;
        if constexpr (ALIGN_EPI) { if (wr == 1) PG8_BAR; }
    }
    PG8_WAIT_V(0);
    if constexpr (!ALIGN_EPI) { if (wr == 0) PG8_BAR; }
    PG8_BAR;
    if constexpr (Epi::AFTER_DRAIN) { E.fused(acc, cur, wr, wc, fr, fq, lds, wid, lane); S.done(cur); }
#undef PG8_SA
#undef PG8_SB
#undef PG8_STAGE
#undef PG8_LDA
#undef PG8_LDB
#undef PG8_MMA
#undef PG8_WAIT_V
#undef PG8_WAIT_L
#undef PG8_BAR
#undef PG8_SCHED
}
}

namespace pg8 {
struct EpiBf16X {
    static constexpr bool PERM = true, AFTER_DRAIN = false;
    bf16_t* O0; int ld0; bf16_t* O1; int ld1; int split; const float* bias; int segw; size_t segstride; const float* ss;
    __device__ __forceinline__ void operator()(const f32x4 (&acc)[2][2][4][2], const Unit& u, int wr, int wc, int fr, int fq) const {
        const int row0 = u.pm * BM + wr * 64 + fr; const int colt = u.pn * BM;
        bf16_t* base; int ldc, cb;
        if (colt < split) { base = O0; ldc = ld0; cb = colt; } else { const int rel = colt - split, sg = rel / segw; base = O1 + (size_t)sg * segstride; ldc = ld1; cb = rel - sg * segw; }
        const int col0 = cb + wc * 32 + 8 * fq, bcol0 = colt + wc * 32 + 8 * fq;
        f32x4 bv[2][2];
#pragma unroll
        for (int bj = 0; bj < 2; ++bj)
#pragma unroll
            for (int n = 0; n < 2; ++n) bv[bj][n] = bias ? *(const f32x4*)(bias + bcol0 + bj * HALF + 4 * n) : (f32x4){0.f, 0.f, 0.f, 0.f};
#pragma unroll
        for (int ai = 0; ai < 2; ++ai)
#pragma unroll
            for (int m = 0; m < 4; ++m) { bf16_t* rowp = base + (size_t)(row0 + ai * HALF + m * 16) * ldc + col0;
                const float rs = ss ? __builtin_amdgcn_rsqf(ss[row0 + ai * HALF + m * 16] * (1.f / 1024.f) + 1e-6f) : 1.f;
#pragma unroll
                for (int bj = 0; bj < 2; ++bj) { const f32x4 v0 = acc[ai][bj][m][0] * rs + bv[bj][0], v1 = acc[ai][bj][m][1] * rs + bv[bj][1];
                    u32x4 w; w.x = cvt_pk_bf16(v0[0], v0[1]); w.y = cvt_pk_bf16(v0[2], v0[3]); w.z = cvt_pk_bf16(v1[0], v1[1]); w.w = cvt_pk_bf16(v1[2], v1[3]);
                    *(u32x4*)(rowp + bj * HALF) = w; } }
    }
};
struct EpiRes {
    static constexpr bool PERM = false, AFTER_DRAIN = false;
    const float* base; float* out; int ldc; const float* bias; bf16_t* xb; float* ss;
    __device__ __forceinline__ void operator()(const f32x4 (&acc)[2][2][4][2], const Unit& u, int wr, int wc, int fr, int fq) const {
        const int col0 = u.pn * BM + wc * 32 + 4 * fq;
        f32x4 bv[2][2];
#pragma unroll
        for (int bj = 0; bj < 2; ++bj)
#pragma unroll
            for (int n = 0; n < 2; ++n) bv[bj][n] = bias ? *(const f32x4*)(bias + col0 + bj * HALF + n * 16) : (f32x4){0.f, 0.f, 0.f, 0.f};
#pragma unroll
        for (int ai = 0; ai < 2; ++ai)
#pragma unroll
            for (int m = 0; m < 4; ++m) { const int row = u.pm * BM + ai * HALF + wr * 64 + m * 16 + fr; const size_t off = (size_t)row * ldc + col0; float sq = 0.f;
#pragma unroll
                for (int bj = 0; bj < 2; ++bj)
#pragma unroll
                    for (int n = 0; n < 2; ++n) { const size_t o = off + bj * HALF + n * 16; const f32x4 bs = *(const f32x4*)(base + o);
                        const f32x4 v = bs + acc[ai][bj][m][n] + bv[bj][n]; *(f32x4*)(out + o) = v;
                        if (xb) { sq += (v[0] * v[0] + v[1] * v[1]) + (v[2] * v[2] + v[3] * v[3]);
                            typedef unsigned u32x2_ __attribute__((ext_vector_type(2))); u32x2_ w; w.x = cvt_pk_bf16(v[0], v[1]); w.y = cvt_pk_bf16(v[2], v[3]); *(u32x2_*)(xb + o) = w; } }
                if (xb) { sq += __shfl_xor(sq, 16); sq += __shfl_xor(sq, 32); if (fq == 0) atomicAdd(ss + row, sq); } }
    }
};
struct EpiGlu {
    static constexpr bool PERM = true, AFTER_DRAIN = false;
    bf16_t* H; const float* cw; const float* cb; float* HG; float* HV; float* TG; const float* ss;
    __device__ __forceinline__ void operator()(const f32x4 (&acc)[2][2][4][2], const Unit& u, int wr, int wc, int fr, int fq) const {
        constexpr int DFF_ = 2816;
        const int gc0 = u.pn * 128 + wc * 32 + 8 * fq;
        float w0[8], w1[8], w2[8], bb[8];
#pragma unroll
        for (int h = 0; h < 2; ++h) { const f32x4 a0 = *(const f32x4*)(cw + gc0 + 4 * h), a1 = *(const f32x4*)(cw + DFF_ + gc0 + 4 * h), a2 = *(const f32x4*)(cw + 2 * DFF_ + gc0 + 4 * h), a3 = *(const f32x4*)(cb + gc0 + 4 * h);
#pragma unroll
            for (int e = 0; e < 4; ++e) { w0[4 * h + e] = a0[e]; w1[4 * h + e] = a1[e]; w2[4 * h + e] = a2[e]; bb[4 * h + e] = a3[e]; } }
        const int l1 = (fq << 4) | ((fr + 15) & 15), l2 = (fq << 4) | ((fr + 14) & 15);
#pragma unroll
        for (int ai = 0; ai < 2; ++ai) {
            const int rbase = u.pm * BM + ai * HALF + wr * 64; const int blk = rbase >> 6;
            float rs[4];
#pragma unroll
            for (int m = 0; m < 4; ++m) rs[m] = __builtin_amdgcn_rsqf(ss[rbase + m * 16 + fr] * (1.f / 1024.f) + 1e-6f);
#pragma unroll
            for (int m = 0; m < 4; ++m) {
                float g[8], gp[8], vl[8], o[8];
#pragma unroll
                for (int n = 0; n < 2; ++n)
#pragma unroll
                    for (int e = 0; e < 4; ++e) { g[4 * n + e] = acc[ai][0][m][n][e] * rs[m]; vl[4 * n + e] = acc[ai][1][m][n][e] * rs[m]; gp[4 * n + e] = m > 0 ? acc[ai][0][m - 1][n][e] * rs[m - 1] : 0.f; }
#pragma unroll
                for (int e = 0; e < 8; ++e) { const float s1 = fr == 15 ? gp[e] : g[e], s2 = fr >= 14 ? gp[e] : g[e];
                    const float p1 = __shfl(s1, l1), p2 = __shfl(s2, l2);
                    const float x = w0[e] * p2 + w1[e] * p1 + w2[e] * g[e] + bb[e];
                    o[e] = x * __builtin_amdgcn_rcpf(1.f + __expf(-x)) * vl[e]; }
                const int row = rbase + m * 16 + fr;
                if (m == 0 && fr < 2) {
                    float* hg = HG + ((size_t)blk * 2 + fr) * DFF_ + gc0; float* hv = HV + ((size_t)blk * 2 + fr) * DFF_ + gc0;
                    *(f32x4*)hg = (f32x4){g[0], g[1], g[2], g[3]}; *(f32x4*)(hg + 4) = (f32x4){g[4], g[5], g[6], g[7]};
                    *(f32x4*)hv = (f32x4){vl[0], vl[1], vl[2], vl[3]}; *(f32x4*)(hv + 4) = (f32x4){vl[4], vl[5], vl[6], vl[7]};
                } else {
                    u32x4 w; w.x = cvt_pk_bf16(o[0], o[1]); w.y = cvt_pk_bf16(o[2], o[3]); w.z = cvt_pk_bf16(o[4], o[5]); w.w = cvt_pk_bf16(o[6], o[7]);
                    *(u32x4*)(H + (size_t)row * DFF_ + gc0) = w;
                }
                if (m == 3 && fr >= 14) { float* tg = TG + ((size_t)blk * 2 + (fr - 14)) * DFF_ + gc0;
                    *(f32x4*)tg = (f32x4){g[0], g[1], g[2], g[3]}; *(f32x4*)(tg + 4) = (f32x4){g[4], g[5], g[6], g[7]}; }
            }
        }
    }
};
}

constexpr int NWAVES = 8, NTHR = 512;
constexpr int BATCH = 2, T = 8192, D = 1024, M = BATCH * T;
constexpr int ABIN = 2816, PRW = 1792, DFF = 2816, UW = 5632, QKVW = 1536, LOW = 1536, LINW = 256, NH = 8;
constexpr size_t MiB = 1u << 20;
constexpr size_t WS_BON = 1 * MiB, WS_BIASP = 1 * MiB + 768 * 1024;
constexpr size_t WS_WIN = 2 * MiB, WS_WL = 8 * MiB, WS_WOUT = 254 * MiB, WS_LOW = 13 * MiB, WS_LOA = 29 * MiB, WS_LOG = 45 * MiB, WS_ST = 13 * MiB, WS_CAT = 61 * MiB, WS_SEQ = 93 * MiB;
constexpr size_t WS_XN1 = 93 * MiB, WS_PC = 125 * MiB, WS_LIN = 157 * MiB;
constexpr size_t WS_ROPE = 253 * MiB;
constexpr size_t DO_PR = 0, DO_ST = 56 * MiB;
constexpr size_t WS_WUP0 = 2 * MiB, WS_WDN0 = 13 * MiB, WS_WQKV = 19 * MiB, WS_WO = 22 * MiB, WS_WUP1 = 24 * MiB, WS_WDN1 = 35 * MiB;
constexpr size_t WS_H = 41 * MiB, WS_HG = 130 * MiB, WS_HV = 136 * MiB, WS_TG = 142 * MiB, WS_QKV = 41 * MiB, WS_O = 89 * MiB, WS_XB = 219 * MiB, WS_END = 256 * MiB;
constexpr size_t WS_SS = 1 * MiB + 512 * 1024;
constexpr int LDS_BYTES = 147456;

#define LAS __attribute__((address_space(3)))
typedef unsigned short bf16;
typedef float f32x4 __attribute__((ext_vector_type(4)));
typedef unsigned v4u __attribute__((ext_vector_type(4)));
typedef unsigned v2u __attribute__((ext_vector_type(2)));
typedef short bf16x8 __attribute__((ext_vector_type(8)));
typedef float f32x16 __attribute__((ext_vector_type(16)));
typedef float f32x2 __attribute__((ext_vector_type(2)));
#define LDS_WAIT() asm volatile("s_waitcnt lgkmcnt(0)" ::: "memory")

typedef __bf16 bf16x2_hw __attribute__((ext_vector_type(2)));
__device__ __forceinline__ unsigned pk2(float lo, float hi) { const f32x2 v = {lo, hi}; return __builtin_bit_cast(unsigned, __builtin_convertvector(v, bf16x2_hw)); }
__device__ __forceinline__ unsigned f2bf(float f) { return pk2(f, 0.f) & 0xffffu; }
__device__ __forceinline__ float bf2f(unsigned h) { return __builtin_bit_cast(float, h << 16); }
__device__ __forceinline__ float bflo(unsigned w) { return __builtin_bit_cast(float, w << 16); }
__device__ __forceinline__ float bfhi(unsigned w) { return __builtin_bit_cast(float, w & 0xffff0000u); }
__device__ __forceinline__ float wave_sum(float v) {
#pragma unroll
    for (int o = 1; o < 64; o <<= 1) v += __shfl_xor(v, o);
    return v;
}
__device__ __forceinline__ float sigm(float x) { return __builtin_amdgcn_rcpf(1.f + __expf(-x)); }
__device__ __forceinline__ float tanh_fast(float x) { return 1.f - 2.f * __builtin_amdgcn_rcpf(__expf(2.f * x) + 1.f); }

struct Args { const float* in[34]; float* out; unsigned char* ws; int ph_lo, ph_hi; };
#define CAS __attribute__((address_space(4)))
__device__ __forceinline__ const CAS char* kargs_ptr() { const CAS char* kp = (const CAS char*)__builtin_amdgcn_kernarg_segment_ptr(); asm volatile("" : "+s"(kp)); return kp; }
#define KIN(i) (*(const float* const CAS*)(kp_ + 8 * (i)))
#define KOUT (*(float* const CAS*)(kp_ + 8 * 34))
#define KWS (*(unsigned char* const CAS*)(kp_ + 8 * 35))
enum { I_X = 0, I_POS, I_ABG, I_WIN, I_CINB, I_DWW, I_DWB, I_CLNG, I_CLNB, I_MU, I_W0, I_W2, I_A0, I_A2, I_G2, I_KK, I_KA, I_RK, I_RLNG, I_RLNB, I_WOUT,
       I_ATG, I_WQKV, I_BQKV, I_QNG, I_KNG, I_SINK, I_WO, I_BO, I_FNG, I_WUP, I_FCW, I_FCB, I_WDN };

__device__ __forceinline__ void transpose_item(const float* W, int K, int N, bf16* WT, LAS float* scr, int item, int lane, const float* gain, int glu) {
    const int nblk = N / 32, kb = item / nblk, nb = item % nblk, k0 = 64 * kb, n0 = 32 * nb;
#pragma unroll 8
    for (int i = 0; i < 32; ++i) { const int kk = 2 * i + (lane >> 5); const float gk = gain ? gain[k0 + kk] : 1.f; scr[kk * 33 + (lane & 31)] = W[(size_t)(k0 + kk) * N + n0 + (lane & 31)] * gk; }
    LDS_WAIT(); asm volatile("" ::: "memory");
    const int c = lane & 7;
#pragma unroll
    for (int j = 0; j < 4; ++j) { const int n = (lane >> 3) + 8 * j; const LAS float* s = scr + (8 * c) * 33 + n;
        v4u o; o.x = pk2(s[0 * 33], s[1 * 33]); o.y = pk2(s[2 * 33], s[3 * 33]); o.z = pk2(s[4 * 33], s[5 * 33]); o.w = pk2(s[6 * 33], s[7 * 33]);
        const int nn = n0 + n; const int dr = glu ? (nn < DFF ? (nn >> 7) * 256 + (nn & 127) : ((nn - DFF) >> 7) * 256 + 128 + ((nn - DFF) & 127)) : nn;
        *(v4u*)(WT + (size_t)dr * K + k0 + 8 * c) = o; }
    LDS_WAIT(); asm volatile("" ::: "memory");
}
__device__ __forceinline__ void transpose_mat(const float* W, int K, int N, bf16* WT, LAS float* scr, int gw, int NGW, int lane, const float* gain = nullptr, int glu = 0) {
    const int nitems = (K / 64) * (N / 32);
    for (int it = gw; it < nitems; it += NGW) transpose_item(W, K, N, WT, scr, it, lane, gain, glu);
}
__device__ __forceinline__ void rms_rows(const float* src, const float* g, bf16* dst, int gw, int NGW, int lane) {
    for (int m = gw; m < M; m += NGW) {
        const f32x4* xr = (const f32x4*)(src + (size_t)m * D) + lane; const f32x4* gr = (const f32x4*)g + lane;
        f32x4 v[4]; float s = 0.f;
#pragma unroll
        for (int j = 0; j < 4; ++j) { v[j] = xr[64 * j]; s += (v[j].x * v[j].x + v[j].y * v[j].y) + (v[j].z * v[j].z + v[j].w * v[j].w); }
        const float rstd = __builtin_amdgcn_rsqf(wave_sum(s) * (1.f / D) + 1e-6f);
        unsigned long long* o8 = (unsigned long long*)(dst + (size_t)m * D) + lane;
#pragma unroll
        for (int j = 0; j < 4; ++j) { const f32x4 gg = gr[64 * j];
            o8[64 * j] = (unsigned long long)pk2(v[j].x * rstd * gg.x, v[j].y * rstd * gg.y) | ((unsigned long long)pk2(v[j].z * rstd * gg.z, v[j].w * rstd * gg.w) << 32); }
    }
}

__device__ __forceinline__ void p0_prologue(const Args& a, LAS unsigned char* lds, int tid, int lane, int wave) {
    const CAS char* kp_ = kargs_ptr();
    LAS float* scr = (LAS float*)(lds + wave * 16384);
    const int G = gridDim.x, gw = blockIdx.x * NWAVES + wave, NGW = G * NWAVES, gt = blockIdx.x * NTHR + tid, NGT = G * NTHR;
    transpose_mat(KIN(I_WIN), D, ABIN, (bf16*)(KWS + WS_WIN), scr, gw, NGW, lane);
    { float* bp = (float*)(KWS + WS_BIASP); for (int i = gt; i < ABIN; i += NGT) bp[i] = i < 1024 ? KIN(I_CINB)[i] : 0.f; }
    rms_rows(KIN(I_X), KIN(I_ABG), (bf16*)(KWS + WS_XN1), gw, NGW, lane);
}

__device__ __forceinline__ void p2_prep(const Args& a, LAS unsigned char* lds, int tid, int lane, int wave) {
    const CAS char* kp_ = kargs_ptr();
    const bf16* PC = (const bf16*)(KWS + WS_PC); const bf16* PR = (const bf16*)((unsigned char*)KOUT + DO_PR);
    bf16* CAT = (bf16*)(KWS + WS_CAT); bf16* LIN = (bf16*)(KWS + WS_LIN);
    LAS float* ybuf = (LAS float*)lds;
    const int c = tid;
    float wv[31];
#pragma unroll
    for (int j = 0; j < 31; ++j) wv[j] = KIN(I_DWW)[j * 512 + c];
    const float bc = KIN(I_DWB)[c];
    for (int tile = blockIdx.x; tile < M / 32; tile += gridDim.x) {
        const int b = tile / (T / 32), tt0 = (tile % (T / 32)) * 32;
        float g[62];
        if (tt0 >= 30) {
            const bf16* rowp = PC + (size_t)(b * T + tt0 - 30) * 1024 + c;
#pragma unroll
            for (int i = 0; i < 62; ++i) { const float x1 = bf2f(rowp[i * 1024]), x2 = bf2f(rowp[i * 1024 + 512]); g[i] = x1 * sigm(x2); }
        } else {
            const bf16* rowp = PC + (size_t)(b * T) * 1024 + c;
#pragma unroll
            for (int i = 0; i < 30; ++i) g[i] = 0.f;
#pragma unroll
            for (int i = 30; i < 62; ++i) { const float x1 = bf2f(rowp[(i - 30) * 1024]), x2 = bf2f(rowp[(i - 30) * 1024 + 512]); g[i] = x1 * sigm(x2); }
        }
#pragma unroll
        for (int tt = 0; tt < 32; ++tt) { float y = bc;
#pragma unroll
            for (int j = 0; j < 31; ++j) y += wv[j] * g[tt + j];
            ybuf[tt * 512 + c] = y; }
        __syncthreads();
#pragma unroll
        for (int q = 0; q < 4; ++q) { const int tt = wave * 4 + q; const LAS f32x4* yr = (const LAS f32x4*)(ybuf + tt * 512 + lane * 8);
            const f32x4 y0 = yr[0], y1 = yr[1];
            const float mean = wave_sum((y0.x + y0.y) + (y0.z + y0.w) + (y1.x + y1.y) + (y1.z + y1.w)) * (1.f / 512.f);
            const f32x4 d0 = y0 - mean, d1 = y1 - mean;
            const float var = wave_sum((d0.x * d0.x + d0.y * d0.y) + (d0.z * d0.z + d0.w * d0.w) + (d1.x * d1.x + d1.y * d1.y) + (d1.z * d1.z + d1.w * d1.w)) * (1.f / 512.f);
            const float rstd = __builtin_amdgcn_rsqf(var + 1e-5f);
            const f32x4 g0 = *(const f32x4*)(KIN(I_CLNG) + lane * 8), g1 = *(const f32x4*)(KIN(I_CLNG) + lane * 8 + 4);
            const f32x4 b0 = *(const f32x4*)(KIN(I_CLNB) + lane * 8), b1 = *(const f32x4*)(KIN(I_CLNB) + lane * 8 + 4);
            f32x4 o0 = d0 * rstd * g0 + b0, o1 = d1 * rstd * g1 + b1;
            o0.x *= sigm(o0.x); o0.y *= sigm(o0.y); o0.z *= sigm(o0.z); o0.w *= sigm(o0.w); o1.x *= sigm(o1.x); o1.y *= sigm(o1.y); o1.z *= sigm(o1.z); o1.w *= sigm(o1.w);
            v4u w; w.x = pk2(o0.x, o0.y); w.y = pk2(o0.z, o0.w); w.z = pk2(o1.x, o1.y); w.w = pk2(o1.z, o1.w);
            *(v4u*)(CAT + (size_t)(b * T + tt0 + tt) * 1024 + lane * 8) = w; }
        __syncthreads();
    }
    const int gt = blockIdx.x * NTHR + tid, NGT = gridDim.x * NTHR;
    for (int w = gt; w < (M / 32) * LINW; w += NGT) { const int j = w & 255, m_start = (w >> 8) * 32;
        const bf16* p = PR + (size_t)m_start * PRW + 1536 + j; bf16* o = LIN + (size_t)m_start * LINW + j;
        const float mu = KIN(I_MU)[1536 + j];
        float prev = (m_start & (T - 1)) != 0 ? bf2f(p[-PRW]) : 0.f;
#pragma unroll 8
        for (int i = 0; i < 32; ++i) { const float p1 = bf2f(p[i * PRW]); const float xs = p1 + (prev - p1) * mu; prev = p1;
            const float v = j < 64 ? tanh_fast(xs) : (j < 128 ? xs : sigm(xs));
            o[i * LINW] = (bf16)f2bf(v); }
    }
}

constexpr int SLABB = 2048, RUNL = 64;
constexpr size_t WS_WLC = 256 * 1024;
struct SlabRegs { v4u p1, p2; };
__device__ __forceinline__ void slab_load(SlabRegs& r, const unsigned char* slab, int lane) {
    r.p1 = *(const v4u*)(slab + lane * 16); r.p2 = *(const v4u*)(slab + 1024 + lane * 16);
}
__device__ __forceinline__ void slab_piece(const v4u q, LAS float* dst, int p) {
    LAS float* d = dst + (p >> 5) * 256 + ((p >> 3) & 3) * 64 + (p & 7) * 8;
    *(LAS f32x4*)d = (f32x4){bflo(q.x), bfhi(q.x), bflo(q.y), bfhi(q.y)}; *(LAS f32x4*)(d + 4) = (f32x4){bflo(q.z), bfhi(q.z), bflo(q.w), bfhi(q.w)};
}
__device__ __forceinline__ void slab_store(const SlabRegs& r, LAS float* dst, int lane) { slab_piece(r.p1, dst, lane); slab_piece(r.p2, dst, lane + 64); }
__device__ __forceinline__ void p4_rwkv_prep(const Args& a, int lane, int wave) {
    const CAS char* kp_ = kargs_ptr();
    const bf16* PR = (const bf16*)((unsigned char*)KOUT + DO_PR); const bf16* LOWp = (const bf16*)(KWS + WS_LOW); const bf16* LOAp = (const bf16*)(KWS + WS_LOA);
    unsigned char* SEQ = KWS + WS_SEQ; float* BON = (float*)(KWS + WS_BON); float* WLC = (float*)(KWS + WS_WLC);
    const int gw = blockIdx.x * NWAVES + wave, NGW = gridDim.x * NWAVES;
    constexpr int RUN = 64, U = 4;
    for (int run = gw; run < (M / RUN) * NH; run += NGW) { const int h = run & 7, mbase = (run >> 3) * RUN, c = h * 64 + lane, b = mbase / T;
        const float mur = KIN(I_MU)[c], muk = KIN(I_MU)[512 + c], w0 = KIN(I_W0)[c], a0 = KIN(I_A0)[c], kkc = KIN(I_KK)[c], kac = KIN(I_KA)[c], rkc = KIN(I_RK)[c];
        float rp = 0.f, kp_ = 0.f, Wc = 1.f;
        if ((mbase & (T - 1)) != 0) { rp = bf2f(PR[(size_t)(mbase - 1) * PRW + c]); kp_ = bf2f(PR[(size_t)(mbase - 1) * PRW + 512 + c]); }
        for (int i0 = 0; i0 < RUN; i0 += U) {
            float r1[U], k1[U], lw[U], la[U];
#pragma unroll
            for (int u = 0; u < U; ++u) { const size_t m = (size_t)(mbase + i0 + u); r1[u] = bf2f(PR[m * PRW + c]); k1[u] = bf2f(PR[m * PRW + 512 + c]); lw[u] = bf2f(LOWp[m * 512 + c]); la[u] = bf2f(LOAp[m * 512 + c]); }
            float kkr[U], kpv[U], rr[U], dec[U], agv[U], n2[U], bn[U];
#pragma unroll
            for (int u = 0; u < U; ++u) {
                const float r = r1[u] + (rp - r1[u]) * mur, k = k1[u] + (kp_ - k1[u]) * muk; rp = r1[u]; kp_ = k1[u];
                const float z = -(w0 + lw[u]);
                const float sp = fmaxf(z, 0.f) + __logf(1.f + __expf(-fabsf(z)));
                dec[u] = __expf(-__expf(-sp - 0.5f));
                const float ag = sigm(a0 + la[u]); agv[u] = ag;
                kkr[u] = k * kkc; n2[u] = kkr[u] * kkr[u];
                kpv[u] = k * (1.f + (ag - 1.f) * kac); rr[u] = r; bn[u] = r * kpv[u] * rkc; }
#pragma unroll
            for (int o = 1; o < 64; o <<= 1)
#pragma unroll
                for (int u = 0; u < U; ++u) { n2[u] += __shfl_xor(n2[u], o); bn[u] += __shfl_xor(bn[u], o); }
#pragma unroll
            for (int u = 0; u < U; ++u) { const int m = mbase + i0 + u, t = m & (T - 1);
                const float kk = kkr[u] * __builtin_amdgcn_rsqf(fmaxf(n2[u], 1e-24f));
                unsigned char* sl_ = SEQ + ((size_t)(b * NH + h) * (T / 4) + (t >> 2)) * SLABB; const int st_ = t & 3;
                const float ap = -kk * Wc; Wc *= dec[u]; const float iW = __builtin_amdgcn_rcpf(Wc);
                bf16* hb = (bf16*)(sl_ + st_ * 512) + lane;
                hb[0] = (bf16)f2bf(ap); hb[64] = (bf16)f2bf(kk * agv[u] * iW); hb[128] = (bf16)f2bf(kpv[u] * iW); hb[192] = (bf16)f2bf(rr[u] * Wc);
                if (lane == 0) BON[(size_t)m * NH + h] = bn[u]; }
        }
        WLC[((size_t)(b * NH + h) * (T / RUNL) + (mbase & (T - 1)) / RUNL) * 64 + lane] = Wc;
    }
}

__device__ __forceinline__ int crow(int r, int hi) { return (r & 3) + 8 * (r >> 2) + 4 * hi; }
constexpr int SLAB = 4, SLABF = SLAB * 256;
constexpr int NCH = 64, CL = T / NCH;
template <int MODE>
__device__ __forceinline__ void scan_task(const Args& a, LAS float* wl, int lane, int chain, int ck) {
    const CAS char* kp_ = kargs_ptr();
    const bf16* PR = (const bf16*)((unsigned char*)KOUT + DO_PR); const bf16* LOGp = (const bf16*)(KWS + WS_LOG);
    const unsigned char* SEQ = KWS + WS_SEQ; const float* BON = (const float*)(KWS + WS_BON); bf16* CAT = (bf16*)(KWS + WS_CAT);
    float* ST = (float*)(KWS + WS_ST);
    const int b = chain >> 3, h = chain & 7, c = h * 64 + lane, t0 = ck * CL;
    const float muv = KIN(I_MU)[1024 + c];
    float lng = 0.f, lnb = 0.f;
    if constexpr (MODE == 2) { lng = KIN(I_RLNG)[c]; lnb = KIN(I_RLNB)[c]; }
    f32x2 S[32];
#pragma unroll
    for (int j = 0; j < 32; ++j) S[j] = (f32x2){0.f, 0.f};
    if constexpr (MODE == 3) {
#pragma unroll
        for (int j = 0; j < 32; ++j) S[j] = (f32x2){lane == 2 * j ? 1.f : 0.f, lane == 2 * j + 1 ? 1.f : 0.f};
    }
    if constexpr (MODE == 2) {
        if (ck > 0) { const f32x4* sp = (const f32x4*)(ST + ((size_t)(chain * NCH + ck - 1) * 2) * 4096 + lane * 64);
#pragma unroll
            for (int j = 0; j < 16; ++j) { const f32x4 q = sp[j]; S[2 * j] = q.xy; S[2 * j + 1] = q.zw; } }
    }
    const unsigned char* sq = SEQ + ((size_t)chain * (T / SLAB) + t0 / SLAB) * SLABB;
    const size_t m0 = (size_t)b * T + t0;
    float pprev = 0.f;
    if constexpr (MODE != 3) pprev = t0 > 0 ? bf2f(PR[(m0 - 1) * PRW + 1024 + c]) : 0.f;
    SlabRegs pre; unsigned pvn[SLAB], gtn[SLAB]; float bnn[SLAB];
    slab_load(pre, sq, lane);
#pragma unroll
    for (int s = 0; s < SLAB; ++s) { const size_t m = m0 + s; if constexpr (MODE != 3) pvn[s] = PR[m * PRW + 1024 + c]; if constexpr (MODE == 2) { gtn[s] = LOGp[m * 512 + c]; bnn[s] = BON[m * NH + h]; } }
    slab_store(pre, wl, lane);
    for (int sl = 0; sl < CL / SLAB; ++sl) {
        const int buf = sl & 1; const LAS float* ob = wl + buf * SLABF;
        if (sl == RUNL / SLAB) {
            const f32x4* wq = (const f32x4*)((const float*)(KWS + WS_WLC) + ((size_t)chain * (T / RUNL) + t0 / RUNL) * 64);
#pragma unroll
            for (int j = 0; j < 16; ++j) { const f32x4 q = wq[j]; S[2 * j] *= q.xy; S[2 * j + 1] *= q.zw; } }
        unsigned pvc[SLAB], gtc[SLAB]; float bnc[SLAB];
#pragma unroll
        for (int s = 0; s < SLAB; ++s) { if constexpr (MODE != 3) pvc[s] = pvn[s]; if constexpr (MODE == 2) { gtc[s] = gtn[s]; bnc[s] = bnn[s]; } }
        const int sn = (sl + 1 < CL / SLAB) ? sl + 1 : sl;
        slab_load(pre, sq + (size_t)sn * SLABB, lane);
#pragma unroll
        for (int s = 0; s < SLAB; ++s) { const size_t m = m0 + (size_t)sn * SLAB + s; if constexpr (MODE != 3) pvn[s] = PR[m * PRW + 1024 + c]; if constexpr (MODE == 2) { gtn[s] = LOGp[m * 512 + c]; bnn[s] = BON[m * NH + h]; } }
        __builtin_amdgcn_sched_barrier(0);
        float ys[SLAB], vs[SLAB];
        constexpr int NIT = 20, NQ = (MODE == 2 ? 3 : (MODE == 1 ? 2 : 1));
        f32x4 ring[8][4];
        const LAS f32x4* o4b = (const LAS f32x4*)ob;
#define SCAN_LD(it_) do { const int st_ = (it_) / NIT, lc_ = (it_) % NIT; const LAS f32x4* o4_ = o4b + st_ * 64; \
            if (lc_ < 4) { _Pragma("unroll") for (int q_ = 0; q_ < 4; ++q_) ring[(it_) & 7][q_] = o4_[4 * lc_ + q_]; } \
            else { _Pragma("unroll") for (int q_ = 0; q_ < NQ; ++q_) ring[(it_) & 7][q_] = o4_[16 * (q_ + 1) + (lc_ - 4)]; } } while (0)
        SCAN_LD(0); SCAN_LD(1); SCAN_LD(2); SCAN_LD(3); SCAN_LD(4); SCAN_LD(5);
        f32x2 sa0 = {0.f, 0.f}, sa1 = {0.f, 0.f}, y0 = {0.f, 0.f}, y1 = {0.f, 0.f}, sav = {0.f, 0.f}, vv = {0.f, 0.f};
#pragma unroll
        for (int it = 0; it < SLAB * NIT; ++it) {
            const int st = it / NIT, lc = it % NIT;
            if (it + 6 < SLAB * NIT) SCAN_LD(it + 6);
            if (lc == 0) { float v = 0.f;
                if constexpr (MODE != 3) { const float pv = bf2f(pvc[st]); v = pv + (pprev - pv) * muv; pprev = pv; }
                vs[st] = v; vv = (f32x2){v, v}; sa0 = (f32x2){0.f, 0.f}; sa1 = (f32x2){0.f, 0.f}; y0 = (f32x2){0.f, 0.f}; y1 = (f32x2){0.f, 0.f}; }
            if (lc < 4) {
#pragma unroll
                for (int q = 0; q < 4; ++q) { const f32x4 a4 = ring[it & 7][q]; sa0 += S[8 * lc + 2 * q] * a4.xy; sa1 += S[8 * lc + 2 * q + 1] * a4.zw; }
                if (lc == 3) { const float sa = (sa0.x + sa0.y) + (sa1.x + sa1.y); sav = (f32x2){sa, sa}; }
            } else { const int j = lc - 4; const f32x4 b4 = ring[it & 7][0];
                f32x2 n0 = S[2 * j] + sav * b4.xy, n1 = S[2 * j + 1] + sav * b4.zw;
                if constexpr (MODE != 3) { const f32x4 k4 = ring[it & 7][1]; n0 += vv * k4.xy; n1 += vv * k4.zw; }
                S[2 * j] = n0; S[2 * j + 1] = n1;
                if constexpr (MODE == 2) { const f32x4 r4 = ring[it & 7][2]; y0 += n0 * r4.xy; y1 += n1 * r4.zw; if (lc == NIT - 1) ys[st] = (y0.x + y0.y) + (y1.x + y1.y); }
            }
            __builtin_amdgcn_sched_barrier(0);
        }
#undef SCAN_LD
        if constexpr (MODE == 2) {
            float mu4[SLAB], d4[SLAB], q4[SLAB];
#pragma unroll
            for (int s = 0; s < SLAB; ++s) mu4[s] = ys[s];
#pragma unroll
            for (int o = 1; o < 64; o <<= 1)
#pragma unroll
                for (int s = 0; s < SLAB; ++s) mu4[s] += __shfl_xor(mu4[s], o);
#pragma unroll
            for (int s = 0; s < SLAB; ++s) { d4[s] = ys[s] - mu4[s] * (1.f / 64.f); q4[s] = d4[s] * d4[s]; }
#pragma unroll
            for (int o = 1; o < 64; o <<= 1)
#pragma unroll
                for (int s = 0; s < SLAB; ++s) q4[s] += __shfl_xor(q4[s], o);
#pragma unroll
            for (int s = 0; s < SLAB; ++s) { float yn = d4[s] * __builtin_amdgcn_rsqf(q4[s] * (1.f / 64.f) + 64e-5f) * lng + lnb;
                yn += bnc[s] * vs[s]; yn *= bf2f(gtc[s]);
                CAT[(m0 + (size_t)sl * SLAB + s) * 1024 + 512 + c] = (bf16)f2bf(yn); }
        }
        slab_store(pre, wl + (buf ^ 1) * SLABF, lane);
    }
    if constexpr (MODE != 2) {
        f32x4* dm = (f32x4*)(ST + ((size_t)(chain * NCH + ck) * 2 + (MODE == 1 ? 1 : 0)) * 4096 + lane * 64);
#pragma unroll
        for (int j = 0; j < 16; ++j) { f32x4 q; q.xy = S[2 * j]; q.zw = S[2 * j + 1]; dm[j] = q; }
    }
}
__device__ __forceinline__ void scan_task_p1(const Args& a, LAS float* wl, int lane, int chain, int ck, int rh) {
    const CAS char* kp_ = kargs_ptr();
    const bf16* PR = (const bf16*)((unsigned char*)KOUT + DO_PR); const unsigned char* SEQ = KWS + WS_SEQ; float* ST = (float*)(KWS + WS_ST);
    const int b = chain >> 3, h = chain & 7, r32 = lane & 31, kh = lane >> 5, row = 32 * rh + r32, c = h * 64 + row, t0 = ck * CL;
    const float muv = KIN(I_MU)[1024 + c];
    f32x2 Sn[16], Sm[16];
#pragma unroll
    for (int j = 0; j < 16; ++j) { Sn[j] = (f32x2){0.f, 0.f}; Sm[j] = (f32x2){row == 32 * kh + 2 * j ? 1.f : 0.f, row == 32 * kh + 2 * j + 1 ? 1.f : 0.f}; }
    const unsigned char* sq = SEQ + ((size_t)chain * (T / SLAB) + t0 / SLAB) * SLABB;
    const size_t m0 = (size_t)b * T + t0;
    float pprev = t0 > 0 ? bf2f(PR[(m0 - 1) * PRW + 1024 + c]) : 0.f;
    SlabRegs pre; unsigned pvn[SLAB];
    slab_load(pre, sq, lane);
#pragma unroll
    for (int s = 0; s < SLAB; ++s) pvn[s] = PR[(m0 + s) * PRW + 1024 + c];
    slab_store(pre, wl, lane);
    for (int sl = 0; sl < CL / SLAB; ++sl) {
        const int buf = sl & 1; const LAS float* ob = wl + buf * SLABF;
        if (sl == RUNL / SLAB) {
            const f32x4* wq = (const f32x4*)((const float*)(KWS + WS_WLC) + ((size_t)chain * (T / RUNL) + t0 / RUNL) * 64 + 32 * kh);
#pragma unroll
            for (int j = 0; j < 8; ++j) { const f32x4 q = wq[j]; Sn[2 * j] *= q.xy; Sn[2 * j + 1] *= q.zw; Sm[2 * j] *= q.xy; Sm[2 * j + 1] *= q.zw; } }
        unsigned pvc[SLAB];
#pragma unroll
        for (int s = 0; s < SLAB; ++s) pvc[s] = pvn[s];
        const int sn = (sl + 1 < CL / SLAB) ? sl + 1 : sl;
        slab_load(pre, sq + (size_t)sn * SLABB, lane);
#pragma unroll
        for (int s = 0; s < SLAB; ++s) pvn[s] = PR[(m0 + (size_t)sn * SLAB + s) * PRW + 1024 + c];
        __builtin_amdgcn_sched_barrier(0);
        constexpr int NIT = 10;
        f32x4 ring[4][4];
        const LAS f32x4* o4b = (const LAS f32x4*)ob + 8 * kh;
#define P1_LD(it_) do { const int st_ = (it_) / NIT, lc_ = (it_) % NIT; const LAS f32x4* o4_ = o4b + st_ * 64; \
            if (lc_ < 2) { _Pragma("unroll") for (int q_ = 0; q_ < 4; ++q_) ring[(it_) & 3][q_] = o4_[4 * lc_ + q_]; } \
            else { _Pragma("unroll") for (int q_ = 0; q_ < 2; ++q_) ring[(it_) & 3][q_] = o4_[16 * (q_ + 1) + (lc_ - 2)]; } } while (0)
        P1_LD(0); P1_LD(1); P1_LD(2);
        f32x2 an0 = {0.f, 0.f}, an1 = {0.f, 0.f}, am0 = {0.f, 0.f}, am1 = {0.f, 0.f}, sanv = {0.f, 0.f}, samv = {0.f, 0.f}, vv = {0.f, 0.f};
#pragma unroll
        for (int it = 0; it < SLAB * NIT; ++it) {
            const int st = it / NIT, lc = it % NIT;
            if (it + 3 < SLAB * NIT) P1_LD(it + 3);
            if (lc == 0) { const float pv = bf2f(pvc[st]); const float v = pv + (pprev - pv) * muv; pprev = pv; vv = (f32x2){v, v};
                an0 = (f32x2){0.f, 0.f}; an1 = (f32x2){0.f, 0.f}; am0 = (f32x2){0.f, 0.f}; am1 = (f32x2){0.f, 0.f}; }
            if (lc < 2) {
#pragma unroll
                for (int q = 0; q < 4; ++q) { const f32x4 a4 = ring[it & 3][q];
                    an0 += Sn[8 * lc + 2 * q] * a4.xy; an1 += Sn[8 * lc + 2 * q + 1] * a4.zw; am0 += Sm[8 * lc + 2 * q] * a4.xy; am1 += Sm[8 * lc + 2 * q + 1] * a4.zw; }
                if (lc == 1) { float san = (an0.x + an0.y) + (an1.x + an1.y), sam = (am0.x + am0.y) + (am1.x + am1.y);
                    san += __shfl_xor(san, 32); sam += __shfl_xor(sam, 32); sanv = (f32x2){san, san}; samv = (f32x2){sam, sam}; }
            } else { const int j = lc - 2; const f32x4 b4 = ring[it & 3][0], k4 = ring[it & 3][1];
                Sn[2 * j] = Sn[2 * j] + sanv * b4.xy + vv * k4.xy; Sn[2 * j + 1] = Sn[2 * j + 1] + sanv * b4.zw + vv * k4.zw;
                Sm[2 * j] = Sm[2 * j] + samv * b4.xy;              Sm[2 * j + 1] = Sm[2 * j + 1] + samv * b4.zw;
            }
            __builtin_amdgcn_sched_barrier(0);
        }
#undef P1_LD
        slab_store(pre, wl + (buf ^ 1) * SLABF, lane);
    }
    f32x4* dm = (f32x4*)(ST + ((size_t)(chain * NCH + ck) * 2) * 4096 + row * 64 + 32 * kh); f32x4* dn = dm + 1024;
    const f32x4* wq = (const f32x4*)((const float*)(KWS + WS_WLC) + ((size_t)chain * (T / RUNL) + t0 / RUNL + 1) * 64 + 32 * kh);
#pragma unroll
    for (int j = 0; j < 8; ++j) { const f32x4 w4 = wq[j]; f32x4 q; q.xy = Sm[2 * j] * w4.xy; q.zw = Sm[2 * j + 1] * w4.zw; dm[j] = q; f32x4 p; p.xy = Sn[2 * j] * w4.xy; p.zw = Sn[2 * j + 1] * w4.zw; dn[j] = p; }
}
__device__ __forceinline__ void scan_pass1(const Args& a, LAS unsigned char* lds, int lane, int wave) {
    LAS float* wl = (LAS float*)(lds + wave * (2 * SLABF * 4));
    const int ntask = 2 * BATCH * NH * (NCH - 1);
    for (int wk = wave * gridDim.x + blockIdx.x; wk < ntask; wk += NWAVES * gridDim.x) {
        const int rh = wk & 1, chain = (wk >> 1) & 15, ck = wk >> 5;
        scan_task_p1(a, wl, lane, chain, ck, rh);
    }
}
__device__ __forceinline__ void scan_pass2(const Args& a, LAS unsigned char* lds, int lane, int wave) {
    LAS float* wl = (LAS float*)(lds + wave * (2 * SLABF * 4));
    for (int wk = wave * gridDim.x + blockIdx.x; wk < BATCH * NH * NCH; wk += NWAVES * gridDim.x) scan_task<2>(a, wl, lane, wk & 15, wk >> 4);
}
constexpr int GS = 8, NG = NCH / GS;
__device__ __forceinline__ f32x16 mm_acc(const LAS float* X, const LAS float* Mm, f32x16 acc, int ti, int tn, int kh, int l31, int hi) {
    const LAS float* sb = X + (32 * ti + l31) * 65 + 32 * kh + hi;
    const LAS float* mb = Mm + (32 * kh + hi) * 64 + 32 * tn + l31;
#pragma unroll
    for (int kk = 0; kk < 16; ++kk) acc = __builtin_amdgcn_mfma_f32_32x32x2f32(sb[2 * kk], mb[2 * kk * 64], acc, 0, 0, 0);
    return acc;
}
__device__ __forceinline__ void comb_a(const Args& a, LAS unsigned char* lds, int tid, int lane, int wave) {
    const CAS char* kp_ = kargs_ptr();
    if (blockIdx.x >= BATCH * NH * NG) return;
    const int chain = blockIdx.x & 15, g = blockIdx.x >> 4, c0 = g * GS;
    float* ST = (float*)(KWS + WS_ST);
    LAS float* XM = (LAS float*)lds;
    LAS float* XN = XM + 2 * 4160;
    LAS float* Mb = XN + 2 * 4160;
    LAS float* Nb = Mb + 4096;
    LAS float* Pb = Nb + 4096;
    const int l31 = lane & 31, hi = lane >> 5, tile = wave & 3, ti = tile >> 1, tn = tile & 1, kh = wave >> 2;
    const int jmax = (c0 + GS - 1 <= NCH - 2) ? GS - 1 : NCH - 2 - c0;
    f32x4 rq[4];
    { const f32x4* gm = (const f32x4*)(ST + ((size_t)(chain * NCH + c0) * 2) * 4096);
#pragma unroll
      for (int e = 0; e < 2; ++e) { const int idx = tid + 512 * e; const f32x4 m = gm[idx], n = gm[1024 + idx]; const int r = idx >> 4, cc = (idx & 15) * 4;
#pragma unroll
          for (int q = 0; q < 4; ++q) { XM[r * 65 + cc + q] = m[q]; XN[r * 65 + cc + q] = n[q]; } }
      const f32x4* g1 = gm + 2048;
      rq[0] = g1[tid]; rq[1] = g1[tid + 512]; rq[2] = g1[1024 + tid]; rq[3] = g1[1024 + tid + 512]; }
    int cur = 0;
    for (int j = 1; j <= jmax; ++j) {
#pragma unroll
        for (int e = 0; e < 2; ++e) { const int idx = tid + 512 * e; *(LAS f32x4*)(Mb + idx * 4) = rq[e]; *(LAS f32x4*)(Nb + idx * 4) = rq[2 + e]; }
        { const int cn = (j + 1 <= jmax) ? c0 + j + 1 : c0 + j; const f32x4* gm = (const f32x4*)(ST + ((size_t)(chain * NCH + cn) * 2) * 4096);
          rq[0] = gm[tid]; rq[1] = gm[tid + 512]; rq[2] = gm[1024 + tid]; rq[3] = gm[1024 + tid + 512]; }
        __syncthreads();
        f32x16 am, an;
#pragma unroll
        for (int r = 0; r < 16; ++r) { am[r] = 0.f; an[r] = kh == 0 ? Nb[(32 * ti + crow(r, hi)) * 64 + 32 * tn + l31] : 0.f; }
        am = mm_acc(XM + cur * 4160, Mb, am, ti, tn, kh, l31, hi);
        an = mm_acc(XN + cur * 4160, Mb, an, ti, tn, kh, l31, hi);
        if (kh == 1) {
#pragma unroll
            for (int r = 0; r < 16; ++r) { Pb[(tile * 16 + r) * 64 + lane] = am[r]; Pb[4096 + (tile * 16 + r) * 64 + lane] = an[r]; }
        }
        __syncthreads();
        if (kh == 0) {
            float* gs = ST + ((size_t)(chain * NCH + c0 + j) * 2) * 4096;
#pragma unroll
            for (int r = 0; r < 16; ++r) { const float vm = am[r] + Pb[(tile * 16 + r) * 64 + lane], vn = an[r] + Pb[4096 + (tile * 16 + r) * 64 + lane]; const int row = 32 * ti + crow(r, hi), col = 32 * tn + l31;
                XM[(cur ^ 1) * 4160 + row * 65 + col] = vm; XN[(cur ^ 1) * 4160 + row * 65 + col] = vn; gs[row * 64 + col] = vm; gs[4096 + row * 64 + col] = vn; }
        }
        cur ^= 1;
    }
}
__device__ __forceinline__ void comb_b(const Args& a, LAS unsigned char* lds, int tid, int lane, int wave) {
    const CAS char* kp_ = kargs_ptr();
    if (blockIdx.x >= BATCH * NH) return;
    const int chain = blockIdx.x;
    float* ST = (float*)(KWS + WS_ST);
    LAS float* Sb = (LAS float*)lds;
    LAS float* Mb = Sb + 2 * 4160;
    LAS float* Nb = Mb + 4096;
    LAS float* Pb = Nb + 4096;
    const int l31 = lane & 31, hi = lane >> 5, tile = wave & 3, ti = tile >> 1, tn = tile & 1, kh = wave >> 2;
    for (int i = tid; i < 2 * 4160; i += NTHR) Sb[i] = 0.f;
    f32x4 rq[4];
    { const f32x4* gm = (const f32x4*)(ST + ((size_t)(chain * NCH + GS - 1) * 2) * 4096); rq[0] = gm[tid]; rq[1] = gm[tid + 512]; rq[2] = gm[1024 + tid]; rq[3] = gm[1024 + tid + 512]; }
    int cur = 0;
    for (int g = 0; g < NG - 1; ++g) {
        const int c = g * GS + GS - 1;
#pragma unroll
        for (int e = 0; e < 2; ++e) { const int idx = tid + 512 * e; *(LAS f32x4*)(Mb + idx * 4) = rq[e]; *(LAS f32x4*)(Nb + idx * 4) = rq[2 + e]; }
        { const int cn = (g + 1 < NG - 1) ? c + GS : c; const f32x4* gm = (const f32x4*)(ST + ((size_t)(chain * NCH + cn) * 2) * 4096);
          rq[0] = gm[tid]; rq[1] = gm[tid + 512]; rq[2] = gm[1024 + tid]; rq[3] = gm[1024 + tid + 512]; }
        __syncthreads();
        f32x16 acc;
#pragma unroll
        for (int r = 0; r < 16; ++r) acc[r] = kh == 0 ? Nb[(32 * ti + crow(r, hi)) * 64 + 32 * tn + l31] : 0.f;
        acc = mm_acc(Sb + cur * 4160, Mb, acc, ti, tn, kh, l31, hi);
        if (kh == 1) {
#pragma unroll
            for (int r = 0; r < 16; ++r) Pb[(tile * 16 + r) * 64 + lane] = acc[r];
        }
        __syncthreads();
        if (kh == 0) {
            float* gs = ST + ((size_t)(chain * NCH + c) * 2) * 4096;
#pragma unroll
            for (int r = 0; r < 16; ++r) { const float v = acc[r] + Pb[(tile * 16 + r) * 64 + lane]; const int row = 32 * ti + crow(r, hi), col = 32 * tn + l31;
                Sb[(cur ^ 1) * 4160 + row * 65 + col] = v; gs[row * 64 + col] = v; }
        }
        cur ^= 1;
    }
}
__device__ __forceinline__ void comb_c(const Args& a, LAS unsigned char* lds, int tid, int lane, int wave) {
    const CAS char* kp_ = kargs_ptr();
    float* ST = (float*)(KWS + WS_ST);
    LAS float* Sb = (LAS float*)lds;
    LAS float* Mb = Sb + 4160;
    LAS float* Nb = Mb + 4096;
    LAS float* Pb = Nb + 4096;
    const int l31 = lane & 31, hi = lane >> 5, tile = wave & 3, ti = tile >> 1, tn = tile & 1, kh = wave >> 2;
    for (int task = blockIdx.x; task < BATCH * NH * NG * (GS - 1); task += gridDim.x) {
        const int chain = task & 15, g = (task >> 4) & (NG - 1), j = task >> 7, c = g * GS + j;
        { const f32x4* gm = (const f32x4*)(ST + ((size_t)(chain * NCH + c) * 2) * 4096);
          const f32x4* gx = (const f32x4*)(ST + ((size_t)(chain * NCH + (g > 0 ? (g * GS - 1) : 0)) * 2) * 4096);
#pragma unroll
          for (int e = 0; e < 2; ++e) { const int idx = tid + 512 * e; *(LAS f32x4*)(Mb + idx * 4) = gm[idx]; *(LAS f32x4*)(Nb + idx * 4) = gm[1024 + idx];
              const f32x4 x = g > 0 ? gx[idx] : (f32x4){0.f, 0.f, 0.f, 0.f}; const int r = idx >> 4, cc = (idx & 15) * 4;
#pragma unroll
              for (int q = 0; q < 4; ++q) Sb[r * 65 + cc + q] = x[q]; } }
        __syncthreads();
        f32x16 acc;
#pragma unroll
        for (int r = 0; r < 16; ++r) acc[r] = kh == 0 ? Nb[(32 * ti + crow(r, hi)) * 64 + 32 * tn + l31] : 0.f;
        acc = mm_acc(Sb, Mb, acc, ti, tn, kh, l31, hi);
        if (kh == 1) {
#pragma unroll
            for (int r = 0; r < 16; ++r) Pb[(tile * 16 + r) * 64 + lane] = acc[r];
        }
        __syncthreads();
        if (kh == 0) {
            float* gs = ST + ((size_t)(chain * NCH + c) * 2) * 4096;
#pragma unroll
            for (int r = 0; r < 16; ++r) gs[(32 * ti + crow(r, hi)) * 64 + 32 * tn + l31] = acc[r] + Pb[(tile * 16 + r) * 64 + lane];
        }
        __syncthreads();
    }
}

__device__ __forceinline__ void glu_fixup(const Args& a, int layer, int tid) {
    const CAS char* kp_ = kargs_ptr();
    bf16* H = (bf16*)(KWS + WS_H); const float* HG = (const float*)(KWS + WS_HG); const float* HV = (const float*)(KWS + WS_HV); const float* TG = (const float*)(KWS + WS_TG);
    const float* cw = KIN(I_FCW) + (size_t)layer * 3 * DFF; const float* cb = KIN(I_FCB) + (size_t)layer * DFF;
    const int gt = blockIdx.x * NTHR + tid, NGT = gridDim.x * NTHR;
    for (int i = gt; i < (M / 64) * 2 * DFF; i += NGT) { const int c = i % DFF, bj = i / DFF, j = bj & 1, blk = bj >> 1;
        const bool first = (blk & (T / 64 - 1)) == 0;
        const float g2 = HG[(size_t)bj * DFF + c];
        const float t1 = first ? 0.f : TG[((size_t)(blk - 1) * 2 + 1) * DFF + c], t0 = first ? 0.f : TG[((size_t)(blk - 1) * 2) * DFF + c];
        const float g1 = j == 1 ? HG[((size_t)blk * 2) * DFF + c] : t1, g0 = j == 1 ? t1 : t0;
        const float x = cw[c] * g0 + cw[DFF + c] * g1 + cw[2 * DFF + c] * g2 + cb[c];
        H[(size_t)(blk * 64 + j) * DFF + c] = (bf16)f2bf(x * sigm(x) * HV[(size_t)bj * DFF + c]); }
}

constexpr int KS_PITCH = 144, VT_PITCH = 528, KS_BYTES = 256 * KS_PITCH;
__device__ __forceinline__ void p14_attn(const Args& a, LAS unsigned char* lds, int tid, int lane, int wave) {
    const CAS char* kp_ = kargs_ptr();
    const bf16* QKV = (const bf16*)(KWS + WS_QKV); bf16* O = (bf16*)(KWS + WS_O); const float* TAB = (const float*)(KWS + WS_ROPE);
    LAS unsigned char* Ks = lds; LAS unsigned char* Vt = lds + KS_BYTES;
    const int q = lane & 31, hi = lane >> 5;
    for (int u = blockIdx.x; u < BATCH * (T / 128) * 4; u += gridDim.x) {
        const int g = u & 3, qb = (u >> 2) & 63, b = u >> 8; const int tok0 = b * T + qb * 128;
        const int hq = g * 4 + (wave >> 1);
        v4u qcur[4];
        { const bf16* qp = QKV + (size_t)(tok0 + 64 * (wave & 1) + q) * QKVW + hq * 64 + 8 * hi;
#pragma unroll
          for (int ks = 0; ks < 4; ++ks) qcur[ks] = *(const v4u*)(qp + 16 * ks); }
        if (tid < 256) {
            const int kj = tid; const bool valid = (qb > 0) || (kj >= 128); const int token = tok0 - 128 + kj;
            float x[64];
            if (valid) { const v4u* src = (const v4u*)(QKV + (size_t)token * QKVW + 1024 + g * 64);
#pragma unroll
                for (int s = 0; s < 8; ++s) { const v4u w = src[s]; x[8 * s] = bflo(w.x); x[8 * s + 1] = bfhi(w.x); x[8 * s + 2] = bflo(w.y); x[8 * s + 3] = bfhi(w.y); x[8 * s + 4] = bflo(w.z); x[8 * s + 5] = bfhi(w.z); x[8 * s + 6] = bflo(w.w); x[8 * s + 7] = bfhi(w.w); }
                float ss = 0.f;
#pragma unroll
                for (int d = 0; d < 64; ++d) ss += x[d] * x[d];
                const float rstd = 1.0f / sqrtf(ss * (1.f / 64.f) + 1e-6f);
#pragma unroll
                for (int d = 0; d < 64; ++d) x[d] = x[d] * rstd * KIN(I_KNG)[d];
#pragma unroll
                for (int i = 0; i < 8; ++i) { const float cs = TAB[(size_t)token * 16 + i], sn = TAB[(size_t)token * 16 + 8 + i]; const float x1 = x[i], x2 = x[i + 8]; x[i] = x1 * cs - x2 * sn; x[i + 8] = x2 * cs + x1 * sn; }
            } else {
#pragma unroll
                for (int d = 0; d < 64; ++d) x[d] = 0.f;
            }
#pragma unroll
            for (int s = 0; s < 8; ++s) { v4u w; w.x = pk2(x[8 * s], x[8 * s + 1]); w.y = pk2(x[8 * s + 2], x[8 * s + 3]); w.z = pk2(x[8 * s + 4], x[8 * s + 5]); w.w = pk2(x[8 * s + 6], x[8 * s + 7]);
                *(LAS v4u*)(Ks + kj * KS_PITCH + s * 16) = w; }
        } else {
            const int tv = tid - 256;
#pragma unroll
            for (int rep = 0; rep < 4; ++rep) { const int item = tv + 256 * rep, kp = item >> 3, seg = item & 7; const int k0 = 2 * kp; const bool valid = (qb > 0) || (k0 >= 128);
                v4u w0 = {0, 0, 0, 0}, w1 = {0, 0, 0, 0};
                if (valid) { const size_t o = (size_t)(tok0 - 128 + k0) * QKVW + 1280 + g * 64 + seg * 8; w0 = *(const v4u*)(QKV + o); w1 = *(const v4u*)(QKV + o + QKVW); }
                const unsigned e0[4] = {w0.x, w0.y, w0.z, w0.w}, e1[4] = {w1.x, w1.y, w1.z, w1.w};
#pragma unroll
                for (int p = 0; p < 4; ++p) { const int d = seg * 8 + 2 * p;
                    *(LAS unsigned*)(Vt + d * VT_PITCH + k0 * 2) = (e0[p] & 0xffffu) | (e1[p] << 16);
                    *(LAS unsigned*)(Vt + (d + 1) * VT_PITCH + k0 * 2) = (e0[p] >> 16) | (e1[p] & 0xffff0000u); }
            }
        }
        __syncthreads();
        const float sink = KIN(I_SINK)[hq];
#pragma unroll 1
        for (int sb = 0; sb < 2; ++sb) {
            v4u qnext[4];
            { const bf16* qp = QKV + (size_t)(tok0 + 64 * (wave & 1) + 32 + q) * QKVW + hq * 64 + 8 * hi;
#pragma unroll
              for (int ks = 0; ks < 4; ++ks) qnext[ks] = *(const v4u*)(qp + 16 * ks); }
            const int qi0 = 64 * (wave & 1) + 32 * sb; const int token = tok0 + qi0 + q;
            float qv[4][8];
            { float ss = 0.f;
#pragma unroll
              for (int ks = 0; ks < 4; ++ks) { const v4u w = qcur[ks];
                  qv[ks][0] = bflo(w.x); qv[ks][1] = bfhi(w.x); qv[ks][2] = bflo(w.y); qv[ks][3] = bfhi(w.y); qv[ks][4] = bflo(w.z); qv[ks][5] = bfhi(w.z); qv[ks][6] = bflo(w.w); qv[ks][7] = bfhi(w.w);
#pragma unroll
                  for (int j = 0; j < 8; ++j) ss += qv[ks][j] * qv[ks][j]; }
              ss += __shfl_xor(ss, 32);
              const float rstd = 1.0f / sqrtf(ss * (1.f / 64.f) + 1e-6f);
#pragma unroll
              for (int ks = 0; ks < 4; ++ks)
#pragma unroll
                  for (int j = 0; j < 8; ++j) qv[ks][j] = qv[ks][j] * rstd * KIN(I_QNG)[16 * ks + 8 * hi + j];
#pragma unroll
              for (int j = 0; j < 8; ++j) { const float other = __shfl_xor(qv[0][j], 32); const float cs = TAB[(size_t)token * 16 + j], sn = TAB[(size_t)token * 16 + 8 + j];
                  qv[0][j] = hi == 0 ? qv[0][j] * cs - other * sn : qv[0][j] * cs + other * sn; }
            }
            bf16x8 qf[4];
#pragma unroll
            for (int ks = 0; ks < 4; ++ks) { v4u w; w.x = pk2(qv[ks][0] * 0.125f, qv[ks][1] * 0.125f); w.y = pk2(qv[ks][2] * 0.125f, qv[ks][3] * 0.125f); w.z = pk2(qv[ks][4] * 0.125f, qv[ks][5] * 0.125f); w.w = pk2(qv[ks][6] * 0.125f, qv[ks][7] * 0.125f);
                qf[ks] = __builtin_bit_cast(bf16x8, w); }
            const int kt0 = qi0 >> 5;
            f32x16 sc[5];
#pragma unroll
            for (int i = 0; i < 5; ++i) {
#pragma unroll
                for (int r = 0; r < 16; ++r) sc[i][r] = 0.f;
#pragma unroll
                for (int ks = 0; ks < 4; ++ks) { const bf16x8 kf = *(const LAS bf16x8*)(Ks + (32 * (kt0 + i) + q) * KS_PITCH + (16 * ks + 8 * hi) * 2);
                    sc[i] = __builtin_amdgcn_mfma_f32_32x32x16_bf16(kf, qf[ks], sc[i], 0, 0, 0); }
            }
            const int qi = qi0 + q; float mx = sink;
#pragma unroll
            for (int i = 0; i < 5; ++i)
#pragma unroll
                for (int r = 0; r < 16; ++r) { const int kj = 32 * (kt0 + i) + crow(r, hi); const int rel = qi + 128 - kj; const bool ok = (rel >= 0) && (rel < 128) && ((qb > 0) || (kj >= 128));
                    sc[i][r] = ok ? sc[i][r] : -INFINITY; mx = fmaxf(mx, sc[i][r]); }
            mx = fmaxf(mx, __shfl_xor(mx, 32));
            float sum = 0.f;
#pragma unroll
            for (int i = 0; i < 5; ++i)
#pragma unroll
                for (int r = 0; r < 16; ++r) { const float p = __expf(sc[i][r] - mx); sc[i][r] = p; sum += p; }
            sum += __shfl_xor(sum, 32);
            const float inv = 1.0f / (sum + __expf(sink - mx));
            f32x16 oa[2];
#pragma unroll
            for (int dt = 0; dt < 2; ++dt)
#pragma unroll
                for (int r = 0; r < 16; ++r) oa[dt][r] = 0.f;
#pragma unroll
            for (int i = 0; i < 5; ++i)
#pragma unroll
                for (int s2 = 0; s2 < 2; ++s2) { v4u pw; pw.x = pk2(sc[i][8 * s2], sc[i][8 * s2 + 1]); pw.y = pk2(sc[i][8 * s2 + 2], sc[i][8 * s2 + 3]); pw.z = pk2(sc[i][8 * s2 + 4], sc[i][8 * s2 + 5]); pw.w = pk2(sc[i][8 * s2 + 6], sc[i][8 * s2 + 7]);
                    const bf16x8 pb = __builtin_bit_cast(bf16x8, pw);
#pragma unroll
                    for (int dt = 0; dt < 2; ++dt) { const LAS unsigned char* vp = Vt + (q + 32 * dt) * VT_PITCH + (32 * (kt0 + i) + 16 * s2 + 4 * hi) * 2;
                        const v2u lo = *(const LAS v2u*)vp, hh = *(const LAS v2u*)(vp + 16); v4u vw; vw.x = lo.x; vw.y = lo.y; vw.z = hh.x; vw.w = hh.y;
                        oa[dt] = __builtin_amdgcn_mfma_f32_32x32x16_bf16(__builtin_bit_cast(bf16x8, vw), pb, oa[dt], 0, 0, 0); } }
            bf16* op = O + (size_t)token * 1024 + hq * 64 + 4 * hi;
#pragma unroll
            for (int dt = 0; dt < 2; ++dt)
#pragma unroll
                for (int rg = 0; rg < 4; ++rg) { v2u w; w.x = pk2(oa[dt][4 * rg] * inv, oa[dt][4 * rg + 1] * inv); w.y = pk2(oa[dt][4 * rg + 2] * inv, oa[dt][4 * rg + 3] * inv);
                    *(v2u*)(op + 32 * dt + 8 * rg) = w; }
#pragma unroll
            for (int ks = 0; ks < 4; ++ks) qcur[ks] = qnext[ks];
        }
        __syncthreads();
    }
}

__device__ __forceinline__ void p8_prep2(const Args& a, LAS unsigned char* lds, int lane, int wave, int vb, int nb) {
    const CAS char* kp_ = kargs_ptr();
    LAS float* scr = (LAS float*)(lds + wave * 16384);
    const int gw = vb * NWAVES + wave, NGW = nb * NWAVES;
    transpose_mat(KIN(I_WUP), D, UW, (bf16*)(KWS + WS_WUP0), scr, gw, NGW, lane, KIN(I_FNG), 1);
}
__device__ __forceinline__ void tail_g10(const Args& a, LAS unsigned char* lds, int lane, int wave, int vb, int nb) {
    const CAS char* kp_ = kargs_ptr();
    LAS float* scr = (LAS float*)(lds + wave * 16384);
    const int gw = vb * NWAVES + wave, NGW = nb * NWAVES;
    transpose_mat(KIN(I_WDN), DFF, D, (bf16*)(KWS + WS_WDN0), scr, gw, NGW, lane);
    transpose_mat(KIN(I_WQKV), D, QKVW, (bf16*)(KWS + WS_WQKV), scr, gw, NGW, lane, KIN(I_ATG));
    transpose_mat(KIN(I_WO), D, D, (bf16*)(KWS + WS_WO), scr, gw, NGW, lane);
}
__device__ __forceinline__ void tail_g14(const Args& a, LAS unsigned char* lds, int lane, int wave, int vb, int nb) {
    const CAS char* kp_ = kargs_ptr();
    LAS float* scr = (LAS float*)(lds + wave * 16384);
    const int gw = vb * NWAVES + wave, NGW = nb * NWAVES;
    transpose_mat(KIN(I_WUP) + (size_t)D * UW, D, UW, (bf16*)(KWS + WS_WUP1), scr, gw, NGW, lane, KIN(I_FNG) + D, 1);
    transpose_mat(KIN(I_WDN) + (size_t)DFF * D, DFF, D, (bf16*)(KWS + WS_WDN1), scr, gw, NGW, lane);
}
__device__ __forceinline__ void tail_g1(const Args& a, LAS unsigned char* lds, int tid, int lane, int wave, int vb, int nb) {
    const CAS char* kp_ = kargs_ptr();
    LAS float* scr = (LAS float*)(lds + wave * 16384);
    const int gw = vb * NWAVES + wave, NGW = nb * NWAVES, gt = vb * NTHR + tid, NGT = nb * NTHR;
    transpose_mat(KIN(I_WOUT), D, D, (bf16*)(KWS + WS_WOUT), scr, gw, NGW, lane);
    {
        bf16* WL = (bf16*)(KWS + WS_WL);
        for (int i = gt; i < LOW * LINW; i += NGT) { const int n = i >> 8, k = i & 255; float v = 0.f;
            if (n < 512) { if (k < 64) v = KIN(I_W2)[k * 512 + n]; }
            else if (n < 1024) { if (k >= 64 && k < 128) v = KIN(I_A2)[(k - 64) * 512 + (n - 512)]; }
            else { if (k >= 128) v = KIN(I_G2)[(k - 128) * 512 + (n - 1024)]; }
            WL[i] = (bf16)f2bf(v); }
    }
    { float* ssz = (float*)(KWS + WS_SS); for (int i = gt; i < 3 * M; i += NGT) ssz[i] = 0.f; }
    {
        float* tab = (float*)(KWS + WS_ROPE); const int* pos = (const int*)KIN(I_POS);
        for (int i = gt; i < M * 8; i += NGT) { const int m = i >> 3, f = i & 7;
            double inv;
            switch (f) { case 0: inv = 1.0; break; case 1: inv = 0.19392274474868576; break; case 2: inv = 0.03760603093086393; break; case 3: inv = 0.007292664737217109; break;
                         case 4: inv = 0.001414213562373095; break; case 5: inv = 0.0002742481756762073; break; case 6: inv = 5.318295896944988e-05; break; default: inv = 1.031338537721246e-05; break; }
            const double rev = (double)pos[m] * inv * 0.15915494309189535; const float fr = (float)(rev - __builtin_rint(rev));
            tab[m * 16 + f] = __builtin_amdgcn_cosf(fr); tab[m * 16 + 8 + f] = __builtin_amdgcn_sinf(fr); }
    }
}

#define XB_TMO      128
#define XB_XCNT(j)  (256  + 64 * (j))
#define XB_XSUB(j)  (1280 + 64 * (j))
#define XB_XGEN(j)  (2304 + 64 * (j))
#define XB_TOP      3328
#define XB_TOPGEN   3392
#define XCD_BAR_WORDS 3456
#define XB_SPIN_CAP (1u << 18)

__device__ __forceinline__ unsigned xb_ld(unsigned* p)              { return __hip_atomic_load(p, __ATOMIC_RELAXED, __HIP_MEMORY_SCOPE_AGENT); }
__device__ __forceinline__ unsigned xb_add(unsigned* p, unsigned v) { return __hip_atomic_fetch_add(p, v, __ATOMIC_RELAXED, __HIP_MEMORY_SCOPE_AGENT); }
__device__ __forceinline__ unsigned xb_xcc_id() { return (unsigned)__builtin_amdgcn_s_getreg((3 << 11) | 20) & 0xFu; }
#define XB_SPIN(cond, bar) do { unsigned _sp = 0; while (cond) { __builtin_amdgcn_s_sleep(1); \
    if ((++_sp & 255u) == 0u) { if (xb_ld(&(bar)[XB_TMO])) break; if (_sp > XB_SPIN_CAP) { atomicAdd(&(bar)[XB_TMO], 1u); break; } } } } while (0)

struct XcdBarrier {
    unsigned* bar; unsigned x;
    volatile LAS unsigned* st;
};

__device__ __forceinline__ XcdBarrier xcd_barrier_post(unsigned* bar, volatile LAS unsigned* st) {
    XcdBarrier b; b.bar = bar; b.x = xb_xcc_id(); b.st = st;
    if (threadIdx.x == 0) (void)xb_add(&bar[XB_XCNT(b.x)], 1u);
    return b;
}
__device__ __forceinline__ void xcd_barrier_complete(unsigned* bar, unsigned x, unsigned& nloc, unsigned& nx) {
    const unsigned G = gridDim.x * gridDim.y * gridDim.z;
    unsigned sum, cnt, mine, sp = 0u;
    for (;;) {
        sum = 0u; cnt = 0u; mine = 0u;
#pragma unroll
        for (unsigned j = 0; j < 16; ++j) { const unsigned c = xb_ld(&bar[XB_XCNT(j)]); sum += c; cnt += (c > 0u) ? 1u : 0u; mine = (j == x) ? c : mine; }
        if (sum == G) break;
        __builtin_amdgcn_s_sleep(1);
        if ((++sp & 255u) == 0u) { if (xb_ld(&bar[XB_TMO])) break; if (sp > XB_SPIN_CAP) { atomicAdd(&bar[XB_TMO], 1u); break; } }
    }
    nloc = mine > 0u ? mine : 1u; nx = cnt > 0u ? cnt : 1u;
}

__device__ __forceinline__ void xcd_barrier(const XcdBarrier& b) {
    asm volatile("s_waitcnt vmcnt(0)" ::: "memory");
    __syncthreads();
    if (threadIdx.x == 0) {
        unsigned* bar = b.bar;
        __builtin_amdgcn_s_waitcnt(0);
        unsigned nloc = b.st[0], nx = b.st[1];
        if (nloc == 0u) { xcd_barrier_complete(bar, b.x, nloc, nx); b.st[0] = nloc; b.st[1] = nx; }
        const unsigned old = xb_add(&bar[XB_XSUB(b.x)], 1u);
        const unsigned gen = old / nloc;
        if (old + 1u == (gen + 1u) * nloc) {
            __builtin_amdgcn_fence(__ATOMIC_RELEASE, "agent");
            asm volatile("s_waitcnt vmcnt(0)" ::: "memory");
            const unsigned og = xb_add(&bar[XB_TOP], 1u);
            const unsigned tg = og / nx;
            if (og + 1u == (tg + 1u) * nx) xb_add(&bar[XB_TOPGEN], 1u);
            else XB_SPIN(xb_ld(&bar[XB_TOPGEN]) == tg, bar);
            __builtin_amdgcn_fence(__ATOMIC_ACQUIRE, "agent");
            xb_add(&bar[XB_XGEN(b.x)], 1u);
            asm volatile("s_waitcnt vmcnt(0)" ::: "memory");
        } else {
            XB_SPIN(xb_ld(&bar[XB_XGEN(b.x)]) == gen, bar);
            __builtin_amdgcn_fence(__ATOMIC_ACQUIRE, "agent");
            asm volatile("s_waitcnt vmcnt(0)" ::: "memory");
        }
    }
    __syncthreads();
}

constexpr int NPHASE = 21;
__global__ void __launch_bounds__(NTHR, 2) fwd_kernel(Args a) {
    extern __shared__ __attribute__((aligned(16))) unsigned char lds_raw[];
    LAS unsigned char* lds = (LAS unsigned char*)lds_raw;
    cg::grid_group grid = cg::this_grid();
    const int tid = threadIdx.x, lane = tid & 63, wave = __builtin_amdgcn_readfirstlane(tid >> 6);
    const int G = gridDim.x, gw = blockIdx.x * NWAVES + wave, NGW = G * NWAVES;
    const int lo = a.ph_lo, hi = a.ph_hi;
    volatile LAS unsigned* MISC = (volatile LAS unsigned*)(lds + LDS_BYTES - 256);
    if (tid < 32) MISC[tid] = 0u;
    __syncthreads();
    XcdBarrier bar = xcd_barrier_post((unsigned*)a.ws, MISC + 8);
    if (hi < 0) grid.sync();
#define PH_BEGIN(k) if (lo <= (k) && (k) < hi) { const CAS char* kp_ = kargs_ptr(); unsigned char* const ws = KWS; (void)ws;
#define PH_END(k) if ((k) + 1 < hi) xcd_barrier(bar); }
#define GEMM_BF(k, Aptr, lda_, Bptr, N_, K_, O0, ld0, O1, ld1, split, bias, segw, segstride, ssp, tail_) PH_BEGIN(k) { pg8::Gemm g{(const bf16*)(Aptr), (const bf16*)(Bptr), M, N_, K_, lda_}; pg8::EpiBf16X e{(bf16*)(O0), ld0, (bf16*)(O1), ld1, split, bias, segw, segstride, ssp}; \
        pg8::StaticOrder S; S.init(M, N_, G, (int)blockIdx.x); pg8::gemm_phase<pg8::EpiBf16X, pg8::StaticOrder, true, true>(lds, g, S, e); { tail_; } } PH_END(k)
#define GEMM_GLU(k, Aptr, Bptr, layer, ssp, tail_) PH_BEGIN(k) { pg8::Gemm g{(const bf16*)(Aptr), (const bf16*)(Bptr), M, UW, D, D}; \
        pg8::EpiGlu e{(bf16*)(ws + WS_H), KIN(I_FCW) + (size_t)(layer) * 3 * DFF, KIN(I_FCB) + (size_t)(layer) * DFF, (float*)(ws + WS_HG), (float*)(ws + WS_HV), (float*)(ws + WS_TG), ssp}; \
        pg8::StaticOrder S; S.init(M, UW, G, (int)blockIdx.x); pg8::gemm_phase<pg8::EpiGlu, pg8::StaticOrder, true, true>(lds, g, S, e); { tail_; } } PH_END(k)
#define GEMM_RES(k, Aptr, lda_, Bptr, N_, K_, base, bias, xbp, ssp) PH_BEGIN(k) { pg8::Gemm g{(const bf16*)(Aptr), (const bf16*)(Bptr), M, N_, K_, lda_}; pg8::EpiRes e{base, KOUT, D, bias, (bf16*)(xbp), ssp}; \
        pg8::StaticOrder S; S.init(M, N_, G, (int)blockIdx.x); pg8::gemm_phase<pg8::EpiRes, pg8::StaticOrder, true, true>(lds, g, S, e); } PH_END(k)
    PH_BEGIN(0) p0_prologue(a, lds, tid, lane, wave); PH_END(0)
    GEMM_BF(1, ws + WS_XN1, D, ws + WS_WIN, ABIN, D, ws + WS_PC, 1024, (unsigned char*)KOUT + DO_PR, PRW, 1024, (const float*)(ws + WS_BIASP), PRW, 0, nullptr, if (G == 256 && blockIdx.x >= 192) tail_g1(a, lds, tid, lane, wave, (int)blockIdx.x - 192, 64); else if (G != 256) tail_g1(a, lds, tid, lane, wave, (int)blockIdx.x, G))
    PH_BEGIN(2) p2_prep(a, lds, tid, lane, wave); PH_END(2)
    GEMM_BF(3, ws + WS_LIN, LINW, ws + WS_WL, LOW, LINW, ws + WS_LOW, 512, ws + WS_LOW, 512, 0, nullptr, 512, (size_t)M * 512, nullptr, (void)0)
    PH_BEGIN(4) p4_rwkv_prep(a, lane, wave); PH_END(4)
    PH_BEGIN(5) scan_pass1(a, lds, lane, wave); PH_END(5)
    PH_BEGIN(6) comb_a(a, lds, tid, lane, wave); if (G == 256 && blockIdx.x >= 128) p8_prep2(a, lds, lane, wave, (int)blockIdx.x - 128, 128); else if (G != 256) p8_prep2(a, lds, lane, wave, (int)blockIdx.x, G); PH_END(6)
    PH_BEGIN(6) comb_b(a, lds, tid, lane, wave); PH_END(6)
    PH_BEGIN(6) comb_c(a, lds, tid, lane, wave); PH_END(6)
    PH_BEGIN(7) scan_pass2(a, lds, lane, wave); PH_END(7)
    GEMM_RES(8, ws + WS_CAT, D, ws + WS_WOUT, D, D, KIN(I_X), nullptr, ws + WS_XB, (float*)(ws + WS_SS))
    GEMM_GLU(10, ws + WS_XB, ws + WS_WUP0, 0, (float*)(ws + WS_SS), if (G == 256 && blockIdx.x >= 128) tail_g10(a, lds, lane, wave, (int)blockIdx.x - 128, 128); else if (G != 256) tail_g10(a, lds, lane, wave, (int)blockIdx.x, G))
    PH_BEGIN(11) glu_fixup(a, 0, tid); PH_END(11)
    GEMM_RES(12, ws + WS_H, DFF, ws + WS_WDN0, D, DFF, KOUT, nullptr, ws + WS_XB, (float*)(ws + WS_SS) + M)
    GEMM_BF(14, ws + WS_XB, D, ws + WS_WQKV, QKVW, D, ws + WS_QKV, QKVW, ws + WS_QKV, QKVW, 1 << 30, KIN(I_BQKV), 256, 0, (float*)(ws + WS_SS) + M, if (G == 256 && blockIdx.x >= 128) tail_g14(a, lds, lane, wave, (int)blockIdx.x - 128, 128); else if (G != 256) tail_g14(a, lds, lane, wave, (int)blockIdx.x, G))
    PH_BEGIN(15) p14_attn(a, lds, tid, lane, wave); PH_END(15)
    GEMM_RES(16, ws + WS_O, D, ws + WS_WO, D, D, KOUT, KIN(I_BO), ws + WS_XB, (float*)(ws + WS_SS) + 2 * M)
    GEMM_GLU(18, ws + WS_XB, ws + WS_WUP1, 1, (float*)(ws + WS_SS) + 2 * M, (void)0)
    PH_BEGIN(19) glu_fixup(a, 1, tid); PH_END(19)
    GEMM_RES(20, ws + WS_H, DFF, ws + WS_WDN1, D, DFF, KOUT, nullptr, nullptr, nullptr)
}

#ifndef N_LAUNCH_MODE
#define N_LAUNCH_MODE 1
#endif
extern "C" void kernel_launch(void* const* d_in, const int* in_sizes, int n_in, void* d_out, int out_size, void* d_ws, size_t ws_size, hipStream_t stream) {
    static int grid = 0;
    if (grid == 0) {
        if (n_in != 34 || out_size != M * D || ws_size < WS_END) { fprintf(stderr, "kernel_launch: unexpected shapes n_in %d out %d ws %zu\n", n_in, out_size, ws_size); grid = -1; return; }
        int dev = 0, cus = 0, per_cu = 0;
        hipGetDevice(&dev); hipDeviceGetAttribute(&cus, hipDeviceAttributeMultiprocessorCount, dev);
        if (hipFuncSetAttribute((const void*)fwd_kernel, hipFuncAttributeMaxDynamicSharedMemorySize, LDS_BYTES) != hipSuccess) { fprintf(stderr, "kernel_launch: hipFuncSetAttribute failed\n"); grid = -1; return; }
        if (hipOccupancyMaxActiveBlocksPerMultiprocessor(&per_cu, (const void*)fwd_kernel, NTHR, LDS_BYTES) != hipSuccess || per_cu < 1) { fprintf(stderr, "kernel_launch: occupancy query says %d\n", per_cu); per_cu = 1; }
        (void)hipGetLastError();
        grid = cus * 1;
    }
    if (grid < 0) return;
    if (hipMemsetAsync(d_ws, 0, 16384, stream) != hipSuccess) { fprintf(stderr, "kernel_launch: memset of the barrier words failed\n"); return; }
    Args a{};
    for (int i = 0; i < 34; ++i) a.in[i] = (const float*)d_in[i];
    a.out = (float*)d_out; a.ws = (unsigned char*)d_ws;
#if N_LAUNCH_MODE == 1
    a.ph_lo = 0; a.ph_hi = NPHASE;
    { void* args[] = {&a}; hipError_t e = hipLaunchCooperativeKernel((const void*)fwd_kernel, dim3(grid), dim3(NTHR), args, LDS_BYTES, stream);
      if (e != hipSuccess) fprintf(stderr, "cooperative launch failed: %s (grid %d)\n", hipGetErrorString(e), grid); }
#else
    for (int ph = 0; ph < NPHASE; ++ph) { a.ph_lo = ph; a.ph_hi = ph + 1; void* args[] = {&a};
        hipError_t e = hipLaunchCooperativeKernel((const void*)fwd_kernel, dim3(grid), dim3(NTHR), args, LDS_BYTES, stream);
        if (e != hipSuccess) { fprintf(stderr, "launch %d failed: %s\n", ph, hipGetErrorString(e)); break; } }
#endif
}
```

```cpp
#include <hip/hip_runtime.h>
#include <hip/hip_cooperative_groups.h>
#include <cstdio>
#include <cstdint>
namespace cg = cooperative_groups;
namespace pg8 {
#define PG8_LAS __attribute__((address_space(3)))
typedef unsigned short bf16_t;
typedef short bf16x8 __attribute__((ext_vector_type(8)));
typedef float f32x4 __attribute__((ext_vector_type(4)));
typedef unsigned u32x4 __attribute__((ext_vector_type(4)));
constexpr int BM = 256, BK = 64, HALF = 128, HTB = HALF * BK * 2  , STAGE_BYTES = 8 * HTB, NXCD = 8, WGM = 8;

__host__ __device__ __forceinline__ int lds_byte(int r, int c) { const int st = (r >> 4) * 2 + (c >> 5), rr = r & 15, cc = c & 31, ob = rr * 64 + cc * 2; return st * 1024 + (ob ^ (((ob >> 9) & 1) << 5)); }
__host__ __device__ __forceinline__ void stage_rc(int b, int& R, int& C) { const int st = b / 1024, sb = b % 1024, swz = sb ^ (((sb >> 9) & 1) << 5); R = (st >> 1) * 16 + swz / 64; C = (st & 1) * 32 + (swz % 64) / 2; }
__host__ __device__ __forceinline__ int perm32(int rho) { const int n = rho >> 4, i = rho & 15; return 8 * (i >> 2) + 4 * n + (i & 3); }

struct Unit { int pm, pn; };
struct Gemm { const bf16_t* A; const bf16_t* Bt; int M, N, K, lda; };

struct StaticOrder {
    int nM, nN, nwg, G, c;
    __host__ __device__ void init(int M, int N, int G_, int c_) { nM = M / BM; nN = N / BM; nwg = nM * nN; G = G_; c = c_; }
    __host__ __device__ bool next(int i, Unit& u) const {
        const long L = (long)i * G + c; if (L >= nwg) return false;
        int wgid = (int)L; { const int q = nwg / NXCD, r = nwg % NXCD, xcd = wgid % NXCD, off = wgid / NXCD; wgid = (xcd < r ? xcd * (q + 1) : r * (q + 1) + (xcd - r) * q) + off; }
        const int nig = WGM * nN, gid = wgid / nig, fm = gid * WGM, gsz = (nM - fm) < WGM ? (nM - fm) : WGM;
        u.pm = fm + ((wgid % nig) % gsz); u.pn = (wgid % nig) / gsz; return true;
    }
    __device__ __forceinline__ void a_ready(const Unit&) const {}
    __device__ __forceinline__ void done(const Unit&) const {}
};

__device__ __forceinline__ unsigned cvt_pk_bf16(float lo, float hi) { unsigned r; asm volatile("v_cvt_pk_bf16_f32 %0, %1, %2" : "=v"(r) : "v"(lo), "v"(hi)); return r; }
typedef float f32x2 __attribute__((ext_vector_type(2)));

template <class Epi, class Sched, bool ALIGN_EPI = false, bool SP2 = false>
__device__ __forceinline__ void gemm_phase(PG8_LAS unsigned char* lds, const Gemm g, const Sched& S, const Epi& E) {
    const int tid = threadIdx.x, wid = __builtin_amdgcn_readfirstlane(tid >> 6), lane = tid & 63, wr = wid >> 2, wc = wid & 3, fr = lane & 15, fq = lane >> 4;
    const int K = g.K, nt = K / BK;
    unsigned voffA[2], voffB[2];
#pragma unroll
    for (int i = 0; i < 2; ++i) { int R, C; stage_rc(tid * 16 + i * 8192, R, C); const int Rb = Epi::PERM ? ((R & ~31) + perm32(R & 31)) : R;
        voffA[i] = (unsigned)(R * g.lda + C) * 2u; voffB[i] = (unsigned)(Rb * K + C) * 2u; }
    const size_t kstep = (size_t)(BK * 2);
    const size_t hstep = (size_t)HALF * K * 2;
    const size_t tstep = 2 * hstep; const size_t hstepA = (size_t)HALF * g.lda * 2, tstepA = 2 * hstepA;
    const unsigned ldsw = (unsigned)wid * 1024u;
    const int aoff = lds_byte(wr * 64 + fr, fq * 8), boff = lds_byte(wc * 32 + fr, fq * 8);
#define PG8_SA(b, h) (((b) * 2 + (h)) * HTB)
#define PG8_SB(b, h) ((4 + (b) * 2 + (h)) * HTB)
#define PG8_STAGE(bufoff, gbase, voff) do { _Pragma("unroll") for (int _i = 0; _i < 2; ++_i) \
        __builtin_amdgcn_global_load_lds((const unsigned*)((const char*)(gbase) + (voff)[_i]), (PG8_LAS unsigned*)(lds + (bufoff) + ldsw + _i * 8192), 16, 0, 0); } while (0)
#define PG8_LDA(dst, b, h) do { _Pragma("unroll") for (int m = 0; m < 4; ++m) _Pragma("unroll") for (int k = 0; k < 2; ++k) dst[m][k] = *(const PG8_LAS bf16x8*)(lds + PG8_SA(b, h) + aoff + m * 2048 + k * 1024); } while (0)
#define PG8_LDB(dst, b, h) do { _Pragma("unroll") for (int n = 0; n < 2; ++n) _Pragma("unroll") for (int k = 0; k < 2; ++k) dst[n][k] = *(const PG8_LAS bf16x8*)(lds + PG8_SB(b, h) + boff + n * 2048 + k * 1024); } while (0)
#define PG8_MMA(ai, bj, At, Bt) do { __builtin_amdgcn_s_setprio(1); _Pragma("unroll") for (int m = 0; m < 4; ++m) _Pragma("unroll") for (int n = 0; n < 2; ++n) _Pragma("unroll") for (int k = 0; k < 2; ++k) \
        acc[ai][bj][m][n] = __builtin_amdgcn_mfma_f32_16x16x32_bf16(Bt[n][k], At[m][k], acc[ai][bj][m][n], 0, 0, 0); __builtin_amdgcn_s_setprio(0); } while (0)
#define PG8_WAIT_V(n) asm volatile("s_waitcnt vmcnt(" #n ")" ::: "memory")
#define PG8_WAIT_L(n) asm volatile("s_waitcnt lgkmcnt(" #n ")" ::: "memory")
#define PG8_BAR __builtin_amdgcn_s_barrier()
#define PG8_SCHED __builtin_amdgcn_sched_barrier(0)
    Unit cur, nxt; int ui = 0;
    if (!S.next(0, cur)) return;
    f32x4 acc[2][2][4][2];
#pragma unroll
    for (int a = 0; a < 2; ++a)
#pragma unroll
        for (int b = 0; b < 2; ++b)
#pragma unroll
            for (int m = 0; m < 4; ++m)
#pragma unroll
                for (int n = 0; n < 2; ++n) acc[a][b][m][n] = (f32x4){0.f, 0.f, 0.f, 0.f};
    bf16x8 At[4][2], B0[2][2], B1[2][2];
    const char* cA = (const char*)g.A + (size_t)cur.pm * tstepA; const char* cB = (const char*)g.Bt + (size_t)cur.pn * tstep;
    S.a_ready(cur);
    if constexpr (SP2) {
        PG8_STAGE(PG8_SB(0, 0), cB, voffB); PG8_STAGE(PG8_SB(0, 1), cB + hstep, voffB); PG8_STAGE(PG8_SA(0, 0), cA, voffA); PG8_STAGE(PG8_SA(0, 1), cA + hstepA, voffA);
        if (wr == 1) PG8_BAR;
        PG8_WAIT_V(2); PG8_BAR;
        PG8_STAGE(PG8_SB(1, 0), cB + kstep, voffB); PG8_STAGE(PG8_SA(1, 0), cA + kstep, voffA); PG8_STAGE(PG8_SB(1, 1), cB + hstep + kstep, voffB);
        PG8_WAIT_V(6); PG8_BAR;
    } else {
        PG8_STAGE(PG8_SB(0, 0), cB, voffB); PG8_STAGE(PG8_SA(0, 0), cA, voffA); PG8_STAGE(PG8_SB(0, 1), cB + hstep, voffB); PG8_STAGE(PG8_SA(0, 1), cA + hstepA, voffA);
        if (wr == 1) PG8_BAR;
        PG8_WAIT_V(4); PG8_BAR;
        PG8_STAGE(PG8_SB(1, 0), cB + kstep, voffB); PG8_STAGE(PG8_SA(1, 0), cA + kstep, voffA); PG8_STAGE(PG8_SB(1, 1), cB + hstep + kstep, voffB);
        PG8_WAIT_V(6); PG8_BAR;
    }
    for (;;) {
        const bool has_next = S.next(ui + 1, nxt);
        const char* nA = has_next ? (const char*)g.A + (size_t)nxt.pm * tstepA : cA; const char* nB = has_next ? (const char*)g.Bt + (size_t)nxt.pn * tstep : cB;
        for (int t = 0; t < nt; t += 2) {
            const bool last = (t == nt - 2);
            const char* a1 = cA + (size_t)(t + 1) * kstep;
            const char* a2 = last ? nA : cA + (size_t)(t + 2) * kstep; const char* b2 = last ? nB : cB + (size_t)(t + 2) * kstep;
            const char* a3 = a2 + kstep; const char* b3 = b2 + kstep;
            if (last && has_next) S.a_ready(nxt);
            if constexpr (SP2) {
            PG8_LDB(B0, 0, 0); PG8_LDB(B1, 0, 1); PG8_SCHED; PG8_LDA(At, 0, 0); PG8_STAGE(PG8_SA(1, 1), a1 + hstepA, voffA);
            PG8_WAIT_V(8); PG8_WAIT_L(0); PG8_BAR; PG8_MMA(0, 0, At, B0); PG8_MMA(0, 1, At, B1); PG8_BAR; PG8_SCHED;
            PG8_LDA(At, 0, 1); PG8_STAGE(PG8_SB(0, 0), b2, voffB); PG8_STAGE(PG8_SB(0, 1), b2 + hstep, voffB); PG8_STAGE(PG8_SA(0, 0), a2, voffA);
            PG8_WAIT_V(8); PG8_WAIT_L(0); PG8_BAR; PG8_MMA(1, 0, At, B0); PG8_MMA(1, 1, At, B1); PG8_BAR; PG8_SCHED;
            PG8_LDB(B0, 1, 0); PG8_LDB(B1, 1, 1); PG8_SCHED; PG8_LDA(At, 1, 0); PG8_STAGE(PG8_SA(0, 1), a2 + hstepA, voffA);
            PG8_WAIT_V(8); PG8_WAIT_L(0); PG8_BAR; PG8_MMA(0, 0, At, B0); PG8_MMA(0, 1, At, B1); PG8_BAR; PG8_SCHED;
            PG8_LDA(At, 1, 1); PG8_STAGE(PG8_SB(1, 0), b3, voffB); PG8_STAGE(PG8_SB(1, 1), b3 + hstep, voffB); PG8_STAGE(PG8_SA(1, 0), a3, voffA);
            PG8_WAIT_V(8); PG8_WAIT_L(0); PG8_BAR; PG8_MMA(1, 0, At, B0); PG8_MMA(1, 1, At, B1); PG8_BAR; PG8_SCHED;
            } else {
            PG8_LDB(B0, 0, 0); PG8_SCHED; PG8_LDA(At, 0, 0); PG8_STAGE(PG8_SA(1, 1), a1 + hstepA, voffA);
            PG8_WAIT_L(8); PG8_BAR; PG8_WAIT_L(0); PG8_MMA(0, 0, At, B0); PG8_BAR; PG8_SCHED;
            PG8_LDB(B1, 0, 1); PG8_STAGE(PG8_SB(0, 0), b2, voffB);
            PG8_BAR; PG8_WAIT_L(0); PG8_MMA(0, 1, At, B1); PG8_BAR;
            PG8_LDA(At, 0, 1); PG8_STAGE(PG8_SA(0, 0), a2, voffA);
            PG8_BAR; PG8_WAIT_L(0); PG8_MMA(1, 0, At, B0); PG8_BAR; PG8_SCHED;
            PG8_STAGE(PG8_SB(0, 1), b2 + hstep, voffB);
            PG8_WAIT_V(6); PG8_BAR; PG8_MMA(1, 1, At, B1); PG8_BAR;
            PG8_LDB(B0, 1, 0); PG8_SCHED; PG8_LDA(At, 1, 0); PG8_STAGE(PG8_SA(0, 1), a2 + hstepA, voffA);
            PG8_WAIT_L(8); PG8_BAR; PG8_WAIT_L(0); PG8_MMA(0, 0, At, B0); PG8_BAR; PG8_SCHED;
            PG8_LDB(B1, 1, 1); PG8_STAGE(PG8_SB(1, 0), b3, voffB);
            PG8_BAR; PG8_WAIT_L(0); PG8_MMA(0, 1, At, B1); PG8_BAR;
            PG8_LDA(At, 1, 1); PG8_STAGE(PG8_SA(1, 0), a3, voffA);
            PG8_BAR; PG8_WAIT_L(0); PG8_MMA(1, 0, At, B0); PG8_BAR; PG8_SCHED;
            PG8_STAGE(PG8_SB(1, 1), b3 + hstep, voffB);
            PG8_WAIT_V(6); PG8_BAR; PG8_MMA(1, 1, At, B1); PG8_BAR;
            }
        }
        if constexpr (ALIGN_EPI) { if (wr == 0) PG8_BAR; }
        if constexpr (!Epi::AFTER_DRAIN) { E(acc, cur, wr, wc, fr, fq); S.done(cur); }
        if (!has_next) break;
#pragma unroll
        for (int a = 0; a < 2; ++a)
#pragma unroll
            for (int b = 0; b < 2; ++b)
#pragma unroll
                for (int m = 0; m < 4; ++m)
#pragma unroll
                    for (int n = 0; n < 2; ++n) acc[a][b][m][n] = (f32x4){0.f, 0.f, 0.f, 0.f};
        cur = nxt; cA = nA; cB = nB; ++ui;
        if constexpr (ALIGN_EPI) { if (wr == 1) PG8_BAR; }
    }
    PG8_WAIT_V(0);
    if constexpr (!ALIGN_EPI) { if (wr == 0) PG8_BAR; }
    PG8_BAR;
    if constexpr (Epi::AFTER_DRAIN) { E.fused(acc, cur, wr, wc, fr, fq, lds, wid, lane); S.done(cur); }
#undef PG8_SA
#undef PG8_SB
#undef PG8_STAGE
#undef PG8_LDA
#undef PG8_LDB
#undef PG8_MMA
#undef PG8_WAIT_V
#undef PG8_WAIT_L
#undef PG8_BAR
#undef PG8_SCHED
}
}

namespace pg8 {
struct EpiBf16X {
    static constexpr bool PERM = true, AFTER_DRAIN = false;
    bf16_t* O0; int ld0; bf16_t* O1; int ld1; int split; const float* bias; int segw; size_t segstride; const float* ss;
    __device__ __forceinline__ void operator()(const f32x4 (&acc)[2][2][4][2], const Unit& u, int wr, int wc, int fr, int fq) const {
        const int row0 = u.pm * BM + wr * 64 + fr; const int colt = u.pn * BM;
        bf16_t* base; int ldc, cb;
        if (colt < split) { base = O0; ldc = ld0; cb = colt; } else { const int rel = colt - split, sg = rel / segw; base = O1 + (size_t)sg * segstride; ldc = ld1; cb = rel - sg * segw; }
        const int col0 = cb + wc * 32 + 8 * fq, bcol0 = colt + wc * 32 + 8 * fq;
        f32x4 bv[2][2];
#pragma unroll
        for (int bj = 0; bj < 2; ++bj)
#pragma unroll
            for (int n = 0; n < 2; ++n) bv[bj][n] = bias ? *(const f32x4*)(bias + bcol0 + bj * HALF + 4 * n) : (f32x4){0.f, 0.f, 0.f, 0.f};
#pragma unroll
        for (int ai = 0; ai < 2; ++ai)
#pragma unroll
            for (int m = 0; m < 4; ++m) { bf16_t* rowp = base + (size_t)(row0 + ai * HALF + m * 16) * ldc + col0;
                const float rs = ss ? __builtin_amdgcn_rsqf(ss[row0 + ai * HALF + m * 16] * (1.f / 1024.f) + 1e-6f) : 1.f;
#pragma unroll
                for (int bj = 0; bj < 2; ++bj) { const f32x4 v0 = acc[ai][bj][m][0] * rs + bv[bj][0], v1 = acc[ai][bj][m][1] * rs + bv[bj][1];
                    u32x4 w; w.x = cvt_pk_bf16(v0[0], v0[1]); w.y = cvt_pk_bf16(v0[2], v0[3]); w.z = cvt_pk_bf16(v1[0], v1[1]); w.w = cvt_pk_bf16(v1[2], v1[3]);
                    *(u32x4*)(rowp + bj * HALF) = w; } }
    }
};
struct EpiRes {
    static constexpr bool PERM = false, AFTER_DRAIN = false;
    const float* base; float* out; int ldc; const float* bias; bf16_t* xb; float* ss;
    __device__ __forceinline__ void operator()(const f32x4 (&acc)[2][2][4][2], const Unit& u, int wr, int wc, int fr, int fq) const {
        const int col0 = u.pn * BM + wc * 32 + 4 * fq;
        f32x4 bv[2][2];
#pragma unroll
        for (int bj = 0; bj < 2; ++bj)
#pragma unroll
            for (int n = 0; n < 2; ++n) bv[bj][n] = bias ? *(const f32x4*)(bias + col0 + bj * HALF + n * 16) : (f32x4){0.f, 0.f, 0.f, 0.f};
#pragma unroll
        for (int ai = 0; ai < 2; ++ai)
#pragma unroll
            for (int m = 0; m < 4; ++m) { const int row = u.pm * BM + ai * HALF + wr * 64 + m * 16 + fr; const size_t off = (size_t)row * ldc + col0; float sq = 0.f;
#pragma unroll
                for (int bj = 0; bj < 2; ++bj)
#pragma unroll
                    for (int n = 0; n < 2; ++n) { const size_t o = off + bj * HALF + n * 16; const f32x4 bs = *(const f32x4*)(base + o);
                        const f32x4 v = bs + acc[ai][bj][m][n] + bv[bj][n]; *(f32x4*)(out + o) = v;
                        if (xb) { sq += (v[0] * v[0] + v[1] * v[1]) + (v[2] * v[2] + v[3] * v[3]);
                            typedef unsigned u32x2_ __attribute__((ext_vector_type(2))); u32x2_ w; w.x = cvt_pk_bf16(v[0], v[1]); w.y = cvt_pk_bf16(v[2], v[3]); *(u32x2_*)(xb + o) = w; } }
                if (xb) { sq += __shfl_xor(sq, 16); sq += __shfl_xor(sq, 32); if (fq == 0) atomicAdd(ss + row, sq); } }
    }
};
struct EpiGlu {
    static constexpr bool PERM = true, AFTER_DRAIN = false;
    bf16_t* H; const float* cw; const float* cb; float* HG; float* HV; float* TG; const float* ss;
    __device__ __forceinline__ void operator()(const f32x4 (&acc)[2][2][4][2], const Unit& u, int wr, int wc, int fr, int fq) const {
        constexpr int DFF_ = 2816;
        const int gc0 = u.pn * 128 + wc * 32 + 8 * fq;
        float w0[8], w1[8], w2[8], bb[8];
#pragma unroll
        for (int h = 0; h < 2; ++h) { const f32x4 a0 = *(const f32x4*)(cw + gc0 + 4 * h), a1 = *(const f32x4*)(cw + DFF_ + gc0 + 4 * h), a2 = *(const f32x4*)(cw + 2 * DFF_ + gc0 + 4 * h), a3 = *(const f32x4*)(cb + gc0 + 4 * h);
#pragma unroll
            for (int e = 0; e < 4; ++e) { w0[4 * h + e] = a0[e]; w1[4 * h + e] = a1[e]; w2[4 * h + e] = a2[e]; bb[4 * h + e] = a3[e]; } }
        const int l1 = (fq << 4) | ((fr + 15) & 15), l2 = (fq << 4) | ((fr + 14) & 15);
#pragma unroll
        for (int ai = 0; ai < 2; ++ai) {
            const int rbase = u.pm * BM + ai * HALF + wr * 64; const int blk = rbase >> 6;
            float rs[4];
#pragma unroll
            for (int m = 0; m < 4; ++m) rs[m] = __builtin_amdgcn_rsqf(ss[rbase + m * 16 + fr] * (1.f / 1024.f) + 1e-6f);
#pragma unroll
            for (int m = 0; m < 4; ++m) {
                float g[8], gp[8], vl[8], o[8];
#pragma unroll
                for (int n = 0; n < 2; ++n)
#pragma unroll
                    for (int e = 0; e < 4; ++e) { g[4 * n + e] = acc[ai][0][m][n][e] * rs[m]; vl[4 * n + e] = acc[ai][1][m][n][e] * rs[m]; gp[4 * n + e] = m > 0 ? acc[ai][0][m - 1][n][e] * rs[m - 1] : 0.f; }
#pragma unroll
                for (int e = 0; e < 8; ++e) { const float s1 = fr == 15 ? gp[e] : g[e], s2 = fr >= 14 ? gp[e] : g[e];
                    const float p1 = __shfl(s1, l1), p2 = __shfl(s2, l2);
                    const float x = w0[e] * p2 + w1[e] * p1 + w2[e] * g[e] + bb[e];
                    o[e] = x * __builtin_amdgcn_rcpf(1.f + __expf(-x)) * vl[e]; }
                const int row = rbase + m * 16 + fr;
                if (m == 0 && fr < 2) {
                    float* hg = HG + ((size_t)blk * 2 + fr) * DFF_ + gc0; float* hv = HV + ((size_t)blk * 2 + fr) * DFF_ + gc0;
                    *(f32x4*)hg = (f32x4){g[0], g[1], g[2], g[3]}; *(f32x4*)(hg + 4) = (f32x4){g[4], g[5], g[6], g[7]};
                    *(f32x4*)hv = (f32x4){vl[0], vl[1], vl[2], vl[3]}; *(f32x4*)(hv + 4) = (f32x4){vl[4], vl[5], vl[6], vl[7]};
                } else {
                    u32x4 w; w.x = cvt_pk_bf16(o[0], o[1]); w.y = cvt_pk_bf16(o[2], o[3]); w.z = cvt_pk_bf16(o[4], o[5]); w.w = cvt_pk_bf16(o[6], o[7]);
                    *(u32x4*)(H + (size_t)row * DFF_ + gc0) = w;
                }
                if (m == 3 && fr >= 14) { float* tg = TG + ((size_t)blk * 2 + (fr - 14)) * DFF_ + gc0;
                    *(f32x4*)tg = (f32x4){g[0], g[1], g[2], g[3]}; *(f32x4*)(tg + 4) = (f32x4){g[4], g[5], g[6], g[7]}; }
            }
        }
    }
};
}

constexpr int NWAVES = 8, NTHR = 512;
constexpr int BATCH = 2, T = 8192, D = 1024, M = BATCH * T;
constexpr int ABIN = 2816, PRW = 1792, DFF = 2816, UW = 5632, QKVW = 1536, LOW = 1536, LINW = 256, NH = 8;
constexpr size_t MiB = 1u << 20;
constexpr size_t WS_BON = 1 * MiB, WS_BIASP = 1 * MiB + 768 * 1024;
constexpr size_t WS_WIN = 2 * MiB, WS_WL = 8 * MiB, WS_WOUT = 254 * MiB, WS_LOW = 13 * MiB, WS_LOA = 29 * MiB, WS_LOG = 45 * MiB, WS_ST = 13 * MiB, WS_CAT = 61 * MiB, WS_SEQ = 93 * MiB;
constexpr size_t WS_XN1 = 93 * MiB, WS_PC = 125 * MiB, WS_LIN = 157 * MiB;
constexpr size_t WS_ROPE = 253 * MiB;
constexpr size_t DO_PR = 0, DO_ST = 56 * MiB;
constexpr size_t WS_WUP0 = 2 * MiB, WS_WDN0 = 13 * MiB, WS_WQKV = 19 * MiB, WS_WO = 22 * MiB, WS_WUP1 = 24 * MiB, WS_WDN1 = 35 * MiB;
constexpr size_t WS_H = 41 * MiB, WS_HG = 130 * MiB, WS_HV = 136 * MiB, WS_TG = 142 * MiB, WS_QKV = 41 * MiB, WS_O = 89 * MiB, WS_XB = 219 * MiB, WS_END = 256 * MiB;
constexpr size_t WS_SS = 1 * MiB + 512 * 1024;
constexpr int LDS_BYTES = 147456;

#define LAS __attribute__((address_space(3)))
typedef unsigned short bf16;
typedef float f32x4 __attribute__((ext_vector_type(4)));
typedef unsigned v4u __attribute__((ext_vector_type(4)));
typedef unsigned v2u __attribute__((ext_vector_type(2)));
typedef short bf16x8 __attribute__((ext_vector_type(8)));
typedef float f32x16 __attribute__((ext_vector_type(16)));
typedef float f32x2 __attribute__((ext_vector_type(2)));
#define LDS_WAIT() asm volatile("s_waitcnt lgkmcnt(0)" ::: "memory")

typedef __bf16 bf16x2_hw __attribute__((ext_vector_type(2)));
__device__ __forceinline__ unsigned pk2(float lo, float hi) { const f32x2 v = {lo, hi}; return __builtin_bit_cast(unsigned, __builtin_convertvector(v, bf16x2_hw)); }
__device__ __forceinline__ unsigned f2bf(float f) { return pk2(f, 0.f) & 0xffffu; }
__device__ __forceinline__ float bf2f(unsigned h) { return __builtin_bit_cast(float, h << 16); }
__device__ __forceinline__ float bflo(unsigned w) { return __builtin_bit_cast(float, w << 16); }
__device__ __forceinline__ float bfhi(unsigned w) { return __builtin_bit_cast(float, w & 0xffff0000u); }
template <int CTRL> __device__ __forceinline__ float dppf(float x) { return __builtin_bit_cast(float, __builtin_amdgcn_update_dpp(0, __builtin_bit_cast(int, x), CTRL, 0xf, 0xf, false)); }
template <int O> __device__ __forceinline__ float xstep(float v) {
    if constexpr (O == 1) return v + dppf<0xB1>(v);
    else if constexpr (O == 2) return v + dppf<0x4E>(v);
    else if constexpr (O == 4) return v + dppf<0x141>(v);
    else if constexpr (O == 8) return v + dppf<0x140>(v);
    else return v + __shfl_xor(v, O);
}
__device__ __forceinline__ float wave_sum(float v) {
    v = xstep<1>(v); v = xstep<2>(v); v = xstep<4>(v); v = xstep<8>(v); v = xstep<16>(v); v = xstep<32>(v);
    return v;
}
__device__ __forceinline__ float sigm(float x) { return __builtin_amdgcn_rcpf(1.f + __expf(-x)); }
__device__ __forceinline__ float tanh_fast(float x) { return 1.f - 2.f * __builtin_amdgcn_rcpf(__expf(2.f * x) + 1.f); }

struct Args { const float* in[34]; float* out; unsigned char* ws; int ph_lo, ph_hi; };
#define CAS __attribute__((address_space(4)))
__device__ __forceinline__ const CAS char* kargs_ptr() { const CAS char* kp = (const CAS char*)__builtin_amdgcn_kernarg_segment_ptr(); asm volatile("" : "+s"(kp)); return kp; }
#define KIN(i) (*(const float* const CAS*)(kp_ + 8 * (i)))
#define KOUT (*(float* const CAS*)(kp_ + 8 * 34))
#define KWS (*(unsigned char* const CAS*)(kp_ + 8 * 35))
enum { I_X = 0, I_POS, I_ABG, I_WIN, I_CINB, I_DWW, I_DWB, I_CLNG, I_CLNB, I_MU, I_W0, I_W2, I_A0, I_A2, I_G2, I_KK, I_KA, I_RK, I_RLNG, I_RLNB, I_WOUT,
       I_ATG, I_WQKV, I_BQKV, I_QNG, I_KNG, I_SINK, I_WO, I_BO, I_FNG, I_WUP, I_FCW, I_FCB, I_WDN };

__device__ __forceinline__ void transpose_item(const float* W, int K, int N, bf16* WT, LAS float* scr, int item, int lane, const float* gain, int glu) {
    const int nblk = N / 32, kb = item / nblk, nb = item % nblk, k0 = 64 * kb, n0 = 32 * nb;
#pragma unroll 8
    for (int i = 0; i < 32; ++i) { const int kk = 2 * i + (lane >> 5); const float gk = gain ? gain[k0 + kk] : 1.f; scr[kk * 33 + (lane & 31)] = W[(size_t)(k0 + kk) * N + n0 + (lane & 31)] * gk; }
    LDS_WAIT(); asm volatile("" ::: "memory");
    const int c = lane & 7;
#pragma unroll
    for (int j = 0; j < 4; ++j) { const int n = (lane >> 3) + 8 * j; const LAS float* s = scr + (8 * c) * 33 + n;
        v4u o; o.x = pk2(s[0 * 33], s[1 * 33]); o.y = pk2(s[2 * 33], s[3 * 33]); o.z = pk2(s[4 * 33], s[5 * 33]); o.w = pk2(s[6 * 33], s[7 * 33]);
        const int nn = n0 + n; const int dr = glu ? (nn < DFF ? (nn >> 7) * 256 + (nn & 127) : ((nn - DFF) >> 7) * 256 + 128 + ((nn - DFF) & 127)) : nn;
        *(v4u*)(WT + (size_t)dr * K + k0 + 8 * c) = o; }
    LDS_WAIT(); asm volatile("" ::: "memory");
}
__device__ __forceinline__ void transpose_mat(const float* W, int K, int N, bf16* WT, LAS float* scr, int gw, int NGW, int lane, const float* gain = nullptr, int glu = 0) {
    const int nitems = (K / 64) * (N / 32);
    for (int it = gw; it < nitems; it += NGW) transpose_item(W, K, N, WT, scr, it, lane, gain, glu);
}
__device__ __forceinline__ void rms_rows(const float* src, const float* g, bf16* dst, int gw, int NGW, int lane) {
    for (int m = gw; m < M; m += NGW) {
        const f32x4* xr = (const f32x4*)(src + (size_t)m * D) + lane; const f32x4* gr = (const f32x4*)g + lane;
        f32x4 v[4]; float s = 0.f;
#pragma unroll
        for (int j = 0; j < 4; ++j) { v[j] = xr[64 * j]; s += (v[j].x * v[j].x + v[j].y * v[j].y) + (v[j].z * v[j].z + v[j].w * v[j].w); }
        const float rstd = __builtin_amdgcn_rsqf(wave_sum(s) * (1.f / D) + 1e-6f);
        unsigned long long* o8 = (unsigned long long*)(dst + (size_t)m * D) + lane;
#pragma unroll
        for (int j = 0; j < 4; ++j) { const f32x4 gg = gr[64 * j];
            o8[64 * j] = (unsigned long long)pk2(v[j].x * rstd * gg.x, v[j].y * rstd * gg.y) | ((unsigned long long)pk2(v[j].z * rstd * gg.z, v[j].w * rstd * gg.w) << 32); }
    }
}

__device__ __forceinline__ void p0_prologue(const Args& a, LAS unsigned char* lds, int tid, int lane, int wave) {
    const CAS char* kp_ = kargs_ptr();
    LAS float* scr = (LAS float*)(lds + wave * 16384);
    const int G = gridDim.x, gw = blockIdx.x * NWAVES + wave, NGW = G * NWAVES, gt = blockIdx.x * NTHR + tid, NGT = G * NTHR;
    transpose_mat(KIN(I_WIN), D, ABIN, (bf16*)(KWS + WS_WIN), scr, gw, NGW, lane);
    { float* bp = (float*)(KWS + WS_BIASP); for (int i = gt; i < ABIN; i += NGT) bp[i] = i < 1024 ? KIN(I_CINB)[i] : 0.f; }
    rms_rows(KIN(I_X), KIN(I_ABG), (bf16*)(KWS + WS_XN1), gw, NGW, lane);
}

__device__ __forceinline__ void p2_prep(const Args& a, LAS unsigned char* lds, int tid, int lane, int wave) {
    const CAS char* kp_ = kargs_ptr();
    const bf16* PC = (const bf16*)(KWS + WS_PC); const bf16* PR = (const bf16*)((unsigned char*)KOUT + DO_PR);
    bf16* CAT = (bf16*)(KWS + WS_CAT); bf16* LIN = (bf16*)(KWS + WS_LIN);
    LAS float* ybuf = (LAS float*)lds;
    const int c = tid;
    float wv[31];
#pragma unroll
    for (int j = 0; j < 31; ++j) wv[j] = KIN(I_DWW)[j * 512 + c];
    const float bc = KIN(I_DWB)[c];
    for (int tile = blockIdx.x; tile < M / 32; tile += gridDim.x) {
        const int b = tile / (T / 32), tt0 = (tile % (T / 32)) * 32;
        float g[62];
        if (tt0 >= 30) {
            const bf16* rowp = PC + (size_t)(b * T + tt0 - 30) * 1024 + c;
#pragma unroll
            for (int i = 0; i < 62; ++i) { const float x1 = bf2f(rowp[i * 1024]), x2 = bf2f(rowp[i * 1024 + 512]); g[i] = x1 * sigm(x2); }
        } else {
            const bf16* rowp = PC + (size_t)(b * T) * 1024 + c;
#pragma unroll
            for (int i = 0; i < 30; ++i) g[i] = 0.f;
#pragma unroll
            for (int i = 30; i < 62; ++i) { const float x1 = bf2f(rowp[(i - 30) * 1024]), x2 = bf2f(rowp[(i - 30) * 1024 + 512]); g[i] = x1 * sigm(x2); }
        }
#pragma unroll
        for (int tt = 0; tt < 32; ++tt) { float y = bc;
#pragma unroll
            for (int j = 0; j < 31; ++j) y += wv[j] * g[tt + j];
            ybuf[tt * 512 + c] = y; }
        __syncthreads();
#pragma unroll
        for (int q = 0; q < 4; ++q) { const int tt = wave * 4 + q; const LAS f32x4* yr = (const LAS f32x4*)(ybuf + tt * 512 + lane * 8);
            const f32x4 y0 = yr[0], y1 = yr[1];
            const float mean = wave_sum((y0.x + y0.y) + (y0.z + y0.w) + (y1.x + y1.y) + (y1.z + y1.w)) * (1.f / 512.f);
            const f32x4 d0 = y0 - mean, d1 = y1 - mean;
            const float var = wave_sum((d0.x * d0.x + d0.y * d0.y) + (d0.z * d0.z + d0.w * d0.w) + (d1.x * d1.x + d1.y * d1.y) + (d1.z * d1.z + d1.w * d1.w)) * (1.f / 512.f);
            const float rstd = __builtin_amdgcn_rsqf(var + 1e-5f);
            const f32x4 g0 = *(const f32x4*)(KIN(I_CLNG) + lane * 8), g1 = *(const f32x4*)(KIN(I_CLNG) + lane * 8 + 4);
            const f32x4 b0 = *(const f32x4*)(KIN(I_CLNB) + lane * 8), b1 = *(const f32x4*)(KIN(I_CLNB) + lane * 8 + 4);
            f32x4 o0 = d0 * rstd * g0 + b0, o1 = d1 * rstd * g1 + b1;
            o0.x *= sigm(o0.x); o0.y *= sigm(o0.y); o0.z *= sigm(o0.z); o0.w *= sigm(o0.w); o1.x *= sigm(o1.x); o1.y *= sigm(o1.y); o1.z *= sigm(o1.z); o1.w *= sigm(o1.w);
            v4u w; w.x = pk2(o0.x, o0.y); w.y = pk2(o0.z, o0.w); w.z = pk2(o1.x, o1.y); w.w = pk2(o1.z, o1.w);
            *(v4u*)(CAT + (size_t)(b * T + tt0 + tt) * 1024 + lane * 8) = w; }
        __syncthreads();
    }
    const int gt = blockIdx.x * NTHR + tid, NGT = gridDim.x * NTHR;
    for (int w = gt; w < (M / 32) * LINW; w += NGT) { const int j = w & 255, m_start = (w >> 8) * 32;
        const bf16* p = PR + (size_t)m_start * PRW + 1536 + j; bf16* o = LIN + (size_t)m_start * LINW + j;
        const float mu = KIN(I_MU)[1536 + j];
        float prev = (m_start & (T - 1)) != 0 ? bf2f(p[-PRW]) : 0.f;
#pragma unroll 8
        for (int i = 0; i < 32; ++i) { const float p1 = bf2f(p[i * PRW]); const float xs = p1 + (prev - p1) * mu; prev = p1;
            const float v = j < 64 ? tanh_fast(xs) : (j < 128 ? xs : sigm(xs));
            o[i * LINW] = (bf16)f2bf(v); }
    }
}

constexpr int SLABB = 2048, RUNL = 64;
constexpr size_t WS_WLC = 256 * 1024;
struct SlabRegs { v4u p1, p2; };
__device__ __forceinline__ void slab_load(SlabRegs& r, const unsigned char* slab, int lane) {
    r.p1 = *(const v4u*)(slab + lane * 16); r.p2 = *(const v4u*)(slab + 1024 + lane * 16);
}
__device__ __forceinline__ void slab_piece(const v4u q, LAS float* dst, int p) {
    LAS float* d = dst + (p >> 5) * 256 + ((p >> 3) & 3) * 64 + (p & 7) * 8;
    *(LAS f32x4*)d = (f32x4){bflo(q.x), bfhi(q.x), bflo(q.y), bfhi(q.y)}; *(LAS f32x4*)(d + 4) = (f32x4){bflo(q.z), bfhi(q.z), bflo(q.w), bfhi(q.w)};
}
__device__ __forceinline__ void slab_store(const SlabRegs& r, LAS float* dst, int lane) { slab_piece(r.p1, dst, lane); slab_piece(r.p2, dst, lane + 64); }
__device__ __forceinline__ void p4_rwkv_prep(const Args& a, int lane, int wave) {
    const CAS char* kp_ = kargs_ptr();
    const bf16* PR = (const bf16*)((unsigned char*)KOUT + DO_PR); const bf16* LOWp = (const bf16*)(KWS + WS_LOW); const bf16* LOAp = (const bf16*)(KWS + WS_LOA);
    unsigned char* SEQ = KWS + WS_SEQ; float* BON = (float*)(KWS + WS_BON); float* WLC = (float*)(KWS + WS_WLC);
    const int gw = blockIdx.x * NWAVES + wave, NGW = gridDim.x * NWAVES;
    constexpr int RUN = 64, U = 4;
    for (int run = gw; run < (M / RUN) * NH; run += NGW) { const int h = run & 7, mbase = (run >> 3) * RUN, c = h * 64 + lane, b = mbase / T;
        const float mur = KIN(I_MU)[c], muk = KIN(I_MU)[512 + c], w0 = KIN(I_W0)[c], a0 = KIN(I_A0)[c], kkc = KIN(I_KK)[c], kac = KIN(I_KA)[c], rkc = KIN(I_RK)[c];
        float rp = 0.f, kp_ = 0.f, Wc = 1.f;
        if ((mbase & (T - 1)) != 0) { rp = bf2f(PR[(size_t)(mbase - 1) * PRW + c]); kp_ = bf2f(PR[(size_t)(mbase - 1) * PRW + 512 + c]); }
        for (int i0 = 0; i0 < RUN; i0 += U) {
            float r1[U], k1[U], lw[U], la[U];
#pragma unroll
            for (int u = 0; u < U; ++u) { const size_t m = (size_t)(mbase + i0 + u); r1[u] = bf2f(PR[m * PRW + c]); k1[u] = bf2f(PR[m * PRW + 512 + c]); lw[u] = bf2f(LOWp[m * 512 + c]); la[u] = bf2f(LOAp[m * 512 + c]); }
            float kkr[U], kpv[U], rr[U], dec[U], agv[U], n2[U], bn[U];
#pragma unroll
            for (int u = 0; u < U; ++u) {
                const float r = r1[u] + (rp - r1[u]) * mur, k = k1[u] + (kp_ - k1[u]) * muk; rp = r1[u]; kp_ = k1[u];
                const float z = -(w0 + lw[u]);
                const float sp = fmaxf(z, 0.f) + __logf(1.f + __expf(-fabsf(z)));
                dec[u] = __expf(-__expf(-sp - 0.5f));
                const float ag = sigm(a0 + la[u]); agv[u] = ag;
                kkr[u] = k * kkc; n2[u] = kkr[u] * kkr[u];
                kpv[u] = k * (1.f + (ag - 1.f) * kac); rr[u] = r; bn[u] = r * kpv[u] * rkc; }
#define P4_STEP(O) _Pragma("unroll") for (int u = 0; u < U; ++u) { n2[u] = xstep<O>(n2[u]); bn[u] = xstep<O>(bn[u]); }
            P4_STEP(1) P4_STEP(2) P4_STEP(4) P4_STEP(8) P4_STEP(16) P4_STEP(32)
#undef P4_STEP
#pragma unroll
            for (int u = 0; u < U; ++u) { const int m = mbase + i0 + u, t = m & (T - 1);
                const float kk = kkr[u] * __builtin_amdgcn_rsqf(fmaxf(n2[u], 1e-24f));
                unsigned char* sl_ = SEQ + ((size_t)(b * NH + h) * (T / 4) + (t >> 2)) * SLABB; const int st_ = t & 3;
                const float ap = -kk * Wc; Wc *= dec[u]; const float iW = __builtin_amdgcn_rcpf(Wc);
                bf16* hb = (bf16*)(sl_ + st_ * 512) + lane;
                hb[0] = (bf16)f2bf(ap); hb[64] = (bf16)f2bf(kk * agv[u] * iW); hb[128] = (bf16)f2bf(kpv[u] * iW); hb[192] = (bf16)f2bf(rr[u] * Wc);
                if (lane == 0) BON[(size_t)m * NH + h] = bn[u]; }
        }
        WLC[((size_t)(b * NH + h) * (T / RUNL) + (mbase & (T - 1)) / RUNL) * 64 + lane] = Wc;
    }
}

__device__ __forceinline__ int crow(int r, int hi) { return (r & 3) + 8 * (r >> 2) + 4 * hi; }
constexpr int SLAB = 4, SLABF = SLAB * 256;
constexpr int NCH = 64, CL = T / NCH;
template <int MODE>
__device__ __forceinline__ void scan_task(const Args& a, LAS float* wl, int lane, int chain, int ck) {
    const CAS char* kp_ = kargs_ptr();
    const bf16* PR = (const bf16*)((unsigned char*)KOUT + DO_PR); const bf16* LOGp = (const bf16*)(KWS + WS_LOG);
    const unsigned char* SEQ = KWS + WS_SEQ; const float* BON = (const float*)(KWS + WS_BON); bf16* CAT = (bf16*)(KWS + WS_CAT);
    float* ST = (float*)(KWS + WS_ST);
    const int b = chain >> 3, h = chain & 7, c = h * 64 + lane, t0 = ck * CL;
    const float muv = KIN(I_MU)[1024 + c];
    float lng = 0.f, lnb = 0.f;
    if constexpr (MODE == 2) { lng = KIN(I_RLNG)[c]; lnb = KIN(I_RLNB)[c]; }
    f32x2 S[32];
#pragma unroll
    for (int j = 0; j < 32; ++j) S[j] = (f32x2){0.f, 0.f};
    if constexpr (MODE == 3) {
#pragma unroll
        for (int j = 0; j < 32; ++j) S[j] = (f32x2){lane == 2 * j ? 1.f : 0.f, lane == 2 * j + 1 ? 1.f : 0.f};
    }
    if constexpr (MODE == 2) {
        if (ck > 0) { const f32x4* sp = (const f32x4*)(ST + ((size_t)(chain * NCH + ck - 1) * 2) * 4096 + lane * 64);
#pragma unroll
            for (int j = 0; j < 16; ++j) { const f32x4 q = sp[j]; S[2 * j] = q.xy; S[2 * j + 1] = q.zw; } }
    }
    const unsigned char* sq = SEQ + ((size_t)chain * (T / SLAB) + t0 / SLAB) * SLABB;
    const size_t m0 = (size_t)b * T + t0;
    float pprev = 0.f;
    if constexpr (MODE != 3) pprev = t0 > 0 ? bf2f(PR[(m0 - 1) * PRW + 1024 + c]) : 0.f;
    SlabRegs pre; unsigned pvn[SLAB], gtn[SLAB]; float bnn[SLAB];
    slab_load(pre, sq, lane);
#pragma unroll
    for (int s = 0; s < SLAB; ++s) { const size_t m = m0 + s; if constexpr (MODE != 3) pvn[s] = PR[m * PRW + 1024 + c]; if constexpr (MODE == 2) { gtn[s] = LOGp[m * 512 + c]; bnn[s] = BON[m * NH + h]; } }
    slab_store(pre, wl, lane);
    for (int sl = 0; sl < CL / SLAB; ++sl) {
        const int buf = sl & 1; const LAS float* ob = wl + buf * SLABF;
        if (sl == RUNL / SLAB) {
            const f32x4* wq = (const f32x4*)((const float*)(KWS + WS_WLC) + ((size_t)chain * (T / RUNL) + t0 / RUNL) * 64);
#pragma unroll
            for (int j = 0; j < 16; ++j) { const f32x4 q = wq[j]; S[2 * j] *= q.xy; S[2 * j + 1] *= q.zw; } }
        unsigned pvc[SLAB], gtc[SLAB]; float bnc[SLAB];
#pragma unroll
        for (int s = 0; s < SLAB; ++s) { if constexpr (MODE != 3) pvc[s] = pvn[s]; if constexpr (MODE == 2) { gtc[s] = gtn[s]; bnc[s] = bnn[s]; } }
        const int sn = (sl + 1 < CL / SLAB) ? sl + 1 : sl;
        slab_load(pre, sq + (size_t)sn * SLABB, lane);
#pragma unroll
        for (int s = 0; s < SLAB; ++s) { const size_t m = m0 + (size_t)sn * SLAB + s; if constexpr (MODE != 3) pvn[s] = PR[m * PRW + 1024 + c]; if constexpr (MODE == 2) { gtn[s] = LOGp[m * 512 + c]; bnn[s] = BON[m * NH + h]; } }
        __builtin_amdgcn_sched_barrier(0);
        float ys[SLAB], vs[SLAB];
        constexpr int NIT = 20, NQ = (MODE == 2 ? 3 : (MODE == 1 ? 2 : 1));
        f32x4 ring[8][4];
        const LAS f32x4* o4b = (const LAS f32x4*)ob;
#define SCAN_LD(it_) do { const int st_ = (it_) / NIT, lc_ = (it_) % NIT; const LAS f32x4* o4_ = o4b + st_ * 64; \
            if (lc_ < 4) { _Pragma("unroll") for (int q_ = 0; q_ < 4; ++q_) ring[(it_) & 7][q_] = o4_[4 * lc_ + q_]; } \
            else { _Pragma("unroll") for (int q_ = 0; q_ < NQ; ++q_) ring[(it_) & 7][q_] = o4_[16 * (q_ + 1) + (lc_ - 4)]; } } while (0)
        SCAN_LD(0); SCAN_LD(1); SCAN_LD(2); SCAN_LD(3); SCAN_LD(4); SCAN_LD(5);
        f32x2 sa0 = {0.f, 0.f}, sa1 = {0.f, 0.f}, y0 = {0.f, 0.f}, y1 = {0.f, 0.f}, sav = {0.f, 0.f}, vv = {0.f, 0.f};
#pragma unroll
        for (int it = 0; it < SLAB * NIT; ++it) {
            const int st = it / NIT, lc = it % NIT;
            if (it + 6 < SLAB * NIT) SCAN_LD(it + 6);
            if (lc == 0) { float v = 0.f;
                if constexpr (MODE != 3) { const float pv = bf2f(pvc[st]); v = pv + (pprev - pv) * muv; pprev = pv; }
                vs[st] = v; vv = (f32x2){v, v}; sa0 = (f32x2){0.f, 0.f}; sa1 = (f32x2){0.f, 0.f}; y0 = (f32x2){0.f, 0.f}; y1 = (f32x2){0.f, 0.f}; }
            if (lc < 4) {
#pragma unroll
                for (int q = 0; q < 4; ++q) { const f32x4 a4 = ring[it & 7][q]; sa0 += S[8 * lc + 2 * q] * a4.xy; sa1 += S[8 * lc + 2 * q + 1] * a4.zw; }
                if (lc == 3) { const float sa = (sa0.x + sa0.y) + (sa1.x + sa1.y); sav = (f32x2){sa, sa}; }
            } else { const int j = lc - 4; const f32x4 b4 = ring[it & 7][0];
                f32x2 n0 = S[2 * j] + sav * b4.xy, n1 = S[2 * j + 1] + sav * b4.zw;
                if constexpr (MODE != 3) { const f32x4 k4 = ring[it & 7][1]; n0 += vv * k4.xy; n1 += vv * k4.zw; }
                S[2 * j] = n0; S[2 * j + 1] = n1;
                if constexpr (MODE == 2) { const f32x4 r4 = ring[it & 7][2]; y0 += n0 * r4.xy; y1 += n1 * r4.zw; if (lc == NIT - 1) ys[st] = (y0.x + y0.y) + (y1.x + y1.y); }
            }
            __builtin_amdgcn_sched_barrier(0);
        }
#undef SCAN_LD
        if constexpr (MODE == 2) {
            float mu4[SLAB], d4[SLAB], q4[SLAB];
#pragma unroll
            for (int s = 0; s < SLAB; ++s) mu4[s] = ys[s];
#define GN_STEP(A_, O) _Pragma("unroll") for (int s = 0; s < SLAB; ++s) A_[s] = xstep<O>(A_[s]);
            GN_STEP(mu4, 1) GN_STEP(mu4, 2) GN_STEP(mu4, 4) GN_STEP(mu4, 8) GN_STEP(mu4, 16) GN_STEP(mu4, 32)
#pragma unroll
            for (int s = 0; s < SLAB; ++s) { d4[s] = ys[s] - mu4[s] * (1.f / 64.f); q4[s] = d4[s] * d4[s]; }
            GN_STEP(q4, 1) GN_STEP(q4, 2) GN_STEP(q4, 4) GN_STEP(q4, 8) GN_STEP(q4, 16) GN_STEP(q4, 32)
#undef GN_STEP
#pragma unroll
            for (int s = 0; s < SLAB; ++s) { float yn = d4[s] * __builtin_amdgcn_rsqf(q4[s] * (1.f / 64.f) + 64e-5f) * lng + lnb;
                yn += bnc[s] * vs[s]; yn *= bf2f(gtc[s]);
                CAT[(m0 + (size_t)sl * SLAB + s) * 1024 + 512 + c] = (bf16)f2bf(yn); }
        }
        slab_store(pre, wl + (buf ^ 1) * SLABF, lane);
    }
    if constexpr (MODE != 2) {
        f32x4* dm = (f32x4*)(ST + ((size_t)(chain * NCH + ck) * 2 + (MODE == 1 ? 1 : 0)) * 4096 + lane * 64);
#pragma unroll
        for (int j = 0; j < 16; ++j) { f32x4 q; q.xy = S[2 * j]; q.zw = S[2 * j + 1]; dm[j] = q; }
    }
}
__device__ __forceinline__ void scan_task_p1(const Args& a, LAS float* wl, int lane, int chain, int ck, int rh) {
    const CAS char* kp_ = kargs_ptr();
    const bf16* PR = (const bf16*)((unsigned char*)KOUT + DO_PR); const unsigned char* SEQ = KWS + WS_SEQ; float* ST = (float*)(KWS + WS_ST);
    const int b = chain >> 3, h = chain & 7, r32 = lane & 31, kh = lane >> 5, row = 32 * rh + r32, c = h * 64 + row, t0 = ck * CL;
    const float muv = KIN(I_MU)[1024 + c];
    f32x2 Sn[16], Sm[16];
#pragma unroll
    for (int j = 0; j < 16; ++j) { Sn[j] = (f32x2){0.f, 0.f}; Sm[j] = (f32x2){row == 32 * kh + 2 * j ? 1.f : 0.f, row == 32 * kh + 2 * j + 1 ? 1.f : 0.f}; }
    const unsigned char* sq = SEQ + ((size_t)chain * (T / SLAB) + t0 / SLAB) * SLABB;
    const size_t m0 = (size_t)b * T + t0;
    float pprev = t0 > 0 ? bf2f(PR[(m0 - 1) * PRW + 1024 + c]) : 0.f;
    SlabRegs pre; unsigned pvn[SLAB];
    slab_load(pre, sq, lane);
#pragma unroll
    for (int s = 0; s < SLAB; ++s) pvn[s] = PR[(m0 + s) * PRW + 1024 + c];
    slab_store(pre, wl, lane);
    for (int sl = 0; sl < CL / SLAB; ++sl) {
        const int buf = sl & 1; const LAS float* ob = wl + buf * SLABF;
        if (sl == RUNL / SLAB) {
            const f32x4* wq = (const f32x4*)((const float*)(KWS + WS_WLC) + ((size_t)chain * (T / RUNL) + t0 / RUNL) * 64 + 32 * kh);
#pragma unroll
            for (int j = 0; j < 8; ++j) { const f32x4 q = wq[j]; Sn[2 * j] *= q.xy; Sn[2 * j + 1] *= q.zw; Sm[2 * j] *= q.xy; Sm[2 * j + 1] *= q.zw; } }
        unsigned pvc[SLAB];
#pragma unroll
        for (int s = 0; s < SLAB; ++s) pvc[s] = pvn[s];
        const int sn = (sl + 1 < CL / SLAB) ? sl + 1 : sl;
        slab_load(pre, sq + (size_t)sn * SLABB, lane);
#pragma unroll
        for (int s = 0; s < SLAB; ++s) pvn[s] = PR[(m0 + (size_t)sn * SLAB + s) * PRW + 1024 + c];
        __builtin_amdgcn_sched_barrier(0);
        constexpr int NIT = 10;
        f32x4 ring[4][4];
        const LAS f32x4* o4b = (const LAS f32x4*)ob + 8 * kh;
#define P1_LD(it_) do { const int st_ = (it_) / NIT, lc_ = (it_) % NIT; const LAS f32x4* o4_ = o4b + st_ * 64; \
            if (lc_ < 2) { _Pragma("unroll") for (int q_ = 0; q_ < 4; ++q_) ring[(it_) & 3][q_] = o4_[4 * lc_ + q_]; } \
            else { _Pragma("unroll") for (int q_ = 0; q_ < 2; ++q_) ring[(it_) & 3][q_] = o4_[16 * (q_ + 1) + (lc_ - 2)]; } } while (0)
        P1_LD(0); P1_LD(1); P1_LD(2);
        f32x2 an0 = {0.f, 0.f}, an1 = {0.f, 0.f}, am0 = {0.f, 0.f}, am1 = {0.f, 0.f}, sanv = {0.f, 0.f}, samv = {0.f, 0.f}, vv = {0.f, 0.f};
#pragma unroll
        for (int it = 0; it < SLAB * NIT; ++it) {
            const int st = it / NIT, lc = it % NIT;
            if (it + 3 < SLAB * NIT) P1_LD(it + 3);
            if (lc == 0) { const float pv = bf2f(pvc[st]); const float v = pv + (pprev - pv) * muv; pprev = pv; vv = (f32x2){v, v};
                an0 = (f32x2){0.f, 0.f}; an1 = (f32x2){0.f, 0.f}; am0 = (f32x2){0.f, 0.f}; am1 = (f32x2){0.f, 0.f}; }
            if (lc < 2) {
#pragma unroll
                for (int q = 0; q < 4; ++q) { const f32x4 a4 = ring[it & 3][q];
                    an0 += Sn[8 * lc + 2 * q] * a4.xy; an1 += Sn[8 * lc + 2 * q + 1] * a4.zw; am0 += Sm[8 * lc + 2 * q] * a4.xy; am1 += Sm[8 * lc + 2 * q + 1] * a4.zw; }
                if (lc == 1) { float san = (an0.x + an0.y) + (an1.x + an1.y), sam = (am0.x + am0.y) + (am1.x + am1.y);
                    san += __shfl_xor(san, 32); sam += __shfl_xor(sam, 32); sanv = (f32x2){san, san}; samv = (f32x2){sam, sam}; }
            } else { const int j = lc - 2; const f32x4 b4 = ring[it & 3][0], k4 = ring[it & 3][1];
                Sn[2 * j] = Sn[2 * j] + sanv * b4.xy + vv * k4.xy; Sn[2 * j + 1] = Sn[2 * j + 1] + sanv * b4.zw + vv * k4.zw;
                Sm[2 * j] = Sm[2 * j] + samv * b4.xy;              Sm[2 * j + 1] = Sm[2 * j + 1] + samv * b4.zw;
            }
            __builtin_amdgcn_sched_barrier(0);
        }
#undef P1_LD
        slab_store(pre, wl + (buf ^ 1) * SLABF, lane);
    }
    f32x4* dm = (f32x4*)(ST + ((size_t)(chain * NCH + ck) * 2) * 4096 + row * 64 + 32 * kh); f32x4* dn = dm + 1024;
    const f32x4* wq = (const f32x4*)((const float*)(KWS + WS_WLC) + ((size_t)chain * (T / RUNL) + t0 / RUNL + 1) * 64 + 32 * kh);
#pragma unroll
    for (int j = 0; j < 8; ++j) { const f32x4 w4 = wq[j]; f32x4 q; q.xy = Sm[2 * j] * w4.xy; q.zw = Sm[2 * j + 1] * w4.zw; dm[j] = q; f32x4 p; p.xy = Sn[2 * j] * w4.xy; p.zw = Sn[2 * j + 1] * w4.zw; dn[j] = p; }
}
__device__ __forceinline__ void scan_pass1(const Args& a, LAS unsigned char* lds, int lane, int wave) {
    LAS float* wl = (LAS float*)(lds + wave * (2 * SLABF * 4));
    const int ntask = 2 * BATCH * NH * (NCH - 1);
    for (int wk = wave * gridDim.x + blockIdx.x; wk < ntask; wk += NWAVES * gridDim.x) {
        const int rh = wk & 1, chain = (wk >> 1) & 15, ck = wk >> 5;
        scan_task_p1(a, wl, lane, chain, ck, rh);
    }
}
__device__ __forceinline__ void scan_pass2(const Args& a, LAS unsigned char* lds, int lane, int wave) {
    LAS float* wl = (LAS float*)(lds + wave * (2 * SLABF * 4));
    for (int wk = wave * gridDim.x + blockIdx.x; wk < BATCH * NH * NCH; wk += NWAVES * gridDim.x) scan_task<2>(a, wl, lane, wk & 15, wk >> 4);
}
constexpr int GS = 8, NG = NCH / GS;
__device__ __forceinline__ f32x16 mm_acc(const LAS float* X, const LAS float* Mm, f32x16 acc, int ti, int tn, int kh, int l31, int hi) {
    const LAS float* sb = X + (32 * ti + l31) * 65 + 32 * kh + hi;
    const LAS float* mb = Mm + (32 * kh + hi) * 64 + 32 * tn + l31;
#pragma unroll
    for (int kk = 0; kk < 16; ++kk) acc = __builtin_amdgcn_mfma_f32_32x32x2f32(sb[2 * kk], mb[2 * kk * 64], acc, 0, 0, 0);
    return acc;
}
__device__ __forceinline__ void comb_a(const Args& a, LAS unsigned char* lds, int tid, int lane, int wave) {
    const CAS char* kp_ = kargs_ptr();
    if (blockIdx.x >= BATCH * NH * NG) return;
    const int chain = blockIdx.x & 15, g = blockIdx.x >> 4, c0 = g * GS;
    float* ST = (float*)(KWS + WS_ST);
    LAS float* XM = (LAS float*)lds;
    LAS float* XN = XM + 2 * 4160;
    LAS float* Mb = XN + 2 * 4160;
    LAS float* Nb = Mb + 4096;
    LAS float* Pb = Nb + 4096;
    const int l31 = lane & 31, hi = lane >> 5, tile = wave & 3, ti = tile >> 1, tn = tile & 1, kh = wave >> 2;
    const int jmax = (c0 + GS - 1 <= NCH - 2) ? GS - 1 : NCH - 2 - c0;
    f32x4 rq[4];
    { const f32x4* gm = (const f32x4*)(ST + ((size_t)(chain * NCH + c0) * 2) * 4096);
#pragma unroll
      for (int e = 0; e < 2; ++e) { const int idx = tid + 512 * e; const f32x4 m = gm[idx], n = gm[1024 + idx]; const int r = idx >> 4, cc = (idx & 15) * 4;
#pragma unroll
          for (int q = 0; q < 4; ++q) { XM[r * 65 + cc + q] = m[q]; XN[r * 65 + cc + q] = n[q]; } }
      const f32x4* g1 = gm + 2048;
      rq[0] = g1[tid]; rq[1] = g1[tid + 512]; rq[2] = g1[1024 + tid]; rq[3] = g1[1024 + tid + 512]; }
    int cur = 0;
    for (int j = 1; j <= jmax; ++j) {
#pragma unroll
        for (int e = 0; e < 2; ++e) { const int idx = tid + 512 * e; *(LAS f32x4*)(Mb + idx * 4) = rq[e]; *(LAS f32x4*)(Nb + idx * 4) = rq[2 + e]; }
        { const int cn = (j + 1 <= jmax) ? c0 + j + 1 : c0 + j; const f32x4* gm = (const f32x4*)(ST + ((size_t)(chain * NCH + cn) * 2) * 4096);
          rq[0] = gm[tid]; rq[1] = gm[tid + 512]; rq[2] = gm[1024 + tid]; rq[3] = gm[1024 + tid + 512]; }
        __syncthreads();
        f32x16 am, an;
#pragma unroll
        for (int r = 0; r < 16; ++r) { am[r] = 0.f; an[r] = kh == 0 ? Nb[(32 * ti + crow(r, hi)) * 64 + 32 * tn + l31] : 0.f; }
        am = mm_acc(XM + cur * 4160, Mb, am, ti, tn, kh, l31, hi);
        an = mm_acc(XN + cur * 4160, Mb, an, ti, tn, kh, l31, hi);
        if (kh == 1) {
#pragma unroll
            for (int r = 0; r < 16; ++r) { Pb[(tile * 16 + r) * 64 + lane] = am[r]; Pb[4096 + (tile * 16 + r) * 64 + lane] = an[r]; }
        }
        __syncthreads();
        if (kh == 0) {
            float* gs = ST + ((size_t)(chain * NCH + c0 + j) * 2) * 4096;
#pragma unroll
            for (int r = 0; r < 16; ++r) { const float vm = am[r] + Pb[(tile * 16 + r) * 64 + lane], vn = an[r] + Pb[4096 + (tile * 16 + r) * 64 + lane]; const int row = 32 * ti + crow(r, hi), col = 32 * tn + l31;
                XM[(cur ^ 1) * 4160 + row * 65 + col] = vm; XN[(cur ^ 1) * 4160 + row * 65 + col] = vn; gs[row * 64 + col] = vm; gs[4096 + row * 64 + col] = vn; }
        }
        cur ^= 1;
    }
}
__device__ __forceinline__ void comb_b(const Args& a, LAS unsigned char* lds, int tid, int lane, int wave) {
    const CAS char* kp_ = kargs_ptr();
    if (blockIdx.x >= BATCH * NH) return;
    const int chain = blockIdx.x;
    float* ST = (float*)(KWS + WS_ST);
    LAS float* Sb = (LAS float*)lds;
    LAS float* Mb = Sb + 2 * 4160;
    LAS float* Nb = Mb + 4096;
    LAS float* Pb = Nb + 4096;
    const int l31 = lane & 31, hi = lane >> 5, tile = wave & 3, ti = tile >> 1, tn = tile & 1, kh = wave >> 2;
    for (int i = tid; i < 2 * 4160; i += NTHR) Sb[i] = 0.f;
    f32x4 rq[4];
    { const f32x4* gm = (const f32x4*)(ST + ((size_t)(chain * NCH + GS - 1) * 2) * 4096); rq[0] = gm[tid]; rq[1] = gm[tid + 512]; rq[2] = gm[1024 + tid]; rq[3] = gm[1024 + tid + 512]; }
    int cur = 0;
    for (int g = 0; g < NG - 1; ++g) {
        const int c = g * GS + GS - 1;
#pragma unroll
        for (int e = 0; e < 2; ++e) { const int idx = tid + 512 * e; *(LAS f32x4*)(Mb + idx * 4) = rq[e]; *(LAS f32x4*)(Nb + idx * 4) = rq[2 + e]; }
        { const int cn = (g + 1 < NG - 1) ? c + GS : c; const f32x4* gm = (const f32x4*)(ST + ((size_t)(chain * NCH + cn) * 2) * 4096);
          rq[0] = gm[tid]; rq[1] = gm[tid + 512]; rq[2] = gm[1024 + tid]; rq[3] = gm[1024 + tid + 512]; }
        __syncthreads();
        f32x16 acc;
#pragma unroll
        for (int r = 0; r < 16; ++r) acc[r] = kh == 0 ? Nb[(32 * ti + crow(r, hi)) * 64 + 32 * tn + l31] : 0.f;
        acc = mm_acc(Sb + cur * 4160, Mb, acc, ti, tn, kh, l31, hi);
        if (kh == 1) {
#pragma unroll
            for (int r = 0; r < 16; ++r) Pb[(tile * 16 + r) * 64 + lane] = acc[r];
        }
        __syncthreads();
        if (kh == 0) {
            float* gs = ST + ((size_t)(chain * NCH + c) * 2) * 4096;
#pragma unroll
            for (int r = 0; r < 16; ++r) { const float v = acc[r] + Pb[(tile * 16 + r) * 64 + lane]; const int row = 32 * ti + crow(r, hi), col = 32 * tn + l31;
                Sb[(cur ^ 1) * 4160 + row * 65 + col] = v; gs[row * 64 + col] = v; }
        }
        cur ^= 1;
    }
}
__device__ __forceinline__ void comb_c(const Args& a, LAS unsigned char* lds, int tid, int lane, int wave) {
    const CAS char* kp_ = kargs_ptr();
    float* ST = (float*)(KWS + WS_ST);
    LAS float* Sb = (LAS float*)lds;
    LAS float* Mb = Sb + 4160;
    LAS float* Nb = Mb + 4096;
    LAS float* Pb = Nb + 4096;
    const int l31 = lane & 31, hi = lane >> 5, tile = wave & 3, ti = tile >> 1, tn = tile & 1, kh = wave >> 2;
    for (int task = blockIdx.x; task < BATCH * NH * NG * (GS - 1); task += gridDim.x) {
        const int chain = task & 15, g = (task >> 4) & (NG - 1), j = task >> 7, c = g * GS + j;
        { const f32x4* gm = (const f32x4*)(ST + ((size_t)(chain * NCH + c) * 2) * 4096);
          const f32x4* gx = (const f32x4*)(ST + ((size_t)(chain * NCH + (g > 0 ? (g * GS - 1) : 0)) * 2) * 4096);
#pragma unroll
          for (int e = 0; e < 2; ++e) { const int idx = tid + 512 * e; *(LAS f32x4*)(Mb + idx * 4) = gm[idx]; *(LAS f32x4*)(Nb + idx * 4) = gm[1024 + idx];
              const f32x4 x = g > 0 ? gx[idx] : (f32x4){0.f, 0.f, 0.f, 0.f}; const int r = idx >> 4, cc = (idx & 15) * 4;
#pragma unroll
              for (int q = 0; q < 4; ++q) Sb[r * 65 + cc + q] = x[q]; } }
        __syncthreads();
        f32x16 acc;
#pragma unroll
        for (int r = 0; r < 16; ++r) acc[r] = kh == 0 ? Nb[(32 * ti + crow(r, hi)) * 64 + 32 * tn + l31] : 0.f;
        acc = mm_acc(Sb, Mb, acc, ti, tn, kh, l31, hi);
        if (kh == 1) {
#pragma unroll
            for (int r = 0; r < 16; ++r) Pb[(tile * 16 + r) * 64 + lane] = acc[r];
        }
        __syncthreads();
        if (kh == 0) {
            float* gs = ST + ((size_t)(chain * NCH + c) * 2) * 4096;
#pragma unroll
            for (int r = 0; r < 16; ++r) gs[(32 * ti + crow(r, hi)) * 64 + 32 * tn + l31] = acc[r] + Pb[(tile * 16 + r) * 64 + lane];
        }
        __syncthreads();
    }
}

__device__ __forceinline__ void glu_fixup(const Args& a, int layer, int tid) {
    const CAS char* kp_ = kargs_ptr();
    bf16* H = (bf16*)(KWS + WS_H); const float* HG = (const float*)(KWS + WS_HG); const float* HV = (const float*)(KWS + WS_HV); const float* TG = (const float*)(KWS + WS_TG);
    const float* cw = KIN(I_FCW) + (size_t)layer * 3 * DFF; const float* cb = KIN(I_FCB) + (size_t)layer * DFF;
    const int gt = blockIdx.x * NTHR + tid, NGT = gridDim.x * NTHR;
    for (int i = gt; i < (M / 64) * 2 * DFF; i += NGT) { const int c = i % DFF, bj = i / DFF, j = bj & 1, blk = bj >> 1;
        const bool first = (blk & (T / 64 - 1)) == 0;
        const float g2 = HG[(size_t)bj * DFF + c];
        const float t1 = first ? 0.f : TG[((size_t)(blk - 1) * 2 + 1) * DFF + c], t0 = first ? 0.f : TG[((size_t)(blk - 1) * 2) * DFF + c];
        const float g1 = j == 1 ? HG[((size_t)blk * 2) * DFF + c] : t1, g0 = j == 1 ? t1 : t0;
        const float x = cw[c] * g0 + cw[DFF + c] * g1 + cw[2 * DFF + c] * g2 + cb[c];
        H[(size_t)(blk * 64 + j) * DFF + c] = (bf16)f2bf(x * sigm(x) * HV[(size_t)bj * DFF + c]); }
}

constexpr int KS_PITCH = 144, VT_PITCH = 528, KS_BYTES = 256 * KS_PITCH;
__device__ __forceinline__ void p14_attn(const Args& a, LAS unsigned char* lds, int tid, int lane, int wave) {
    const CAS char* kp_ = kargs_ptr();
    const bf16* QKV = (const bf16*)(KWS + WS_QKV); bf16* O = (bf16*)(KWS + WS_O); const float* TAB = (const float*)(KWS + WS_ROPE);
    LAS unsigned char* Ks = lds; LAS unsigned char* Vt = lds + KS_BYTES;
    const int q = lane & 31, hi = lane >> 5;
    for (int u = blockIdx.x; u < BATCH * (T / 128) * 4; u += gridDim.x) {
        const int g = u & 3, qb = (u >> 2) & 63, b = u >> 8; const int tok0 = b * T + qb * 128;
        const int hq = g * 4 + (wave >> 1);
        v4u qcur[4];
        { const bf16* qp = QKV + (size_t)(tok0 + 64 * (wave & 1) + q) * QKVW + hq * 64 + 8 * hi;
#pragma unroll
          for (int ks = 0; ks < 4; ++ks) qcur[ks] = *(const v4u*)(qp + 16 * ks); }
        if (tid < 256) {
            const int kj = tid; const bool valid = (qb > 0) || (kj >= 128); const int token = tok0 - 128 + kj;
            float x[64];
            if (valid) { const v4u* src = (const v4u*)(QKV + (size_t)token * QKVW + 1024 + g * 64);
#pragma unroll
                for (int s = 0; s < 8; ++s) { const v4u w = src[s]; x[8 * s] = bflo(w.x); x[8 * s + 1] = bfhi(w.x); x[8 * s + 2] = bflo(w.y); x[8 * s + 3] = bfhi(w.y); x[8 * s + 4] = bflo(w.z); x[8 * s + 5] = bfhi(w.z); x[8 * s + 6] = bflo(w.w); x[8 * s + 7] = bfhi(w.w); }
                float ss = 0.f;
#pragma unroll
                for (int d = 0; d < 64; ++d) ss += x[d] * x[d];
                const float rstd = 1.0f / sqrtf(ss * (1.f / 64.f) + 1e-6f);
#pragma unroll
                for (int d = 0; d < 64; ++d) x[d] = x[d] * rstd * KIN(I_KNG)[d];
#pragma unroll
                for (int i = 0; i < 8; ++i) { const float cs = TAB[(size_t)token * 16 + i], sn = TAB[(size_t)token * 16 + 8 + i]; const float x1 = x[i], x2 = x[i + 8]; x[i] = x1 * cs - x2 * sn; x[i + 8] = x2 * cs + x1 * sn; }
            } else {
#pragma unroll
                for (int d = 0; d < 64; ++d) x[d] = 0.f;
            }
#pragma unroll
            for (int s = 0; s < 8; ++s) { v4u w; w.x = pk2(x[8 * s], x[8 * s + 1]); w.y = pk2(x[8 * s + 2], x[8 * s + 3]); w.z = pk2(x[8 * s + 4], x[8 * s + 5]); w.w = pk2(x[8 * s + 6], x[8 * s + 7]);
                *(LAS v4u*)(Ks + kj * KS_PITCH + s * 16) = w; }
        } else {
            const int tv = tid - 256;
#pragma unroll
            for (int rep = 0; rep < 4; ++rep) { const int item = tv + 256 * rep, kp = item >> 3, seg = item & 7; const int k0 = 2 * kp; const bool valid = (qb > 0) || (k0 >= 128);
                v4u w0 = {0, 0, 0, 0}, w1 = {0, 0, 0, 0};
                if (valid) { const size_t o = (size_t)(tok0 - 128 + k0) * QKVW + 1280 + g * 64 + seg * 8; w0 = *(const v4u*)(QKV + o); w1 = *(const v4u*)(QKV + o + QKVW); }
                const unsigned e0[4] = {w0.x, w0.y, w0.z, w0.w}, e1[4] = {w1.x, w1.y, w1.z, w1.w};
#pragma unroll
                for (int p = 0; p < 4; ++p) { const int d = seg * 8 + 2 * p;
                    *(LAS unsigned*)(Vt + d * VT_PITCH + k0 * 2) = (e0[p] & 0xffffu) | (e1[p] << 16);
                    *(LAS unsigned*)(Vt + (d + 1) * VT_PITCH + k0 * 2) = (e0[p] >> 16) | (e1[p] & 0xffff0000u); }
            }
        }
        __syncthreads();
        const float sink = KIN(I_SINK)[hq];
#pragma unroll 1
        for (int sb = 0; sb < 2; ++sb) {
            v4u qnext[4];
            { const bf16* qp = QKV + (size_t)(tok0 + 64 * (wave & 1) + 32 + q) * QKVW + hq * 64 + 8 * hi;
#pragma unroll
              for (int ks = 0; ks < 4; ++ks) qnext[ks] = *(const v4u*)(qp + 16 * ks); }
            const int qi0 = 64 * (wave & 1) + 32 * sb; const int token = tok0 + qi0 + q;
            float qv[4][8];
            { float ss = 0.f;
#pragma unroll
              for (int ks = 0; ks < 4; ++ks) { const v4u w = qcur[ks];
                  qv[ks][0] = bflo(w.x); qv[ks][1] = bfhi(w.x); qv[ks][2] = bflo(w.y); qv[ks][3] = bfhi(w.y); qv[ks][4] = bflo(w.z); qv[ks][5] = bfhi(w.z); qv[ks][6] = bflo(w.w); qv[ks][7] = bfhi(w.w);
#pragma unroll
                  for (int j = 0; j < 8; ++j) ss += qv[ks][j] * qv[ks][j]; }
              ss += __shfl_xor(ss, 32);
              const float rstd = 1.0f / sqrtf(ss * (1.f / 64.f) + 1e-6f);
#pragma unroll
              for (int ks = 0; ks < 4; ++ks)
#pragma unroll
                  for (int j = 0; j < 8; ++j) qv[ks][j] = qv[ks][j] * rstd * KIN(I_QNG)[16 * ks + 8 * hi + j];
#pragma unroll
              for (int j = 0; j < 8; ++j) { const float other = __shfl_xor(qv[0][j], 32); const float cs = TAB[(size_t)token * 16 + j], sn = TAB[(size_t)token * 16 + 8 + j];
                  qv[0][j] = hi == 0 ? qv[0][j] * cs - other * sn : qv[0][j] * cs + other * sn; }
            }
            bf16x8 qf[4];
#pragma unroll
            for (int ks = 0; ks < 4; ++ks) { v4u w; w.x = pk2(qv[ks][0] * 0.125f, qv[ks][1] * 0.125f); w.y = pk2(qv[ks][2] * 0.125f, qv[ks][3] * 0.125f); w.z = pk2(qv[ks][4] * 0.125f, qv[ks][5] * 0.125f); w.w = pk2(qv[ks][6] * 0.125f, qv[ks][7] * 0.125f);
                qf[ks] = __builtin_bit_cast(bf16x8, w); }
            const int kt0 = qi0 >> 5;
            f32x16 sc[5];
#pragma unroll
            for (int i = 0; i < 5; ++i) {
#pragma unroll
                for (int r = 0; r < 16; ++r) sc[i][r] = 0.f;
#pragma unroll
                for (int ks = 0; ks < 4; ++ks) { const bf16x8 kf = *(const LAS bf16x8*)(Ks + (32 * (kt0 + i) + q) * KS_PITCH + (16 * ks + 8 * hi) * 2);
                    sc[i] = __builtin_amdgcn_mfma_f32_32x32x16_bf16(kf, qf[ks], sc[i], 0, 0, 0); }
            }
            const int qi = qi0 + q; float mx = sink;
#pragma unroll
            for (int i = 0; i < 5; ++i)
#pragma unroll
                for (int r = 0; r < 16; ++r) { const int kj = 32 * (kt0 + i) + crow(r, hi); const int rel = qi + 128 - kj; const bool ok = (rel >= 0) && (rel < 128) && ((qb > 0) || (kj >= 128));
                    sc[i][r] = ok ? sc[i][r] : -INFINITY; mx = fmaxf(mx, sc[i][r]); }
            mx = fmaxf(mx, __shfl_xor(mx, 32));
            float sum = 0.f;
#pragma unroll
            for (int i = 0; i < 5; ++i)
#pragma unroll
                for (int r = 0; r < 16; ++r) { const float p = __expf(sc[i][r] - mx); sc[i][r] = p; sum += p; }
            sum += __shfl_xor(sum, 32);
            const float inv = 1.0f / (sum + __expf(sink - mx));
            f32x16 oa[2];
#pragma unroll
            for (int dt = 0; dt < 2; ++dt)
#pragma unroll
                for (int r = 0; r < 16; ++r) oa[dt][r] = 0.f;
#pragma unroll
            for (int i = 0; i < 5; ++i)
#pragma unroll
                for (int s2 = 0; s2 < 2; ++s2) { v4u pw; pw.x = pk2(sc[i][8 * s2], sc[i][8 * s2 + 1]); pw.y = pk2(sc[i][8 * s2 + 2], sc[i][8 * s2 + 3]); pw.z = pk2(sc[i][8 * s2 + 4], sc[i][8 * s2 + 5]); pw.w = pk2(sc[i][8 * s2 + 6], sc[i][8 * s2 + 7]);
                    const bf16x8 pb = __builtin_bit_cast(bf16x8, pw);
#pragma unroll
                    for (int dt = 0; dt < 2; ++dt) { const LAS unsigned char* vp = Vt + (q + 32 * dt) * VT_PITCH + (32 * (kt0 + i) + 16 * s2 + 4 * hi) * 2;
                        const v2u lo = *(const LAS v2u*)vp, hh = *(const LAS v2u*)(vp + 16); v4u vw; vw.x = lo.x; vw.y = lo.y; vw.z = hh.x; vw.w = hh.y;
                        oa[dt] = __builtin_amdgcn_mfma_f32_32x32x16_bf16(__builtin_bit_cast(bf16x8, vw), pb, oa[dt], 0, 0, 0); } }
            bf16* op = O + (size_t)token * 1024 + hq * 64 + 4 * hi;
#pragma unroll
            for (int dt = 0; dt < 2; ++dt)
#pragma unroll
                for (int rg = 0; rg < 4; ++rg) { v2u w; w.x = pk2(oa[dt][4 * rg] * inv, oa[dt][4 * rg + 1] * inv); w.y = pk2(oa[dt][4 * rg + 2] * inv, oa[dt][4 * rg + 3] * inv);
                    *(v2u*)(op + 32 * dt + 8 * rg) = w; }
#pragma unroll
            for (int ks = 0; ks < 4; ++ks) qcur[ks] = qnext[ks];
        }
        __syncthreads();
    }
}

__device__ __forceinline__ void p8_prep2(const Args& a, LAS unsigned char* lds, int lane, int wave, int vb, int nb) {
    const CAS char* kp_ = kargs_ptr();
    LAS float* scr = (LAS float*)(lds + wave * 16384);
    const int gw = vb * NWAVES + wave, NGW = nb * NWAVES;
    transpose_mat(KIN(I_WUP), D, UW, (bf16*)(KWS + WS_WUP0), scr, gw, NGW, lane, KIN(I_FNG), 1);
}
__device__ __forceinline__ void tail_g10(const Args& a, LAS unsigned char* lds, int lane, int wave, int vb, int nb) {
    const CAS char* kp_ = kargs_ptr();
    LAS float* scr = (LAS float*)(lds + wave * 16384);
    const int gw = vb * NWAVES + wave, NGW = nb * NWAVES;
    transpose_mat(KIN(I_WDN), DFF, D, (bf16*)(KWS + WS_WDN0), scr, gw, NGW, lane);
    transpose_mat(KIN(I_WQKV), D, QKVW, (bf16*)(KWS + WS_WQKV), scr, gw, NGW, lane, KIN(I_ATG));
    transpose_mat(KIN(I_WO), D, D, (bf16*)(KWS + WS_WO), scr, gw, NGW, lane);
}
__device__ __forceinline__ void tail_g14(const Args& a, LAS unsigned char* lds, int lane, int wave, int vb, int nb) {
    const CAS char* kp_ = kargs_ptr();
    LAS float* scr = (LAS float*)(lds + wave * 16384);
    const int gw = vb * NWAVES + wave, NGW = nb * NWAVES;
    transpose_mat(KIN(I_WUP) + (size_t)D * UW, D, UW, (bf16*)(KWS + WS_WUP1), scr, gw, NGW, lane, KIN(I_FNG) + D, 1);
    transpose_mat(KIN(I_WDN) + (size_t)DFF * D, DFF, D, (bf16*)(KWS + WS_WDN1), scr, gw, NGW, lane);
}
__device__ __forceinline__ void tail_g1(const Args& a, LAS unsigned char* lds, int tid, int lane, int wave, int vb, int nb) {
    const CAS char* kp_ = kargs_ptr();
    LAS float* scr = (LAS float*)(lds + wave * 16384);
    const int gw = vb * NWAVES + wave, NGW = nb * NWAVES, gt = vb * NTHR + tid, NGT = nb * NTHR;
    transpose_mat(KIN(I_WOUT), D, D, (bf16*)(KWS + WS_WOUT), scr, gw, NGW, lane);
    {
        bf16* WL = (bf16*)(KWS + WS_WL);
        for (int i = gt; i < LOW * LINW; i += NGT) { const int n = i >> 8, k = i & 255; float v = 0.f;
            if (n < 512) { if (k < 64) v = KIN(I_W2)[k * 512 + n]; }
            else if (n < 1024) { if (k >= 64 && k < 128) v = KIN(I_A2)[(k - 64) * 512 + (n - 512)]; }
            else { if (k >= 128) v = KIN(I_G2)[(k - 128) * 512 + (n - 1024)]; }
            WL[i] = (bf16)f2bf(v); }
    }
    { float* ssz = (float*)(KWS + WS_SS); for (int i = gt; i < 3 * M; i += NGT) ssz[i] = 0.f; }
    {
        float* tab = (float*)(KWS + WS_ROPE); const int* pos = (const int*)KIN(I_POS);
        for (int i = gt; i < M * 8; i += NGT) { const int m = i >> 3, f = i & 7;
            double inv;
            switch (f) { case 0: inv = 1.0; break; case 1: inv = 0.19392274474868576; break; case 2: inv = 0.03760603093086393; break; case 3: inv = 0.007292664737217109; break;
                         case 4: inv = 0.001414213562373095; break; case 5: inv = 0.0002742481756762073; break; case 6: inv = 5.318295896944988e-05; break; default: inv = 1.031338537721246e-05; break; }
            const double rev = (double)pos[m] * inv * 0.15915494309189535; const float fr = (float)(rev - __builtin_rint(rev));
            tab[m * 16 + f] = __builtin_amdgcn_cosf(fr); tab[m * 16 + 8 + f] = __builtin_amdgcn_sinf(fr); }
    }
}

#define XB_TMO      128
#define XB_XCNT(j)  (256  + 64 * (j))
#define XB_XSUB(j)  (1280 + 64 * (j))
#define XB_XGEN(j)  (2304 + 64 * (j))
#define XB_TOP      3328
#define XB_TOPGEN   3392
#define XCD_BAR_WORDS 3456
#define XB_SPIN_CAP (1u << 18)

__device__ __forceinline__ unsigned xb_ld(unsigned* p)              { return __hip_atomic_load(p, __ATOMIC_RELAXED, __HIP_MEMORY_SCOPE_AGENT); }
__device__ __forceinline__ unsigned xb_add(unsigned* p, unsigned v) { return __hip_atomic_fetch_add(p, v, __ATOMIC_RELAXED, __HIP_MEMORY_SCOPE_AGENT); }
__device__ __forceinline__ unsigned xb_xcc_id() { return (unsigned)__builtin_amdgcn_s_getreg((3 << 11) | 20) & 0xFu; }
#define XB_SPIN(cond, bar) do { unsigned _sp = 0; while (cond) { __builtin_amdgcn_s_sleep(1); \
    if ((++_sp & 255u) == 0u) { if (xb_ld(&(bar)[XB_TMO])) break; if (_sp > XB_SPIN_CAP) { atomicAdd(&(bar)[XB_TMO], 1u); break; } } } } while (0)

struct XcdBarrier {
    unsigned* bar; unsigned x;
    volatile LAS unsigned* st;
};

__device__ __forceinline__ XcdBarrier xcd_barrier_post(unsigned* bar, volatile LAS unsigned* st) {
    XcdBarrier b; b.bar = bar; b.x = xb_xcc_id(); b.st = st;
    if (threadIdx.x == 0) (void)xb_add(&bar[XB_XCNT(b.x)], 1u);
    return b;
}
__device__ __forceinline__ void xcd_barrier_complete(unsigned* bar, unsigned x, unsigned& nloc, unsigned& nx) {
    const unsigned G = gridDim.x * gridDim.y * gridDim.z;
    unsigned sum, cnt, mine, sp = 0u;
    for (;;) {
        sum = 0u; cnt = 0u; mine = 0u;
#pragma unroll
        for (unsigned j = 0; j < 16; ++j) { const unsigned c = xb_ld(&bar[XB_XCNT(j)]); sum += c; cnt += (c > 0u) ? 1u : 0u; mine = (j == x) ? c : mine; }
        if (sum == G) break;
        __builtin_amdgcn_s_sleep(1);
        if ((++sp & 255u) == 0u) { if (xb_ld(&bar[XB_TMO])) break; if (sp > XB_SPIN_CAP) { atomicAdd(&bar[XB_TMO], 1u); break; } }
    }
    nloc = mine > 0u ? mine : 1u; nx = cnt > 0u ? cnt : 1u;
}

__device__ __forceinline__ void xcd_barrier(const XcdBarrier& b) {
    asm volatile("s_waitcnt vmcnt(0)" ::: "memory");
    __syncthreads();
    if (threadIdx.x == 0) {
        unsigned* bar = b.bar;
        __builtin_amdgcn_s_waitcnt(0);
        unsigned nloc = b.st[0], nx = b.st[1];
        if (nloc == 0u) { xcd_barrier_complete(bar, b.x, nloc, nx); b.st[0] = nloc; b.st[1] = nx; }
        const unsigned old = xb_add(&bar[XB_XSUB(b.x)], 1u);
        const unsigned gen = old / nloc;
        if (old + 1u == (gen + 1u) * nloc) {
            __builtin_amdgcn_fence(__ATOMIC_RELEASE, "agent");
            asm volatile("s_waitcnt vmcnt(0)" ::: "memory");
            const unsigned og = xb_add(&bar[XB_TOP], 1u);
            const unsigned tg = og / nx;
            if (og + 1u == (tg + 1u) * nx) xb_add(&bar[XB_TOPGEN], 1u);
            else XB_SPIN(xb_ld(&bar[XB_TOPGEN]) == tg, bar);
            __builtin_amdgcn_fence(__ATOMIC_ACQUIRE, "agent");
            xb_add(&bar[XB_XGEN(b.x)], 1u);
            asm volatile("s_waitcnt vmcnt(0)" ::: "memory");
        } else {
            XB_SPIN(xb_ld(&bar[XB_XGEN(b.x)]) == gen, bar);
            __builtin_amdgcn_fence(__ATOMIC_ACQUIRE, "agent");
            asm volatile("s_waitcnt vmcnt(0)" ::: "memory");
        }
    }
    __syncthreads();
}

constexpr int NPHASE = 21;
__global__ void __launch_bounds__(NTHR, 2) fwd_kernel(Args a) {
    extern __shared__ __attribute__((aligned(16))) unsigned char lds_raw[];
    LAS unsigned char* lds = (LAS unsigned char*)lds_raw;
    cg::grid_group grid = cg::this_grid();
    const int tid = threadIdx.x, lane = tid & 63, wave = __builtin_amdgcn_readfirstlane(tid >> 6);
    const int G = gridDim.x, gw = blockIdx.x * NWAVES + wave, NGW = G * NWAVES;
    const int lo = a.ph_lo, hi = a.ph_hi;
    volatile LAS unsigned* MISC = (volatile LAS unsigned*)(lds + LDS_BYTES - 256);
    if (tid < 32) MISC[tid] = 0u;
    __syncthreads();
    XcdBarrier bar = xcd_barrier_post((unsigned*)a.ws, MISC + 8);
    if (hi < 0) grid.sync();
#define PH_BEGIN(k) if (lo <= (k) && (k) < hi) { const CAS char* kp_ = kargs_ptr(); unsigned char* const ws = KWS; (void)ws;
#define PH_END(k) if ((k) + 1 < hi) xcd_barrier(bar); }
#define GEMM_BF(k, Aptr, lda_, Bptr, N_, K_, O0, ld0, O1, ld1, split, bias, segw, segstride, ssp, tail_) PH_BEGIN(k) { pg8::Gemm g{(const bf16*)(Aptr), (const bf16*)(Bptr), M, N_, K_, lda_}; pg8::EpiBf16X e{(bf16*)(O0), ld0, (bf16*)(O1), ld1, split, bias, segw, segstride, ssp}; \
        pg8::StaticOrder S; S.init(M, N_, G, (int)blockIdx.x); pg8::gemm_phase<pg8::EpiBf16X, pg8::StaticOrder, true, true>(lds, g, S, e); { tail_; } } PH_END(k)
#define GEMM_GLU(k, Aptr, Bptr, layer, ssp, tail_) PH_BEGIN(k) { pg8::Gemm g{(const bf16*)(Aptr), (const bf16*)(Bptr), M, UW, D, D}; \
        pg8::EpiGlu e{(bf16*)(ws + WS_H), KIN(I_FCW) + (size_t)(layer) * 3 * DFF, KIN(I_FCB) + (size_t)(layer) * DFF, (float*)(ws + WS_HG), (float*)(ws + WS_HV), (float*)(ws + WS_TG), ssp}; \
        pg8::StaticOrder S; S.init(M, UW, G, (int)blockIdx.x); pg8::gemm_phase<pg8::EpiGlu, pg8::StaticOrder, true, true>(lds, g, S, e); { tail_; } } PH_END(k)
#define GEMM_RES(k, Aptr, lda_, Bptr, N_, K_, base, bias, xbp, ssp) PH_BEGIN(k) { pg8::Gemm g{(const bf16*)(Aptr), (const bf16*)(Bptr), M, N_, K_, lda_}; pg8::EpiRes e{base, KOUT, D, bias, (bf16*)(xbp), ssp}; \
        pg8::StaticOrder S; S.init(M, N_, G, (int)blockIdx.x); pg8::gemm_phase<pg8::EpiRes, pg8::StaticOrder, true, true>(lds, g, S, e); } PH_END(k)
    PH_BEGIN(0) p0_prologue(a, lds, tid, lane, wave); PH_END(0)
    GEMM_BF(1, ws + WS_XN1, D, ws + WS_WIN, ABIN, D, ws + WS_PC, 1024, (unsigned char*)KOUT + DO_PR, PRW, 1024, (const float*)(ws + WS_BIASP), PRW, 0, nullptr, if (G == 256 && blockIdx.x >= 192) tail_g1(a, lds, tid, lane, wave, (int)blockIdx.x - 192, 64); else if (G != 256) tail_g1(a, lds, tid, lane, wave, (int)blockIdx.x, G))
    PH_BEGIN(2) p2_prep(a, lds, tid, lane, wave); PH_END(2)
    GEMM_BF(3, ws + WS_LIN, LINW, ws + WS_WL, LOW, LINW, ws + WS_LOW, 512, ws + WS_LOW, 512, 0, nullptr, 512, (size_t)M * 512, nullptr, (void)0)
    PH_BEGIN(4) p4_rwkv_prep(a, lane, wave); PH_END(4)
    PH_BEGIN(5) scan_pass1(a, lds, lane, wave); PH_END(5)
    PH_BEGIN(6) comb_a(a, lds, tid, lane, wave); if (G == 256 && blockIdx.x >= 128) p8_prep2(a, lds, lane, wave, (int)blockIdx.x - 128, 128); else if (G != 256) p8_prep2(a, lds, lane, wave, (int)blockIdx.x, G); PH_END(6)
    PH_BEGIN(6) comb_b(a, lds, tid, lane, wave); PH_END(6)
    PH_BEGIN(6) comb_c(a, lds, tid, lane, wave); PH_END(6)
    PH_BEGIN(7) scan_pass2(a, lds, lane, wave); PH_END(7)
    GEMM_RES(8, ws + WS_CAT, D, ws + WS_WOUT, D, D, KIN(I_X), nullptr, ws + WS_XB, (float*)(ws + WS_SS))
    GEMM_GLU(10, ws + WS_XB, ws + WS_WUP0, 0, (float*)(ws + WS_SS), if (G == 256 && blockIdx.x >= 128) tail_g10(a, lds, lane, wave, (int)blockIdx.x - 128, 128); else if (G != 256) tail_g10(a, lds, lane, wave, (int)blockIdx.x, G))
    PH_BEGIN(11) glu_fixup(a, 0, tid); PH_END(11)
    GEMM_RES(12, ws + WS_H, DFF, ws + WS_WDN0, D, DFF, KOUT, nullptr, ws + WS_XB, (float*)(ws + WS_SS) + M)
    GEMM_BF(14, ws + WS_XB, D, ws + WS_WQKV, QKVW, D, ws + WS_QKV, QKVW, ws + WS_QKV, QKVW, 1 << 30, KIN(I_BQKV), 256, 0, (float*)(ws + WS_SS) + M, if (G == 256 && blockIdx.x >= 128) tail_g14(a, lds, lane, wave, (int)blockIdx.x - 128, 128); else if (G != 256) tail_g14(a, lds, lane, wave, (int)blockIdx.x, G))
    PH_BEGIN(15) p14_attn(a, lds, tid, lane, wave); PH_END(15)
    GEMM_RES(16, ws + WS_O, D, ws + WS_WO, D, D, KOUT, KIN(I_BO), ws + WS_XB, (float*)(ws + WS_SS) + 2 * M)
    GEMM_GLU(18, ws + WS_XB, ws + WS_WUP1, 1, (float*)(ws + WS_SS) + 2 * M, (void)0)
    PH_BEGIN(19) glu_fixup(a, 1, tid); PH_END(19)
    GEMM_RES(20, ws + WS_H, DFF, ws + WS_WDN1, D, DFF, KOUT, nullptr, nullptr, nullptr)
}

#ifndef N_LAUNCH_MODE
#define N_LAUNCH_MODE 1
#endif
extern "C" void kernel_launch(void* const* d_in, const int* in_sizes, int n_in, void* d_out, int out_size, void* d_ws, size_t ws_size, hipStream_t stream) {
    static int grid = 0;
    if (grid == 0) {
        if (n_in != 34 || out_size != M * D || ws_size < WS_END) { fprintf(stderr, "kernel_launch: unexpected shapes n_in %d out %d ws %zu\n", n_in, out_size, ws_size); grid = -1; return; }
        int dev = 0, cus = 0, per_cu = 0;
        hipGetDevice(&dev); hipDeviceGetAttribute(&cus, hipDeviceAttributeMultiprocessorCount, dev);
        if (hipFuncSetAttribute((const void*)fwd_kernel, hipFuncAttributeMaxDynamicSharedMemorySize, LDS_BYTES) != hipSuccess) { fprintf(stderr, "kernel_launch: hipFuncSetAttribute failed\n"); grid = -1; return; }
        if (hipOccupancyMaxActiveBlocksPerMultiprocessor(&per_cu, (const void*)fwd_kernel, NTHR, LDS_BYTES) != hipSuccess || per_cu < 1) { fprintf(stderr, "kernel_launch: occupancy query says %d\n", per_cu); per_cu = 1; }
        (void)hipGetLastError();
        grid = cus * 1;
    }
    if (grid < 0) return;
    if (hipMemsetAsync(d_ws, 0, 16384, stream) != hipSuccess) { fprintf(stderr, "kernel_launch: memset of the barrier words failed\n"); return; }
    Args a{};
    for (int i = 0; i < 34; ++i) a.in[i] = (const float*)d_in[i];
    a.out = (float*)d_out; a.ws = (unsigned char*)d_ws;
#if N_LAUNCH_MODE == 1
    a.ph_lo = 0; a.ph_hi = NPHASE;
    { void* args[] = {&a}; hipError_t e = hipLaunchCooperativeKernel((const void*)fwd_kernel, dim3(grid), dim3(NTHR), args, LDS_BYTES, stream);
      if (e != hipSuccess) fprintf(stderr, "cooperative launch failed: %s (grid %d)\n", hipGetErrorString(e), grid); }
#else
    for (int ph = 0; ph < NPHASE; ++ph) { a.ph_lo = ph; a.ph_hi = ph + 1; void* args[] = {&a};
        hipError_t e = hipLaunchCooperativeKernel((const void*)fwd_kernel, dim3(grid), dim3(NTHR), args, LDS_BYTES, stream);
        if (e != hipSuccess) { fprintf(stderr, "launch %d failed: %s\n", ph, hipGetErrorString(e)); break; } }
#endif
}
```

```cpp
#include <hip/hip_runtime.h>
#include <hip/hip_cooperative_groups.h>
#include <cstdio>
#include <cstdint>
namespace cg = cooperative_groups;
namespace pg8 {
#define PG8_LAS __attribute__((address_space(3)))
typedef unsigned short bf16_t;
typedef short bf16x8 __attribute__((ext_vector_type(8)));
typedef float f32x4 __attribute__((ext_vector_type(4)));
typedef unsigned u32x4 __attribute__((ext_vector_type(4)));
constexpr int BM = 256, BK = 64, HALF = 128, HTB = HALF * BK * 2  , STAGE_BYTES = 8 * HTB, NXCD = 8, WGM = 8;

__host__ __device__ __forceinline__ int lds_byte(int r, int c) { const int st = (r >> 4) * 2 + (c >> 5), rr = r & 15, cc = c & 31, ob = rr * 64 + cc * 2; return st * 1024 + (ob ^ (((ob >> 9) & 1) << 5)); }
__host__ __device__ __forceinline__ void stage_rc(int b, int& R, int& C) { const int st = b / 1024, sb = b % 1024, swz = sb ^ (((sb >> 9) & 1) << 5); R = (st >> 1) * 16 + swz / 64; C = (st & 1) * 32 + (swz % 64) / 2; }
__host__ __device__ __forceinline__ int perm32(int rho) { const int n = rho >> 4, i = rho & 15; return 8 * (i >> 2) + 4 * n + (i & 3); }

struct Unit { int pm, pn; };
struct Gemm { const bf16_t* A; const bf16_t* Bt; int M, N, K, lda; };

struct StaticOrder {
    int nM, nN, nwg, G, c;
    __host__ __device__ void init(int M, int N, int G_, int c_) { nM = M / BM; nN = N / BM; nwg = nM * nN; G = G_; c = c_; }
    __host__ __device__ bool next(int i, Unit& u) const {
        const long L = (long)i * G + c; if (L >= nwg) return false;
        int wgid = (int)L; { const int q = nwg / NXCD, r = nwg % NXCD, xcd = wgid % NXCD, off = wgid / NXCD; wgid = (xcd < r ? xcd * (q + 1) : r * (q + 1) + (xcd - r) * q) + off; }
        const int nig = WGM * nN, gid = wgid / nig, fm = gid * WGM, gsz = (nM - fm) < WGM ? (nM - fm) : WGM;
        u.pm = fm + ((wgid % nig) % gsz); u.pn = (wgid % nig) / gsz; return true;
    }
    __device__ __forceinline__ void a_ready(const Unit&) const {}
    __device__ __forceinline__ void done(const Unit&) const {}
};

__device__ __forceinline__ unsigned cvt_pk_bf16(float lo, float hi) { unsigned r; asm volatile("v_cvt_pk_bf16_f32 %0, %1, %2" : "=v"(r) : "v"(lo), "v"(hi)); return r; }
typedef float f32x2 __attribute__((ext_vector_type(2)));

template <class Epi, class Sched, bool ALIGN_EPI = false, bool SP2 = false>
__device__ __forceinline__ void gemm_phase(PG8_LAS unsigned char* lds, const Gemm g, const Sched& S, const Epi& E) {
    const int tid = threadIdx.x, wid = __builtin_amdgcn_readfirstlane(tid >> 6), lane = tid & 63, wr = wid >> 2, wc = wid & 3, fr = lane & 15, fq = lane >> 4;
    const int K = g.K, nt = K / BK;
    unsigned voffA[2], voffB[2];
#pragma unroll
    for (int i = 0; i < 2; ++i) { int R, C; stage_rc(tid * 16 + i * 8192, R, C); const int Rb = Epi::PERM ? ((R & ~31) + perm32(R & 31)) : R;
        voffA[i] = (unsigned)(R * g.lda + C) * 2u; voffB[i] = (unsigned)(Rb * K + C) * 2u; }
    const size_t kstep = (size_t)(BK * 2);
    const size_t hstep = (size_t)HALF * K * 2;
    const size_t tstep = 2 * hstep; const size_t hstepA = (size_t)HALF * g.lda * 2, tstepA = 2 * hstepA;
    const unsigned ldsw = (unsigned)wid * 1024u;
    const int aoff = lds_byte(wr * 64 + fr, fq * 8), boff = lds_byte(wc * 32 + fr, fq * 8);
#define PG8_SA(b, h) (((b) * 2 + (h)) * HTB)
#define PG8_SB(b, h) ((4 + (b) * 2 + (h)) * HTB)
#define PG8_STAGE(bufoff, gbase, voff) do { _Pragma("unroll") for (int _i = 0; _i < 2; ++_i) \
        __builtin_amdgcn_global_load_lds((const unsigned*)((const char*)(gbase) + (voff)[_i]), (PG8_LAS unsigned*)(lds + (bufoff) + ldsw + _i * 8192), 16, 0, 0); } while (0)
#define PG8_LDA(dst, b, h) do { _Pragma("unroll") for (int m = 0; m < 4; ++m) _Pragma("unroll") for (int k = 0; k < 2; ++k) dst[m][k] = *(const PG8_LAS bf16x8*)(lds + PG8_SA(b, h) + aoff + m * 2048 + k * 1024); } while (0)
#define PG8_LDB(dst, b, h) do { _Pragma("unroll") for (int n = 0; n < 2; ++n) _Pragma("unroll") for (int k = 0; k < 2; ++k) dst[n][k] = *(const PG8_LAS bf16x8*)(lds + PG8_SB(b, h) + boff + n * 2048 + k * 1024); } while (0)
#define PG8_MMA(ai, bj, At, Bt) do { __builtin_amdgcn_s_setprio(1); _Pragma("unroll") for (int m = 0; m < 4; ++m) _Pragma("unroll") for (int n = 0; n < 2; ++n) _Pragma("unroll") for (int k = 0; k < 2; ++k) \
        acc[ai][bj][m][n] = __builtin_amdgcn_mfma_f32_16x16x32_bf16(Bt[n][k], At[m][k], acc[ai][bj][m][n], 0, 0, 0); __builtin_amdgcn_s_setprio(0); } while (0)
#define PG8_WAIT_V(n) asm volatile("s_waitcnt vmcnt(" #n ")" ::: "memory")
#define PG8_WAIT_L(n) asm volatile("s_waitcnt lgkmcnt(" #n ")" ::: "memory")
#define PG8_BAR __builtin_amdgcn_s_barrier()
#define PG8_SCHED __builtin_amdgcn_sched_barrier(0)
    Unit cur, nxt; int ui = 0;
    if (!S.next(0, cur)) return;
    f32x4 acc[2][2][4][2];
#pragma unroll
    for (int a = 0; a < 2; ++a)
#pragma unroll
        for (int b = 0; b < 2; ++b)
#pragma unroll
            for (int m = 0; m < 4; ++m)
#pragma unroll
                for (int n = 0; n < 2; ++n) acc[a][b][m][n] = (f32x4){0.f, 0.f, 0.f, 0.f};
    bf16x8 At[4][2], B0[2][2], B1[2][2];
    const char* cA = (const char*)g.A + (size_t)cur.pm * tstepA; const char* cB = (const char*)g.Bt + (size_t)cur.pn * tstep;
    S.a_ready(cur);
    if constexpr (SP2) {
        PG8_STAGE(PG8_SB(0, 0), cB, voffB); PG8_STAGE(PG8_SB(0, 1), cB + hstep, voffB); PG8_STAGE(PG8_SA(0, 0), cA, voffA); PG8_STAGE(PG8_SA(0, 1), cA + hstepA, voffA);
        if (wr == 1) PG8_BAR;
        PG8_WAIT_V(2); PG8_BAR;
        PG8_STAGE(PG8_SB(1, 0), cB + kstep, voffB); PG8_STAGE(PG8_SA(1, 0), cA + kstep, voffA); PG8_STAGE(PG8_SB(1, 1), cB + hstep + kstep, voffB);
        PG8_WAIT_V(6); PG8_BAR;
    } else {
        PG8_STAGE(PG8_SB(0, 0), cB, voffB); PG8_STAGE(PG8_SA(0, 0), cA, voffA); PG8_STAGE(PG8_SB(0, 1), cB + hstep, voffB); PG8_STAGE(PG8_SA(0, 1), cA + hstepA, voffA);
        if (wr == 1) PG8_BAR;
        PG8_WAIT_V(4); PG8_BAR;
        PG8_STAGE(PG8_SB(1, 0), cB + kstep, voffB); PG8_STAGE(PG8_SA(1, 0), cA + kstep, voffA); PG8_STAGE(PG8_SB(1, 1), cB + hstep + kstep, voffB);
        PG8_WAIT_V(6); PG8_BAR;
    }
    for (;;) {
        const bool has_next = S.next(ui + 1, nxt);
        const char* nA = has_next ? (const char*)g.A + (size_t)nxt.pm * tstepA : cA; const char* nB = has_next ? (const char*)g.Bt + (size_t)nxt.pn * tstep : cB;
        for (int t = 0; t < nt; t += 2) {
            const bool last = (t == nt - 2);
            const char* a1 = cA + (size_t)(t + 1) * kstep;
            const char* a2 = last ? nA : cA + (size_t)(t + 2) * kstep; const char* b2 = last ? nB : cB + (size_t)(t + 2) * kstep;
            const char* a3 = a2 + kstep; const char* b3 = b2 + kstep;
            if (last && has_next) S.a_ready(nxt);
            if constexpr (SP2) {
            PG8_LDB(B0, 0, 0); PG8_LDB(B1, 0, 1); PG8_SCHED; PG8_LDA(At, 0, 0); PG8_STAGE(PG8_SA(1, 1), a1 + hstepA, voffA);
            PG8_WAIT_V(8); PG8_WAIT_L(0); PG8_BAR; PG8_MMA(0, 0, At, B0); PG8_MMA(0, 1, At, B1); PG8_BAR; PG8_SCHED;
            PG8_LDA(At, 0, 1); PG8_STAGE(PG8_SB(0, 0), b2, voffB); PG8_STAGE(PG8_SB(0, 1), b2 + hstep, voffB); PG8_STAGE(PG8_SA(0, 0), a2, voffA);
            PG8_WAIT_V(8); PG8_WAIT_L(0); PG8_BAR; PG8_MMA(1, 0, At, B0); PG8_MMA(1, 1, At, B1); PG8_BAR; PG8_SCHED;
            PG8_LDB(B0, 1, 0); PG8_LDB(B1, 1, 1); PG8_SCHED; PG8_LDA(At, 1, 0); PG8_STAGE(PG8_SA(0, 1), a2 + hstepA, voffA);
            PG8_WAIT_V(8); PG8_WAIT_L(0); PG8_BAR; PG8_MMA(0, 0, At, B0); PG8_MMA(0, 1, At, B1); PG8_BAR; PG8_SCHED;
            PG8_LDA(At, 1, 1); PG8_STAGE(PG8_SB(1, 0), b3, voffB); PG8_STAGE(PG8_SB(1, 1), b3 + hstep, voffB); PG8_STAGE(PG8_SA(1, 0), a3, voffA);
            PG8_WAIT_V(8); PG8_WAIT_L(0); PG8_BAR; PG8_MMA(1, 0, At, B0); PG8_MMA(1, 1, At, B1); PG8_BAR; PG8_SCHED;
            } else {
            PG8_LDB(B0, 0, 0); PG8_SCHED; PG8_LDA(At, 0, 0); PG8_STAGE(PG8_SA(1, 1), a1 + hstepA, voffA);
            PG8_WAIT_L(8); PG8_BAR; PG8_WAIT_L(0); PG8_MMA(0, 0, At, B0); PG8_BAR; PG8_SCHED;
            PG8_LDB(B1, 0, 1); PG8_STAGE(PG8_SB(0, 0), b2, voffB);
            PG8_BAR; PG8_WAIT_L(0); PG8_MMA(0, 1, At, B1); PG8_BAR;
            PG8_LDA(At, 0, 1); PG8_STAGE(PG8_SA(0, 0), a2, voffA);
            PG8_BAR; PG8_WAIT_L(0); PG8_MMA(1, 0, At, B0); PG8_BAR; PG8_SCHED;
            PG8_STAGE(PG8_SB(0, 1), b2 + hstep, voffB);
            PG8_WAIT_V(6); PG8_BAR; PG8_MMA(1, 1, At, B1); PG8_BAR;
            PG8_LDB(B0, 1, 0); PG8_SCHED; PG8_LDA(At, 1, 0); PG8_STAGE(PG8_SA(0, 1), a2 + hstepA, voffA);
            PG8_WAIT_L(8); PG8_BAR; PG8_WAIT_L(0); PG8_MMA(0, 0, At, B0); PG8_BAR; PG8_SCHED;
            PG8_LDB(B1, 1, 1); PG8_STAGE(PG8_SB(1, 0), b3, voffB);
            PG8_BAR; PG8_WAIT_L(0); PG8_MMA(0, 1, At, B1); PG8_BAR;
            PG8_LDA(At, 1, 1); PG8_STAGE(PG8_SA(1, 0), a3, voffA);
            PG8_BAR; PG8_WAIT_L(0); PG8_MMA(1, 0, At, B0); PG8_BAR; PG8_SCHED;
            PG8_STAGE(PG8_SB(1, 1), b3 + hstep, voffB);
            PG8_WAIT_V(6); PG8_BAR; PG8_MMA(1, 1, At, B1); PG8_BAR;
            }
        }
        if constexpr (ALIGN_EPI) { if (wr == 0) PG8_BAR; }
        if constexpr (!Epi::AFTER_DRAIN) { E(acc, cur, wr, wc, fr, fq); S.done(cur); }
        if (!has_next) break;
#pragma unroll
        for (int a = 0; a < 2; ++a)
#pragma unroll
            for (int b = 0; b < 2; ++b)
#pragma unroll
                for (int m = 0; m < 4; ++m)
#pragma unroll
                    for (int n = 0; n < 2; ++n) acc[a][b][m][n] = (f32x4){0.f, 0.f, 0.f, 0.f};
        cur = nxt; cA = nA; cB = nB; ++ui;
        if constexpr (ALIGN_EPI) { if (wr == 1) PG8_BAR; }
    }
    PG8_WAIT_V(0);
    if constexpr (!ALIGN_EPI) { if (wr == 0) PG8_BAR; }
    PG8_BAR;
    if constexpr (Epi::AFTER_DRAIN) { E.fused(acc, cur, wr, wc, fr, fq, lds, wid, lane); S.done(cur); }
#undef PG8_SA
#undef PG8_SB
#undef PG8_STAGE
#undef PG8_LDA
#undef PG8_LDB
#undef PG8_MMA
#undef PG8_WAIT_V
#undef PG8_WAIT_L
#undef PG8_BAR
#undef PG8_SCHED
}
}

namespace pg8 {
struct EpiBf16X {
    static constexpr bool PERM = true, AFTER_DRAIN = false;
    bf16_t* O0; int ld0; bf16_t* O1; int ld1; int split; const float* bias; int segw; size_t segstride; const float* ss;
    __device__ __forceinline__ void operator()(const f32x4 (&acc)[2][2][4][2], const Unit& u, int wr, int wc, int fr, int fq) const {
        const int row0 = u.pm * BM + wr * 64 + fr; const int colt = u.pn * BM;
        bf16_t* base; int ldc, cb;
        if (colt < split) { base = O0; ldc = ld0; cb = colt; } else { const int rel = colt - split, sg = rel / segw; base = O1 + (size_t)sg * segstride; ldc = ld1; cb = rel - sg * segw; }
        const int col0 = cb + wc * 32 + 8 * fq, bcol0 = colt + wc * 32 + 8 * fq;
        f32x4 bv[2][2];
#pragma unroll
        for (int bj = 0; bj < 2; ++bj)
#pragma unroll
            for (int n = 0; n < 2; ++n) bv[bj][n] = bias ? *(const f32x4*)(bias + bcol0 + bj * HALF + 4 * n) : (f32x4){0.f, 0.f, 0.f, 0.f};
#pragma unroll
        for (int ai = 0; ai < 2; ++ai)
#pragma unroll
            for (int m = 0; m < 4; ++m) { bf16_t* rowp = base + (size_t)(row0 + ai * HALF + m * 16) * ldc + col0;
                const float rs = ss ? __builtin_amdgcn_rsqf(ss[row0 + ai * HALF + m * 16] * (1.f / 1024.f) + 1e-6f) : 1.f;
#pragma unroll
                for (int bj = 0; bj < 2; ++bj) { const f32x4 v0 = acc[ai][bj][m][0] * rs + bv[bj][0], v1 = acc[ai][bj][m][1] * rs + bv[bj][1];
                    u32x4 w; w.x = cvt_pk_bf16(v0[0], v0[1]); w.y = cvt_pk_bf16(v0[2], v0[3]); w.z = cvt_pk_bf16(v1[0], v1[1]); w.w = cvt_pk_bf16(v1[2], v1[3]);
                    *(u32x4*)(rowp + bj * HALF) = w; } }
    }
};
struct EpiRes {
    static constexpr bool PERM = false, AFTER_DRAIN = false;
    const float* base; float* out; int ldc; const float* bias; bf16_t* xb; float* ss;
    __device__ __forceinline__ void operator()(const f32x4 (&acc)[2][2][4][2], const Unit& u, int wr, int wc, int fr, int fq) const {
        const int col0 = u.pn * BM + wc * 32 + 4 * fq;
        f32x4 bv[2][2];
#pragma unroll
        for (int bj = 0; bj < 2; ++bj)
#pragma unroll
            for (int n = 0; n < 2; ++n) bv[bj][n] = bias ? *(const f32x4*)(bias + col0 + bj * HALF + n * 16) : (f32x4){0.f, 0.f, 0.f, 0.f};
#pragma unroll
        for (int ai = 0; ai < 2; ++ai)
#pragma unroll
            for (int m = 0; m < 4; ++m) { const int row = u.pm * BM + ai * HALF + wr * 64 + m * 16 + fr; const size_t off = (size_t)row * ldc + col0; float sq = 0.f;
#pragma unroll
                for (int bj = 0; bj < 2; ++bj)
#pragma unroll
                    for (int n = 0; n < 2; ++n) { const size_t o = off + bj * HALF + n * 16; const f32x4 bs = *(const f32x4*)(base + o);
                        const f32x4 v = bs + acc[ai][bj][m][n] + bv[bj][n]; *(f32x4*)(out + o) = v;
                        if (xb) { sq += (v[0] * v[0] + v[1] * v[1]) + (v[2] * v[2] + v[3] * v[3]);
                            typedef unsigned u32x2_ __attribute__((ext_vector_type(2))); u32x2_ w; w.x = cvt_pk_bf16(v[0], v[1]); w.y = cvt_pk_bf16(v[2], v[3]); *(u32x2_*)(xb + o) = w; } }
                if (xb) { sq += __shfl_xor(sq, 16); sq += __shfl_xor(sq, 32); if (fq == 0) atomicAdd(ss + row, sq); } }
    }
};
struct EpiGlu {
    static constexpr bool PERM = true, AFTER_DRAIN = false;
    bf16_t* H; const float* cw; const float* cb; float* HG; float* HV; float* TG; const float* ss;
    __device__ __forceinline__ void operator()(const f32x4 (&acc)[2][2][4][2], const Unit& u, int wr, int wc, int fr, int fq) const {
        constexpr int DFF_ = 2816;
        const int gc0 = u.pn * 128 + wc * 32 + 8 * fq;
        float w0[8], w1[8], w2[8], bb[8];
#pragma unroll
        for (int h = 0; h < 2; ++h) { const f32x4 a0 = *(const f32x4*)(cw + gc0 + 4 * h), a1 = *(const f32x4*)(cw + DFF_ + gc0 + 4 * h), a2 = *(const f32x4*)(cw + 2 * DFF_ + gc0 + 4 * h), a3 = *(const f32x4*)(cb + gc0 + 4 * h);
#pragma unroll
            for (int e = 0; e < 4; ++e) { w0[4 * h + e] = a0[e]; w1[4 * h + e] = a1[e]; w2[4 * h + e] = a2[e]; bb[4 * h + e] = a3[e]; } }
        const int l1 = (fq << 4) | ((fr + 15) & 15), l2 = (fq << 4) | ((fr + 14) & 15);
#pragma unroll
        for (int ai = 0; ai < 2; ++ai) {
            const int rbase = u.pm * BM + ai * HALF + wr * 64; const int blk = rbase >> 6;
            float rs[4];
#pragma unroll
            for (int m = 0; m < 4; ++m) rs[m] = __builtin_amdgcn_rsqf(ss[rbase + m * 16 + fr] * (1.f / 1024.f) + 1e-6f);
#pragma unroll
            for (int m = 0; m < 4; ++m) {
                float g[8], gp[8], vl[8], o[8];
#pragma unroll
                for (int n = 0; n < 2; ++n)
#pragma unroll
                    for (int e = 0; e < 4; ++e) { g[4 * n + e] = acc[ai][0][m][n][e] * rs[m]; vl[4 * n + e] = acc[ai][1][m][n][e] * rs[m]; gp[4 * n + e] = m > 0 ? acc[ai][0][m - 1][n][e] * rs[m - 1] : 0.f; }
#pragma unroll
                for (int e = 0; e < 8; ++e) { const float s1 = fr == 15 ? gp[e] : g[e], s2 = fr >= 14 ? gp[e] : g[e];
                    const float p1 = __shfl(s1, l1), p2 = __shfl(s2, l2);
                    const float x = w0[e] * p2 + w1[e] * p1 + w2[e] * g[e] + bb[e];
                    o[e] = x * __builtin_amdgcn_rcpf(1.f + __expf(-x)) * vl[e]; }
                const int row = rbase + m * 16 + fr;
                if (m == 0 && fr < 2) {
                    float* hg = HG + ((size_t)blk * 2 + fr) * DFF_ + gc0; float* hv = HV + ((size_t)blk * 2 + fr) * DFF_ + gc0;
                    *(f32x4*)hg = (f32x4){g[0], g[1], g[2], g[3]}; *(f32x4*)(hg + 4) = (f32x4){g[4], g[5], g[6], g[7]};
                    *(f32x4*)hv = (f32x4){vl[0], vl[1], vl[2], vl[3]}; *(f32x4*)(hv + 4) = (f32x4){vl[4], vl[5], vl[6], vl[7]};
                } else {
                    u32x4 w; w.x = cvt_pk_bf16(o[0], o[1]); w.y = cvt_pk_bf16(o[2], o[3]); w.z = cvt_pk_bf16(o[4], o[5]); w.w = cvt_pk_bf16(o[6], o[7]);
                    *(u32x4*)(H + (size_t)row * DFF_ + gc0) = w;
                }
                if (m == 3 && fr >= 14) { float* tg = TG + ((size_t)blk * 2 + (fr - 14)) * DFF_ + gc0;
                    *(f32x4*)tg = (f32x4){g[0], g[1], g[2], g[3]}; *(f32x4*)(tg + 4) = (f32x4){g[4], g[5], g[6], g[7]}; }
            }
        }
    }
};
}

constexpr int NWAVES = 8, NTHR = 512;
constexpr int BATCH = 2, T = 8192, D = 1024, M = BATCH * T;
constexpr int ABIN = 2816, PRW = 1792, DFF = 2816, UW = 5632, QKVW = 1536, LOW = 1536, LINW = 256, NH = 8;
constexpr size_t MiB = 1u << 20;
constexpr size_t WS_BON = 1 * MiB, WS_BIASP = 1 * MiB + 768 * 1024;
constexpr size_t WS_WIN = 2 * MiB, WS_WL = 8 * MiB, WS_WOUT = 254 * MiB, WS_LOW = 13 * MiB, WS_LOA = 29 * MiB, WS_LOG = 45 * MiB, WS_ST = 13 * MiB, WS_CAT = 61 * MiB, WS_SEQ = 93 * MiB;
constexpr size_t WS_XN1 = 93 * MiB, WS_PC = 125 * MiB, WS_LIN = 157 * MiB;
constexpr size_t WS_ROPE = 253 * MiB;
constexpr size_t DO_PR = 0, DO_ST = 56 * MiB;
constexpr size_t WS_WUP0 = 2 * MiB, WS_WDN0 = 13 * MiB, WS_WQKV = 19 * MiB, WS_WO = 22 * MiB, WS_WUP1 = 24 * MiB, WS_WDN1 = 35 * MiB;
constexpr size_t WS_H = 41 * MiB, WS_HG = 130 * MiB, WS_HV = 136 * MiB, WS_TG = 142 * MiB, WS_QKV = 41 * MiB, WS_O = 89 * MiB, WS_XB = 219 * MiB, WS_END = 256 * MiB;
constexpr size_t WS_SS = 1 * MiB + 512 * 1024;
constexpr int LDS_BYTES = 147456;

#define LAS __attribute__((address_space(3)))
typedef unsigned short bf16;
typedef float f32x4 __attribute__((ext_vector_type(4)));
typedef unsigned v4u __attribute__((ext_vector_type(4)));
typedef unsigned v2u __attribute__((ext_vector_type(2)));
typedef short bf16x8 __attribute__((ext_vector_type(8)));
typedef float f32x16 __attribute__((ext_vector_type(16)));
typedef float f32x2 __attribute__((ext_vector_type(2)));
#define LDS_WAIT() asm volatile("s_waitcnt lgkmcnt(0)" ::: "memory")

typedef __bf16 bf16x2_hw __attribute__((ext_vector_type(2)));
__device__ __forceinline__ unsigned pk2(float lo, float hi) { const f32x2 v = {lo, hi}; return __builtin_bit_cast(unsigned, __builtin_convertvector(v, bf16x2_hw)); }
__device__ __forceinline__ unsigned f2bf(float f) { return pk2(f, 0.f) & 0xffffu; }
__device__ __forceinline__ float bf2f(unsigned h) { return __builtin_bit_cast(float, h << 16); }
__device__ __forceinline__ float bflo(unsigned w) { return __builtin_bit_cast(float, w << 16); }
__device__ __forceinline__ float bfhi(unsigned w) { return __builtin_bit_cast(float, w & 0xffff0000u); }
template <int CTRL> __device__ __forceinline__ float dppf(float x) { return __builtin_bit_cast(float, __builtin_amdgcn_update_dpp(0, __builtin_bit_cast(int, x), CTRL, 0xf, 0xf, false)); }
template <int O> __device__ __forceinline__ float xstep(float v) {
    if constexpr (O == 1) return v + dppf<0xB1>(v);
    else if constexpr (O == 2) return v + dppf<0x4E>(v);
    else if constexpr (O == 4) return v + dppf<0x141>(v);
    else if constexpr (O == 8) return v + dppf<0x140>(v);
    else if constexpr (O == 16) return v + __builtin_bit_cast(float, __builtin_amdgcn_update_dpp(0, __builtin_bit_cast(int, v), 0x142, 0xa, 0xf, false));
    else { const float t = v + __builtin_bit_cast(float, __builtin_amdgcn_update_dpp(0, __builtin_bit_cast(int, v), 0x143, 0xc, 0xf, false));
        return __builtin_bit_cast(float, __builtin_amdgcn_readlane(__builtin_bit_cast(int, t), 63)); }
}
__device__ __forceinline__ float wave_sum(float v) {
    v = xstep<1>(v); v = xstep<2>(v); v = xstep<4>(v); v = xstep<8>(v); v = xstep<16>(v); v = xstep<32>(v);
    return v;
}
__device__ __forceinline__ float sigm(float x) { return __builtin_amdgcn_rcpf(1.f + __expf(-x)); }
__device__ __forceinline__ float tanh_fast(float x) { return 1.f - 2.f * __builtin_amdgcn_rcpf(__expf(2.f * x) + 1.f); }

struct Args { const float* in[34]; float* out; unsigned char* ws; int ph_lo, ph_hi; };
#define CAS __attribute__((address_space(4)))
__device__ __forceinline__ const CAS char* kargs_ptr() { const CAS char* kp = (const CAS char*)__builtin_amdgcn_kernarg_segment_ptr(); asm volatile("" : "+s"(kp)); return kp; }
#define KIN(i) (*(const float* const CAS*)(kp_ + 8 * (i)))
#define KOUT (*(float* const CAS*)(kp_ + 8 * 34))
#define KWS (*(unsigned char* const CAS*)(kp_ + 8 * 35))
enum { I_X = 0, I_POS, I_ABG, I_WIN, I_CINB, I_DWW, I_DWB, I_CLNG, I_CLNB, I_MU, I_W0, I_W2, I_A0, I_A2, I_G2, I_KK, I_KA, I_RK, I_RLNG, I_RLNB, I_WOUT,
       I_ATG, I_WQKV, I_BQKV, I_QNG, I_KNG, I_SINK, I_WO, I_BO, I_FNG, I_WUP, I_FCW, I_FCB, I_WDN };

__device__ __forceinline__ void transpose_item(const float* W, int K, int N, bf16* WT, LAS float* scr, int item, int lane, const float* gain, int glu) {
    const int nblk = N / 32, kb = item / nblk, nb = item % nblk, k0 = 64 * kb, n0 = 32 * nb;
#pragma unroll 8
    for (int i = 0; i < 32; ++i) { const int kk = 2 * i + (lane >> 5); const float gk = gain ? gain[k0 + kk] : 1.f; scr[kk * 33 + (lane & 31)] = W[(size_t)(k0 + kk) * N + n0 + (lane & 31)] * gk; }
    LDS_WAIT(); asm volatile("" ::: "memory");
    const int c = lane & 7;
#pragma unroll
    for (int j = 0; j < 4; ++j) { const int n = (lane >> 3) + 8 * j; const LAS float* s = scr + (8 * c) * 33 + n;
        v4u o; o.x = pk2(s[0 * 33], s[1 * 33]); o.y = pk2(s[2 * 33], s[3 * 33]); o.z = pk2(s[4 * 33], s[5 * 33]); o.w = pk2(s[6 * 33], s[7 * 33]);
        const int nn = n0 + n; const int dr = glu ? (nn < DFF ? (nn >> 7) * 256 + (nn & 127) : ((nn - DFF) >> 7) * 256 + 128 + ((nn - DFF) & 127)) : nn;
        *(v4u*)(WT + (size_t)dr * K + k0 + 8 * c) = o; }
    LDS_WAIT(); asm volatile("" ::: "memory");
}
__device__ __forceinline__ void transpose_mat(const float* W, int K, int N, bf16* WT, LAS float* scr, int gw, int NGW, int lane, const float* gain = nullptr, int glu = 0) {
    const int nitems = (K / 64) * (N / 32);
    for (int it = gw; it < nitems; it += NGW) transpose_item(W, K, N, WT, scr, it, lane, gain, glu);
}
__device__ __forceinline__ void rms_rows(const float* src, const float* g, bf16* dst, int gw, int NGW, int lane) {
    for (int m = gw; m < M; m += NGW) {
        const f32x4* xr = (const f32x4*)(src + (size_t)m * D) + lane; const f32x4* gr = (const f32x4*)g + lane;
        f32x4 v[4]; float s = 0.f;
#pragma unroll
        for (int j = 0; j < 4; ++j) { v[j] = xr[64 * j]; s += (v[j].x * v[j].x + v[j].y * v[j].y) + (v[j].z * v[j].z + v[j].w * v[j].w); }
        const float rstd = __builtin_amdgcn_rsqf(wave_sum(s) * (1.f / D) + 1e-6f);
        unsigned long long* o8 = (unsigned long long*)(dst + (size_t)m * D) + lane;
#pragma unroll
        for (int j = 0; j < 4; ++j) { const f32x4 gg = gr[64 * j];
            o8[64 * j] = (unsigned long long)pk2(v[j].x * rstd * gg.x, v[j].y * rstd * gg.y) | ((unsigned long long)pk2(v[j].z * rstd * gg.z, v[j].w * rstd * gg.w) << 32); }
    }
}

__device__ __forceinline__ void p0_prologue(const Args& a, LAS unsigned char* lds, int tid, int lane, int wave) {
    const CAS char* kp_ = kargs_ptr();
    LAS float* scr = (LAS float*)(lds + wave * 16384);
    const int G = gridDim.x, gw = blockIdx.x * NWAVES + wave, NGW = G * NWAVES, gt = blockIdx.x * NTHR + tid, NGT = G * NTHR;
    transpose_mat(KIN(I_WIN), D, ABIN, (bf16*)(KWS + WS_WIN), scr, gw, NGW, lane);
    { float* bp = (float*)(KWS + WS_BIASP); for (int i = gt; i < ABIN; i += NGT) bp[i] = i < 1024 ? KIN(I_CINB)[i] : 0.f; }
    rms_rows(KIN(I_X), KIN(I_ABG), (bf16*)(KWS + WS_XN1), gw, NGW, lane);
}

__device__ __forceinline__ void p2_prep(const Args& a, LAS unsigned char* lds, int tid, int lane, int wave) {
    const CAS char* kp_ = kargs_ptr();
    const bf16* PC = (const bf16*)(KWS + WS_PC); const bf16* PR = (const bf16*)((unsigned char*)KOUT + DO_PR);
    bf16* CAT = (bf16*)(KWS + WS_CAT); bf16* LIN = (bf16*)(KWS + WS_LIN);
    LAS float* ybuf = (LAS float*)lds;
    const int c = tid;
    float wv[31];
#pragma unroll
    for (int j = 0; j < 31; ++j) wv[j] = KIN(I_DWW)[j * 512 + c];
    const float bc = KIN(I_DWB)[c];
    for (int tile = blockIdx.x; tile < M / 32; tile += gridDim.x) {
        const int b = tile / (T / 32), tt0 = (tile % (T / 32)) * 32;
        float g[62];
        if (tt0 >= 30) {
            const bf16* rowp = PC + (size_t)(b * T + tt0 - 30) * 1024 + c;
#pragma unroll
            for (int i = 0; i < 62; ++i) { const float x1 = bf2f(rowp[i * 1024]), x2 = bf2f(rowp[i * 1024 + 512]); g[i] = x1 * sigm(x2); }
        } else {
            const bf16* rowp = PC + (size_t)(b * T) * 1024 + c;
#pragma unroll
            for (int i = 0; i < 30; ++i) g[i] = 0.f;
#pragma unroll
            for (int i = 30; i < 62; ++i) { const float x1 = bf2f(rowp[(i - 30) * 1024]), x2 = bf2f(rowp[(i - 30) * 1024 + 512]); g[i] = x1 * sigm(x2); }
        }
#pragma unroll
        for (int tt = 0; tt < 32; ++tt) { float y = bc;
#pragma unroll
            for (int j = 0; j < 31; ++j) y += wv[j] * g[tt + j];
            ybuf[tt * 512 + c] = y; }
        __syncthreads();
#pragma unroll
        for (int q = 0; q < 4; ++q) { const int tt = wave * 4 + q; const LAS f32x4* yr = (const LAS f32x4*)(ybuf + tt * 512 + lane * 8);
            const f32x4 y0 = yr[0], y1 = yr[1];
            const float mean = wave_sum((y0.x + y0.y) + (y0.z + y0.w) + (y1.x + y1.y) + (y1.z + y1.w)) * (1.f / 512.f);
            const f32x4 d0 = y0 - mean, d1 = y1 - mean;
            const float var = wave_sum((d0.x * d0.x + d0.y * d0.y) + (d0.z * d0.z + d0.w * d0.w) + (d1.x * d1.x + d1.y * d1.y) + (d1.z * d1.z + d1.w * d1.w)) * (1.f / 512.f);
            const float rstd = __builtin_amdgcn_rsqf(var + 1e-5f);
            const f32x4 g0 = *(const f32x4*)(KIN(I_CLNG) + lane * 8), g1 = *(const f32x4*)(KIN(I_CLNG) + lane * 8 + 4);
            const f32x4 b0 = *(const f32x4*)(KIN(I_CLNB) + lane * 8), b1 = *(const f32x4*)(KIN(I_CLNB) + lane * 8 + 4);
            f32x4 o0 = d0 * rstd * g0 + b0, o1 = d1 * rstd * g1 + b1;
            o0.x *= sigm(o0.x); o0.y *= sigm(o0.y); o0.z *= sigm(o0.z); o0.w *= sigm(o0.w); o1.x *= sigm(o1.x); o1.y *= sigm(o1.y); o1.z *= sigm(o1.z); o1.w *= sigm(o1.w);
            v4u w; w.x = pk2(o0.x, o0.y); w.y = pk2(o0.z, o0.w); w.z = pk2(o1.x, o1.y); w.w = pk2(o1.z, o1.w);
            *(v4u*)(CAT + (size_t)(b * T + tt0 + tt) * 1024 + lane * 8) = w; }
        __syncthreads();
    }
    const int gt = blockIdx.x * NTHR + tid, NGT = gridDim.x * NTHR;
    for (int w = gt; w < (M / 32) * LINW; w += NGT) { const int j = w & 255, m_start = (w >> 8) * 32;
        const bf16* p = PR + (size_t)m_start * PRW + 1536 + j; bf16* o = LIN + (size_t)m_start * LINW + j;
        const float mu = KIN(I_MU)[1536 + j];
        float prev = (m_start & (T - 1)) != 0 ? bf2f(p[-PRW]) : 0.f;
#pragma unroll 8
        for (int i = 0; i < 32; ++i) { const float p1 = bf2f(p[i * PRW]); const float xs = p1 + (prev - p1) * mu; prev = p1;
            const float v = j < 64 ? tanh_fast(xs) : (j < 128 ? xs : sigm(xs));
            o[i * LINW] = (bf16)f2bf(v); }
    }
}

constexpr int SLABB = 2048, RUNL = 64;
constexpr size_t WS_WLC = 256 * 1024;
struct SlabRegs { v4u p1, p2; };
__device__ __forceinline__ void slab_load(SlabRegs& r, const unsigned char* slab, int lane) {
    r.p1 = *(const v4u*)(slab + lane * 16); r.p2 = *(const v4u*)(slab + 1024 + lane * 16);
}
__device__ __forceinline__ void slab_piece(const v4u q, LAS float* dst, int p) {
    LAS float* d = dst + (p >> 5) * 256 + ((p >> 3) & 3) * 64 + (p & 7) * 8;
    *(LAS f32x4*)d = (f32x4){bflo(q.x), bfhi(q.x), bflo(q.y), bfhi(q.y)}; *(LAS f32x4*)(d + 4) = (f32x4){bflo(q.z), bfhi(q.z), bflo(q.w), bfhi(q.w)};
}
__device__ __forceinline__ void slab_store(const SlabRegs& r, LAS float* dst, int lane) { slab_piece(r.p1, dst, lane); slab_piece(r.p2, dst, lane + 64); }
__device__ __forceinline__ void p4_rwkv_prep(const Args& a, int lane, int wave) {
    const CAS char* kp_ = kargs_ptr();
    const bf16* PR = (const bf16*)((unsigned char*)KOUT + DO_PR); const bf16* LOWp = (const bf16*)(KWS + WS_LOW); const bf16* LOAp = (const bf16*)(KWS + WS_LOA);
    unsigned char* SEQ = KWS + WS_SEQ; float* BON = (float*)(KWS + WS_BON); float* WLC = (float*)(KWS + WS_WLC);
    const int gw = blockIdx.x * NWAVES + wave, NGW = gridDim.x * NWAVES;
    constexpr int RUN = 64, U = 4;
    for (int run = gw; run < (M / RUN) * NH; run += NGW) { const int h = run & 7, mbase = (run >> 3) * RUN, c = h * 64 + lane, b = mbase / T;
        const float mur = KIN(I_MU)[c], muk = KIN(I_MU)[512 + c], w0 = KIN(I_W0)[c], a0 = KIN(I_A0)[c], kkc = KIN(I_KK)[c], kac = KIN(I_KA)[c], rkc = KIN(I_RK)[c];
        float rp = 0.f, kp_ = 0.f, Wc = 1.f;
        if ((mbase & (T - 1)) != 0) { rp = bf2f(PR[(size_t)(mbase - 1) * PRW + c]); kp_ = bf2f(PR[(size_t)(mbase - 1) * PRW + 512 + c]); }
        for (int i0 = 0; i0 < RUN; i0 += U) {
            float r1[U], k1[U], lw[U], la[U];
#pragma unroll
            for (int u = 0; u < U; ++u) { const size_t m = (size_t)(mbase + i0 + u); r1[u] = bf2f(PR[m * PRW + c]); k1[u] = bf2f(PR[m * PRW + 512 + c]); lw[u] = bf2f(LOWp[m * 512 + c]); la[u] = bf2f(LOAp[m * 512 + c]); }
            float kkr[U], kpv[U], rr[U], dec[U], agv[U], n2[U], bn[U];
#pragma unroll
            for (int u = 0; u < U; ++u) {
                const float r = r1[u] + (rp - r1[u]) * mur, k = k1[u] + (kp_ - k1[u]) * muk; rp = r1[u]; kp_ = k1[u];
                const float z = -(w0 + lw[u]);
                const float sp = fmaxf(z, 0.f) + __logf(1.f + __expf(-fabsf(z)));
                dec[u] = __expf(-__expf(-sp - 0.5f));
                const float ag = sigm(a0 + la[u]); agv[u] = ag;
                kkr[u] = k * kkc; n2[u] = kkr[u] * kkr[u];
                kpv[u] = k * (1.f + (ag - 1.f) * kac); rr[u] = r; bn[u] = r * kpv[u] * rkc; }
#define P4_STEP(O) _Pragma("unroll") for (int u = 0; u < U; ++u) { n2[u] = xstep<O>(n2[u]); bn[u] = xstep<O>(bn[u]); }
            P4_STEP(1) P4_STEP(2) P4_STEP(4) P4_STEP(8) P4_STEP(16) P4_STEP(32)
#undef P4_STEP
#pragma unroll
            for (int u = 0; u < U; ++u) { const int m = mbase + i0 + u, t = m & (T - 1);
                const float kk = kkr[u] * __builtin_amdgcn_rsqf(fmaxf(n2[u], 1e-24f));
                unsigned char* sl_ = SEQ + ((size_t)(b * NH + h) * (T / 4) + (t >> 2)) * SLABB; const int st_ = t & 3;
                const float ap = -kk * Wc; Wc *= dec[u]; const float iW = __builtin_amdgcn_rcpf(Wc);
                bf16* hb = (bf16*)(sl_ + st_ * 512) + lane;
                hb[0] = (bf16)f2bf(ap); hb[64] = (bf16)f2bf(kk * agv[u] * iW); hb[128] = (bf16)f2bf(kpv[u] * iW); hb[192] = (bf16)f2bf(rr[u] * Wc);
                if (lane == 0) BON[(size_t)m * NH + h] = bn[u]; }
        }
        WLC[((size_t)(b * NH + h) * (T / RUNL) + (mbase & (T - 1)) / RUNL) * 64 + lane] = Wc;
    }
}

__device__ __forceinline__ int crow(int r, int hi) { return (r & 3) + 8 * (r >> 2) + 4 * hi; }
constexpr int SLAB = 4, SLABF = SLAB * 256;
constexpr int NCH = 64, CL = T / NCH;
template <int MODE>
__device__ __forceinline__ void scan_task(const Args& a, LAS float* wl, int lane, int chain, int ck) {
    const CAS char* kp_ = kargs_ptr();
    const bf16* PR = (const bf16*)((unsigned char*)KOUT + DO_PR); const bf16* LOGp = (const bf16*)(KWS + WS_LOG);
    const unsigned char* SEQ = KWS + WS_SEQ; const float* BON = (const float*)(KWS + WS_BON); bf16* CAT = (bf16*)(KWS + WS_CAT);
    float* ST = (float*)(KWS + WS_ST);
    const int b = chain >> 3, h = chain & 7, c = h * 64 + lane, t0 = ck * CL;
    const float muv = KIN(I_MU)[1024 + c];
    float lng = 0.f, lnb = 0.f;
    if constexpr (MODE == 2) { lng = KIN(I_RLNG)[c]; lnb = KIN(I_RLNB)[c]; }
    f32x2 S[32];
#pragma unroll
    for (int j = 0; j < 32; ++j) S[j] = (f32x2){0.f, 0.f};
    if constexpr (MODE == 3) {
#pragma unroll
        for (int j = 0; j < 32; ++j) S[j] = (f32x2){lane == 2 * j ? 1.f : 0.f, lane == 2 * j + 1 ? 1.f : 0.f};
    }
    if constexpr (MODE == 2) {
        if (ck > 0) { const f32x4* sp = (const f32x4*)(ST + ((size_t)(chain * NCH + ck - 1) * 2) * 4096 + lane * 64);
#pragma unroll
            for (int j = 0; j < 16; ++j) { const f32x4 q = sp[j]; S[2 * j] = q.xy; S[2 * j + 1] = q.zw; } }
    }
    const unsigned char* sq = SEQ + ((size_t)chain * (T / SLAB) + t0 / SLAB) * SLABB;
    const size_t m0 = (size_t)b * T + t0;
    float pprev = 0.f;
    if constexpr (MODE != 3) pprev = t0 > 0 ? bf2f(PR[(m0 - 1) * PRW + 1024 + c]) : 0.f;
    SlabRegs pre; unsigned pvn[SLAB], gtn[SLAB]; float bnn[SLAB];
    slab_load(pre, sq, lane);
#pragma unroll
    for (int s = 0; s < SLAB; ++s) { const size_t m = m0 + s; if constexpr (MODE != 3) pvn[s] = PR[m * PRW + 1024 + c]; if constexpr (MODE == 2) { gtn[s] = LOGp[m * 512 + c]; bnn[s] = BON[m * NH + h]; } }
    slab_store(pre, wl, lane);
    for (int sl = 0; sl < CL / SLAB; ++sl) {
        const int buf = sl & 1; const LAS float* ob = wl + buf * SLABF;
        if (sl == RUNL / SLAB) {
            const f32x4* wq = (const f32x4*)((const float*)(KWS + WS_WLC) + ((size_t)chain * (T / RUNL) + t0 / RUNL) * 64);
#pragma unroll
            for (int j = 0; j < 16; ++j) { const f32x4 q = wq[j]; S[2 * j] *= q.xy; S[2 * j + 1] *= q.zw; } }
        unsigned pvc[SLAB], gtc[SLAB]; float bnc[SLAB];
#pragma unroll
        for (int s = 0; s < SLAB; ++s) { if constexpr (MODE != 3) pvc[s] = pvn[s]; if constexpr (MODE == 2) { gtc[s] = gtn[s]; bnc[s] = bnn[s]; } }
        const int sn = (sl + 1 < CL / SLAB) ? sl + 1 : sl;
        slab_load(pre, sq + (size_t)sn * SLABB, lane);
#pragma unroll
        for (int s = 0; s < SLAB; ++s) { const size_t m = m0 + (size_t)sn * SLAB + s; if constexpr (MODE != 3) pvn[s] = PR[m * PRW + 1024 + c]; if constexpr (MODE == 2) { gtn[s] = LOGp[m * 512 + c]; bnn[s] = BON[m * NH + h]; } }
        __builtin_amdgcn_sched_barrier(0);
        float ys[SLAB], vs[SLAB];
        constexpr int NIT = 20, NQ = (MODE == 2 ? 3 : (MODE == 1 ? 2 : 1));
        f32x4 ring[8][4];
        const LAS f32x4* o4b = (const LAS f32x4*)ob;
#define SCAN_LD(it_) do { const int st_ = (it_) / NIT, lc_ = (it_) % NIT; const LAS f32x4* o4_ = o4b + st_ * 64; \
            if (lc_ < 4) { _Pragma("unroll") for (int q_ = 0; q_ < 4; ++q_) ring[(it_) & 7][q_] = o4_[4 * lc_ + q_]; } \
            else { _Pragma("unroll") for (int q_ = 0; q_ < NQ; ++q_) ring[(it_) & 7][q_] = o4_[16 * (q_ + 1) + (lc_ - 4)]; } } while (0)
        SCAN_LD(0); SCAN_LD(1); SCAN_LD(2); SCAN_LD(3); SCAN_LD(4); SCAN_LD(5);
        f32x2 sa0 = {0.f, 0.f}, sa1 = {0.f, 0.f}, y0 = {0.f, 0.f}, y1 = {0.f, 0.f}, sav = {0.f, 0.f}, vv = {0.f, 0.f};
#pragma unroll
        for (int it = 0; it < SLAB * NIT; ++it) {
            const int st = it / NIT, lc = it % NIT;
            if (it + 6 < SLAB * NIT) SCAN_LD(it + 6);
            if (lc == 0) { float v = 0.f;
                if constexpr (MODE != 3) { const float pv = bf2f(pvc[st]); v = pv + (pprev - pv) * muv; pprev = pv; }
                vs[st] = v; vv = (f32x2){v, v}; sa0 = (f32x2){0.f, 0.f}; sa1 = (f32x2){0.f, 0.f}; y0 = (f32x2){0.f, 0.f}; y1 = (f32x2){0.f, 0.f}; }
            if (lc < 4) {
#pragma unroll
                for (int q = 0; q < 4; ++q) { const f32x4 a4 = ring[it & 7][q]; sa0 += S[8 * lc + 2 * q] * a4.xy; sa1 += S[8 * lc + 2 * q + 1] * a4.zw; }
                if (lc == 3) { const float sa = (sa0.x + sa0.y) + (sa1.x + sa1.y); sav = (f32x2){sa, sa}; }
            } else { const int j = lc - 4; const f32x4 b4 = ring[it & 7][0];
                f32x2 n0 = S[2 * j] + sav * b4.xy, n1 = S[2 * j + 1] + sav * b4.zw;
                if constexpr (MODE != 3) { const f32x4 k4 = ring[it & 7][1]; n0 += vv * k4.xy; n1 += vv * k4.zw; }
                S[2 * j] = n0; S[2 * j + 1] = n1;
                if constexpr (MODE == 2) { const f32x4 r4 = ring[it & 7][2]; y0 += n0 * r4.xy; y1 += n1 * r4.zw; if (lc == NIT - 1) ys[st] = (y0.x + y0.y) + (y1.x + y1.y); }
            }
            __builtin_amdgcn_sched_barrier(0);
        }
#undef SCAN_LD
        if constexpr (MODE == 2) {
            float mu4[SLAB], d4[SLAB], q4[SLAB];
#pragma unroll
            for (int s = 0; s < SLAB; ++s) mu4[s] = ys[s];
#define GN_STEP(A_, O) _Pragma("unroll") for (int s = 0; s < SLAB; ++s) A_[s] = xstep<O>(A_[s]);
            GN_STEP(mu4, 1) GN_STEP(mu4, 2) GN_STEP(mu4, 4) GN_STEP(mu4, 8) GN_STEP(mu4, 16) GN_STEP(mu4, 32)
#pragma unroll
            for (int s = 0; s < SLAB; ++s) { d4[s] = ys[s] - mu4[s] * (1.f / 64.f); q4[s] = d4[s] * d4[s]; }
            GN_STEP(q4, 1) GN_STEP(q4, 2) GN_STEP(q4, 4) GN_STEP(q4, 8) GN_STEP(q4, 16) GN_STEP(q4, 32)
#undef GN_STEP
#pragma unroll
            for (int s = 0; s < SLAB; ++s) { float yn = d4[s] * __builtin_amdgcn_rsqf(q4[s] * (1.f / 64.f) + 64e-5f) * lng + lnb;
                yn += bnc[s] * vs[s]; yn *= bf2f(gtc[s]);
                CAT[(m0 + (size_t)sl * SLAB + s) * 1024 + 512 + c] = (bf16)f2bf(yn); }
        }
        slab_store(pre, wl + (buf ^ 1) * SLABF, lane);
    }
    if constexpr (MODE != 2) {
        f32x4* dm = (f32x4*)(ST + ((size_t)(chain * NCH + ck) * 2 + (MODE == 1 ? 1 : 0)) * 4096 + lane * 64);
#pragma unroll
        for (int j = 0; j < 16; ++j) { f32x4 q; q.xy = S[2 * j]; q.zw = S[2 * j + 1]; dm[j] = q; }
    }
}
__device__ __forceinline__ void scan_task_p1(const Args& a, LAS float* wl, int lane, int chain, int ck, int rh) {
    const CAS char* kp_ = kargs_ptr();
    const bf16* PR = (const bf16*)((unsigned char*)KOUT + DO_PR); const unsigned char* SEQ = KWS + WS_SEQ; float* ST = (float*)(KWS + WS_ST);
    const int b = chain >> 3, h = chain & 7, r32 = lane & 31, kh = lane >> 5, row = 32 * rh + r32, c = h * 64 + row, t0 = ck * CL;
    const float muv = KIN(I_MU)[1024 + c];
    f32x2 Sn[16], Sm[16];
#pragma unroll
    for (int j = 0; j < 16; ++j) { Sn[j] = (f32x2){0.f, 0.f}; Sm[j] = (f32x2){row == 32 * kh + 2 * j ? 1.f : 0.f, row == 32 * kh + 2 * j + 1 ? 1.f : 0.f}; }
    const unsigned char* sq = SEQ + ((size_t)chain * (T / SLAB) + t0 / SLAB) * SLABB;
    const size_t m0 = (size_t)b * T + t0;
    float pprev = t0 > 0 ? bf2f(PR[(m0 - 1) * PRW + 1024 + c]) : 0.f;
    SlabRegs pre; unsigned pvn[SLAB];
    slab_load(pre, sq, lane);
#pragma unroll
    for (int s = 0; s < SLAB; ++s) pvn[s] = PR[(m0 + s) * PRW + 1024 + c];
    slab_store(pre, wl, lane);
    for (int sl = 0; sl < CL / SLAB; ++sl) {
        const int buf = sl & 1; const LAS float* ob = wl + buf * SLABF;
        if (sl == RUNL / SLAB) {
            const f32x4* wq = (const f32x4*)((const float*)(KWS + WS_WLC) + ((size_t)chain * (T / RUNL) + t0 / RUNL) * 64 + 32 * kh);
#pragma unroll
            for (int j = 0; j < 8; ++j) { const f32x4 q = wq[j]; Sn[2 * j] *= q.xy; Sn[2 * j + 1] *= q.zw; Sm[2 * j] *= q.xy; Sm[2 * j + 1] *= q.zw; } }
        unsigned pvc[SLAB];
#pragma unroll
        for (int s = 0; s < SLAB; ++s) pvc[s] = pvn[s];
        const int sn = (sl + 1 < CL / SLAB) ? sl + 1 : sl;
        slab_load(pre, sq + (size_t)sn * SLABB, lane);
#pragma unroll
        for (int s = 0; s < SLAB; ++s) pvn[s] = PR[(m0 + (size_t)sn * SLAB + s) * PRW + 1024 + c];
        __builtin_amdgcn_sched_barrier(0);
        constexpr int NIT = 10;
        f32x4 ring[4][4];
        const LAS f32x4* o4b = (const LAS f32x4*)ob + 8 * kh;
#define P1_LD(it_) do { const int st_ = (it_) / NIT, lc_ = (it_) % NIT; const LAS f32x4* o4_ = o4b + st_ * 64; \
            if (lc_ < 2) { _Pragma("unroll") for (int q_ = 0; q_ < 4; ++q_) ring[(it_) & 3][q_] = o4_[4 * lc_ + q_]; } \
            else { _Pragma("unroll") for (int q_ = 0; q_ < 2; ++q_) ring[(it_) & 3][q_] = o4_[16 * (q_ + 1) + (lc_ - 2)]; } } while (0)
        P1_LD(0); P1_LD(1); P1_LD(2);
        f32x2 an0 = {0.f, 0.f}, an1 = {0.f, 0.f}, am0 = {0.f, 0.f}, am1 = {0.f, 0.f}, sanv = {0.f, 0.f}, samv = {0.f, 0.f}, vv = {0.f, 0.f};
#pragma unroll
        for (int it = 0; it < SLAB * NIT; ++it) {
            const int st = it / NIT, lc = it % NIT;
            if (it + 3 < SLAB * NIT) P1_LD(it + 3);
            if (lc == 0) { const float pv = bf2f(pvc[st]); const float v = pv + (pprev - pv) * muv; pprev = pv; vv = (f32x2){v, v};
                an0 = (f32x2){0.f, 0.f}; an1 = (f32x2){0.f, 0.f}; am0 = (f32x2){0.f, 0.f}; am1 = (f32x2){0.f, 0.f}; }
            if (lc < 2) {
#pragma unroll
                for (int q = 0; q < 4; ++q) { const f32x4 a4 = ring[it & 3][q];
                    an0 += Sn[8 * lc + 2 * q] * a4.xy; an1 += Sn[8 * lc + 2 * q + 1] * a4.zw; am0 += Sm[8 * lc + 2 * q] * a4.xy; am1 += Sm[8 * lc + 2 * q + 1] * a4.zw; }
                if (lc == 1) { float san = (an0.x + an0.y) + (an1.x + an1.y), sam = (am0.x + am0.y) + (am1.x + am1.y);
                    san += __shfl_xor(san, 32); sam += __shfl_xor(sam, 32); sanv = (f32x2){san, san}; samv = (f32x2){sam, sam}; }
            } else { const int j = lc - 2; const f32x4 b4 = ring[it & 3][0], k4 = ring[it & 3][1];
                Sn[2 * j] = Sn[2 * j] + sanv * b4.xy + vv * k4.xy; Sn[2 * j + 1] = Sn[2 * j + 1] + sanv * b4.zw + vv * k4.zw;
                Sm[2 * j] = Sm[2 * j] + samv * b4.xy;              Sm[2 * j + 1] = Sm[2 * j + 1] + samv * b4.zw;
            }
            __builtin_amdgcn_sched_barrier(0);
        }
#undef P1_LD
        slab_store(pre, wl + (buf ^ 1) * SLABF, lane);
    }
    f32x4* dm = (f32x4*)(ST + ((size_t)(chain * NCH + ck) * 2) * 4096 + row * 64 + 32 * kh); f32x4* dn = dm + 1024;
    const f32x4* wq = (const f32x4*)((const float*)(KWS + WS_WLC) + ((size_t)chain * (T / RUNL) + t0 / RUNL + 1) * 64 + 32 * kh);
#pragma unroll
    for (int j = 0; j < 8; ++j) { const f32x4 w4 = wq[j]; f32x4 q; q.xy = Sm[2 * j] * w4.xy; q.zw = Sm[2 * j + 1] * w4.zw; dm[j] = q; f32x4 p; p.xy = Sn[2 * j] * w4.xy; p.zw = Sn[2 * j + 1] * w4.zw; dn[j] = p; }
}
__device__ __forceinline__ void scan_pass1(const Args& a, LAS unsigned char* lds, int lane, int wave) {
    LAS float* wl = (LAS float*)(lds + wave * (2 * SLABF * 4));
    const int ntask = 2 * BATCH * NH * (NCH - 1);
    for (int wk = wave * gridDim.x + blockIdx.x; wk < ntask; wk += NWAVES * gridDim.x) {
        const int rh = wk & 1, chain = (wk >> 1) & 15, ck = wk >> 5;
        scan_task_p1(a, wl, lane, chain, ck, rh);
    }
}
__device__ __forceinline__ void scan_pass2(const Args& a, LAS unsigned char* lds, int lane, int wave) {
    LAS float* wl = (LAS float*)(lds + wave * (2 * SLABF * 4));
    for (int wk = wave * gridDim.x + blockIdx.x; wk < BATCH * NH * NCH; wk += NWAVES * gridDim.x) scan_task<2>(a, wl, lane, wk & 15, wk >> 4);
}
constexpr int GS = 8, NG = NCH / GS;
__device__ __forceinline__ f32x16 mm_acc(const LAS float* X, const LAS float* Mm, f32x16 acc, int ti, int tn, int kh, int l31, int hi) {
    const LAS float* sb = X + (32 * ti + l31) * 65 + 32 * kh + hi;
    const LAS float* mb = Mm + (32 * kh + hi) * 64 + 32 * tn + l31;
#pragma unroll
    for (int kk = 0; kk < 16; ++kk) acc = __builtin_amdgcn_mfma_f32_32x32x2f32(sb[2 * kk], mb[2 * kk * 64], acc, 0, 0, 0);
    return acc;
}
__device__ __forceinline__ void comb_a(const Args& a, LAS unsigned char* lds, int tid, int lane, int wave) {
    const CAS char* kp_ = kargs_ptr();
    if (blockIdx.x >= BATCH * NH * NG) return;
    const int chain = blockIdx.x & 15, g = blockIdx.x >> 4, c0 = g * GS;
    float* ST = (float*)(KWS + WS_ST);
    LAS float* XM = (LAS float*)lds;
    LAS float* XN = XM + 2 * 4160;
    LAS float* Mb = XN + 2 * 4160;
    LAS float* Nb = Mb + 4096;
    LAS float* Pb = Nb + 4096;
    const int l31 = lane & 31, hi = lane >> 5, tile = wave & 3, ti = tile >> 1, tn = tile & 1, kh = wave >> 2;
    const int jmax = (c0 + GS - 1 <= NCH - 2) ? GS - 1 : NCH - 2 - c0;
    f32x4 rq[4];
    { const f32x4* gm = (const f32x4*)(ST + ((size_t)(chain * NCH + c0) * 2) * 4096);
#pragma unroll
      for (int e = 0; e < 2; ++e) { const int idx = tid + 512 * e; const f32x4 m = gm[idx], n = gm[1024 + idx]; const int r = idx >> 4, cc = (idx & 15) * 4;
#pragma unroll
          for (int q = 0; q < 4; ++q) { XM[r * 65 + cc + q] = m[q]; XN[r * 65 + cc + q] = n[q]; } }
      const f32x4* g1 = gm + 2048;
      rq[0] = g1[tid]; rq[1] = g1[tid + 512]; rq[2] = g1[1024 + tid]; rq[3] = g1[1024 + tid + 512]; }
    int cur = 0;
    for (int j = 1; j <= jmax; ++j) {
#pragma unroll
        for (int e = 0; e < 2; ++e) { const int idx = tid + 512 * e; *(LAS f32x4*)(Mb + idx * 4) = rq[e]; *(LAS f32x4*)(Nb + idx * 4) = rq[2 + e]; }
        { const int cn = (j + 1 <= jmax) ? c0 + j + 1 : c0 + j; const f32x4* gm = (const f32x4*)(ST + ((size_t)(chain * NCH + cn) * 2) * 4096);
          rq[0] = gm[tid]; rq[1] = gm[tid + 512]; rq[2] = gm[1024 + tid]; rq[3] = gm[1024 + tid + 512]; }
        __syncthreads();
        f32x16 am, an;
#pragma unroll
        for (int r = 0; r < 16; ++r) { am[r] = 0.f; an[r] = kh == 0 ? Nb[(32 * ti + crow(r, hi)) * 64 + 32 * tn + l31] : 0.f; }
        am = mm_acc(XM + cur * 4160, Mb, am, ti, tn, kh, l31, hi);
        an = mm_acc(XN + cur * 4160, Mb, an, ti, tn, kh, l31, hi);
        if (kh == 1) {
#pragma unroll
            for (int r = 0; r < 16; ++r) { Pb[(tile * 16 + r) * 64 + lane] = am[r]; Pb[4096 + (tile * 16 + r) * 64 + lane] = an[r]; }
        }
        __syncthreads();
        if (kh == 0) {
            float* gs = ST + ((size_t)(chain * NCH + c0 + j) * 2) * 4096;
#pragma unroll
            for (int r = 0; r < 16; ++r) { const float vm = am[r] + Pb[(tile * 16 + r) * 64 + lane], vn = an[r] + Pb[4096 + (tile * 16 + r) * 64 + lane]; const int row = 32 * ti + crow(r, hi), col = 32 * tn + l31;
                XM[(cur ^ 1) * 4160 + row * 65 + col] = vm; XN[(cur ^ 1) * 4160 + row * 65 + col] = vn; gs[row * 64 + col] = vm; gs[4096 + row * 64 + col] = vn; }
        }
        cur ^= 1;
    }
}
__device__ __forceinline__ void comb_b(const Args& a, LAS unsigned char* lds, int tid, int lane, int wave) {
    const CAS char* kp_ = kargs_ptr();
    if (blockIdx.x >= BATCH * NH) return;
    const int chain = blockIdx.x;
    float* ST = (float*)(KWS + WS_ST);
    LAS float* Sb = (LAS float*)lds;
    LAS float* Mb = Sb + 2 * 4160;
    LAS float* Nb = Mb + 4096;
    LAS float* Pb = Nb + 4096;
    const int l31 = lane & 31, hi = lane >> 5, tile = wave & 3, ti = tile >> 1, tn = tile & 1, kh = wave >> 2;
    for (int i = tid; i < 2 * 4160; i += NTHR) Sb[i] = 0.f;
    f32x4 rq[4];
    { const f32x4* gm = (const f32x4*)(ST + ((size_t)(chain * NCH + GS - 1) * 2) * 4096); rq[0] = gm[tid]; rq[1] = gm[tid + 512]; rq[2] = gm[1024 + tid]; rq[3] = gm[1024 + tid + 512]; }
    int cur = 0;
    for (int g = 0; g < NG - 1; ++g) {
        const int c = g * GS + GS - 1;
#pragma unroll
        for (int e = 0; e < 2; ++e) { const int idx = tid + 512 * e; *(LAS f32x4*)(Mb + idx * 4) = rq[e]; *(LAS f32x4*)(Nb + idx * 4) = rq[2 + e]; }
        { const int cn = (g + 1 < NG - 1) ? c + GS : c; const f32x4* gm = (const f32x4*)(ST + ((size_t)(chain * NCH + cn) * 2) * 4096);
          rq[0] = gm[tid]; rq[1] = gm[tid + 512]; rq[2] = gm[1024 + tid]; rq[3] = gm[1024 + tid + 512]; }
        __syncthreads();
        f32x16 acc;
#pragma unroll
        for (int r = 0; r < 16; ++r) acc[r] = kh == 0 ? Nb[(32 * ti + crow(r, hi)) * 64 + 32 * tn + l31] : 0.f;
        acc = mm_acc(Sb + cur * 4160, Mb, acc, ti, tn, kh, l31, hi);
        if (kh == 1) {
#pragma unroll
            for (int r = 0; r < 16; ++r) Pb[(tile * 16 + r) * 64 + lane] = acc[r];
        }
        __syncthreads();
        if (kh == 0) {
            float* gs = ST + ((size_t)(chain * NCH + c) * 2) * 4096;
#pragma unroll
            for (int r = 0; r < 16; ++r) { const float v = acc[r] + Pb[(tile * 16 + r) * 64 + lane]; const int row = 32 * ti + crow(r, hi), col = 32 * tn + l31;
                Sb[(cur ^ 1) * 4160 + row * 65 + col] = v; gs[row * 64 + col] = v; }
        }
        cur ^= 1;
    }
}
__device__ __forceinline__ void comb_c(const Args& a, LAS unsigned char* lds, int tid, int lane, int wave) {
    const CAS char* kp_ = kargs_ptr();
    float* ST = (float*)(KWS + WS_ST);
    LAS float* Sb = (LAS float*)lds;
    LAS float* Mb = Sb + 4160;
    LAS float* Nb = Mb + 4096;
    LAS float* Pb = Nb + 4096;
    const int l31 = lane & 31, hi = lane >> 5, tile = wave & 3, ti = tile >> 1, tn = tile & 1, kh = wave >> 2;
    for (int task = blockIdx.x; task < BATCH * NH * NG * (GS - 1); task += gridDim.x) {
        const int chain = task & 15, g = (task >> 4) & (NG - 1), j = task >> 7, c = g * GS + j;
        { const f32x4* gm = (const f32x4*)(ST + ((size_t)(chain * NCH + c) * 2) * 4096);
          const f32x4* gx = (const f32x4*)(ST + ((size_t)(chain * NCH + (g > 0 ? (g * GS - 1) : 0)) * 2) * 4096);
#pragma unroll
          for (int e = 0; e < 2; ++e) { const int idx = tid + 512 * e; *(LAS f32x4*)(Mb + idx * 4) = gm[idx]; *(LAS f32x4*)(Nb + idx * 4) = gm[1024 + idx];
              const f32x4 x = g > 0 ? gx[idx] : (f32x4){0.f, 0.f, 0.f, 0.f}; const int r = idx >> 4, cc = (idx & 15) * 4;
#pragma unroll
              for (int q = 0; q < 4; ++q) Sb[r * 65 + cc + q] = x[q]; } }
        __syncthreads();
        f32x16 acc;
#pragma unroll
        for (int r = 0; r < 16; ++r) acc[r] = kh == 0 ? Nb[(32 * ti + crow(r, hi)) * 64 + 32 * tn + l31] : 0.f;
        acc = mm_acc(Sb, Mb, acc, ti, tn, kh, l31, hi);
        if (kh == 1) {
#pragma unroll
            for (int r = 0; r < 16; ++r) Pb[(tile * 16 + r) * 64 + lane] = acc[r];
        }
        __syncthreads();
        if (kh == 0) {
            float* gs = ST + ((size_t)(chain * NCH + c) * 2) * 4096;
#pragma unroll
            for (int r = 0; r < 16; ++r) gs[(32 * ti + crow(r, hi)) * 64 + 32 * tn + l31] = acc[r] + Pb[(tile * 16 + r) * 64 + lane];
        }
        __syncthreads();
    }
}

__device__ __forceinline__ void glu_fixup(const Args& a, int layer, int tid) {
    const CAS char* kp_ = kargs_ptr();
    bf16* H = (bf16*)(KWS + WS_H); const float* HG = (const float*)(KWS + WS_HG); const float* HV = (const float*)(KWS + WS_HV); const float* TG = (const float*)(KWS + WS_TG);
    const float* cw = KIN(I_FCW) + (size_t)layer * 3 * DFF; const float* cb = KIN(I_FCB) + (size_t)layer * DFF;
    const int gt = blockIdx.x * NTHR + tid, NGT = gridDim.x * NTHR;
    for (int i = gt; i < (M / 64) * 2 * DFF; i += NGT) { const int c = i % DFF, bj = i / DFF, j = bj & 1, blk = bj >> 1;
        const bool first = (blk & (T / 64 - 1)) == 0;
        const float g2 = HG[(size_t)bj * DFF + c];
        const float t1 = first ? 0.f : TG[((size_t)(blk - 1) * 2 + 1) * DFF + c], t0 = first ? 0.f : TG[((size_t)(blk - 1) * 2) * DFF + c];
        const float g1 = j == 1 ? HG[((size_t)blk * 2) * DFF + c] : t1, g0 = j == 1 ? t1 : t0;
        const float x = cw[c] * g0 + cw[DFF + c] * g1 + cw[2 * DFF + c] * g2 + cb[c];
        H[(size_t)(blk * 64 + j) * DFF + c] = (bf16)f2bf(x * sigm(x) * HV[(size_t)bj * DFF + c]); }
}

constexpr int KS_PITCH = 144, VT_PITCH = 528, KS_BYTES = 256 * KS_PITCH;
__device__ __forceinline__ void p14_attn(const Args& a, LAS unsigned char* lds, int tid, int lane, int wave) {
    const CAS char* kp_ = kargs_ptr();
    const bf16* QKV = (const bf16*)(KWS + WS_QKV); bf16* O = (bf16*)(KWS + WS_O); const float* TAB = (const float*)(KWS + WS_ROPE);
    LAS unsigned char* Ks = lds; LAS unsigned char* Vt = lds + KS_BYTES;
    const int q = lane & 31, hi = lane >> 5;
    for (int u = blockIdx.x; u < BATCH * (T / 128) * 4; u += gridDim.x) {
        const int g = u & 3, qb = (u >> 2) & 63, b = u >> 8; const int tok0 = b * T + qb * 128;
        const int hq = g * 4 + (wave >> 1);
        v4u qcur[4];
        { const bf16* qp = QKV + (size_t)(tok0 + 64 * (wave & 1) + q) * QKVW + hq * 64 + 8 * hi;
#pragma unroll
          for (int ks = 0; ks < 4; ++ks) qcur[ks] = *(const v4u*)(qp + 16 * ks); }
        if (tid < 256) {
            const int kj = tid; const bool valid = (qb > 0) || (kj >= 128); const int token = tok0 - 128 + kj;
            float x[64];
            if (valid) { const v4u* src = (const v4u*)(QKV + (size_t)token * QKVW + 1024 + g * 64);
#pragma unroll
                for (int s = 0; s < 8; ++s) { const v4u w = src[s]; x[8 * s] = bflo(w.x); x[8 * s + 1] = bfhi(w.x); x[8 * s + 2] = bflo(w.y); x[8 * s + 3] = bfhi(w.y); x[8 * s + 4] = bflo(w.z); x[8 * s + 5] = bfhi(w.z); x[8 * s + 6] = bflo(w.w); x[8 * s + 7] = bfhi(w.w); }
                float ss = 0.f;
#pragma unroll
                for (int d = 0; d < 64; ++d) ss += x[d] * x[d];
                const float rstd = 1.0f / sqrtf(ss * (1.f / 64.f) + 1e-6f);
#pragma unroll
                for (int d = 0; d < 64; ++d) x[d] = x[d] * rstd * KIN(I_KNG)[d];
#pragma unroll
                for (int i = 0; i < 8; ++i) { const float cs = TAB[(size_t)token * 16 + i], sn = TAB[(size_t)token * 16 + 8 + i]; const float x1 = x[i], x2 = x[i + 8]; x[i] = x1 * cs - x2 * sn; x[i + 8] = x2 * cs + x1 * sn; }
            } else {
#pragma unroll
                for (int d = 0; d < 64; ++d) x[d] = 0.f;
            }
#pragma unroll
            for (int s = 0; s < 8; ++s) { v4u w; w.x = pk2(x[8 * s], x[8 * s + 1]); w.y = pk2(x[8 * s + 2], x[8 * s + 3]); w.z = pk2(x[8 * s + 4], x[8 * s + 5]); w.w = pk2(x[8 * s + 6], x[8 * s + 7]);
                *(LAS v4u*)(Ks + kj * KS_PITCH + s * 16) = w; }
        } else {
            const int tv = tid - 256;
#pragma unroll
            for (int rep = 0; rep < 4; ++rep) { const int item = tv + 256 * rep, kp = item >> 3, seg = item & 7; const int k0 = 2 * kp; const bool valid = (qb > 0) || (k0 >= 128);
                v4u w0 = {0, 0, 0, 0}, w1 = {0, 0, 0, 0};
                if (valid) { const size_t o = (size_t)(tok0 - 128 + k0) * QKVW + 1280 + g * 64 + seg * 8; w0 = *(const v4u*)(QKV + o); w1 = *(const v4u*)(QKV + o + QKVW); }
                const unsigned e0[4] = {w0.x, w0.y, w0.z, w0.w}, e1[4] = {w1.x, w1.y, w1.z, w1.w};
#pragma unroll
                for (int p = 0; p < 4; ++p) { const int d = seg * 8 + 2 * p;
                    *(LAS unsigned*)(Vt + d * VT_PITCH + k0 * 2) = (e0[p] & 0xffffu) | (e1[p] << 16);
                    *(LAS unsigned*)(Vt + (d + 1) * VT_PITCH + k0 * 2) = (e0[p] >> 16) | (e1[p] & 0xffff0000u); }
            }
        }
        __syncthreads();
        const float sink = KIN(I_SINK)[hq];
#pragma unroll 1
        for (int sb = 0; sb < 2; ++sb) {
            v4u qnext[4];
            { const bf16* qp = QKV + (size_t)(tok0 + 64 * (wave & 1) + 32 + q) * QKVW + hq * 64 + 8 * hi;
#pragma unroll
              for (int ks = 0; ks < 4; ++ks) qnext[ks] = *(const v4u*)(qp + 16 * ks); }
            const int qi0 = 64 * (wave & 1) + 32 * sb; const int token = tok0 + qi0 + q;
            float qv[4][8];
            { float ss = 0.f;
#pragma unroll
              for (int ks = 0; ks < 4; ++ks) { const v4u w = qcur[ks];
                  qv[ks][0] = bflo(w.x); qv[ks][1] = bfhi(w.x); qv[ks][2] = bflo(w.y); qv[ks][3] = bfhi(w.y); qv[ks][4] = bflo(w.z); qv[ks][5] = bfhi(w.z); qv[ks][6] = bflo(w.w); qv[ks][7] = bfhi(w.w);
#pragma unroll
                  for (int j = 0; j < 8; ++j) ss += qv[ks][j] * qv[ks][j]; }
              ss += __shfl_xor(ss, 32);
              const float rstd = 1.0f / sqrtf(ss * (1.f / 64.f) + 1e-6f);
#pragma unroll
              for (int ks = 0; ks < 4; ++ks)
#pragma unroll
                  for (int j = 0; j < 8; ++j) qv[ks][j] = qv[ks][j] * rstd * KIN(I_QNG)[16 * ks + 8 * hi + j];
#pragma unroll
              for (int j = 0; j < 8; ++j) { const float other = __shfl_xor(qv[0][j], 32); const float cs = TAB[(size_t)token * 16 + j], sn = TAB[(size_t)token * 16 + 8 + j];
                  qv[0][j] = hi == 0 ? qv[0][j] * cs - other * sn : qv[0][j] * cs + other * sn; }
            }
            bf16x8 qf[4];
#pragma unroll
            for (int ks = 0; ks < 4; ++ks) { v4u w; w.x = pk2(qv[ks][0] * 0.125f, qv[ks][1] * 0.125f); w.y = pk2(qv[ks][2] * 0.125f, qv[ks][3] * 0.125f); w.z = pk2(qv[ks][4] * 0.125f, qv[ks][5] * 0.125f); w.w = pk2(qv[ks][6] * 0.125f, qv[ks][7] * 0.125f);
                qf[ks] = __builtin_bit_cast(bf16x8, w); }
            const int kt0 = qi0 >> 5;
            f32x16 sc[5];
#pragma unroll
            for (int i = 0; i < 5; ++i) {
#pragma unroll
                for (int r = 0; r < 16; ++r) sc[i][r] = 0.f;
#pragma unroll
                for (int ks = 0; ks < 4; ++ks) { const bf16x8 kf = *(const LAS bf16x8*)(Ks + (32 * (kt0 + i) + q) * KS_PITCH + (16 * ks + 8 * hi) * 2);
                    sc[i] = __builtin_amdgcn_mfma_f32_32x32x16_bf16(kf, qf[ks], sc[i], 0, 0, 0); }
            }
            const int qi = qi0 + q; float mx = sink;
#pragma unroll
            for (int i = 0; i < 5; ++i)
#pragma unroll
                for (int r = 0; r < 16; ++r) { const int kj = 32 * (kt0 + i) + crow(r, hi); const int rel = qi + 128 - kj; const bool ok = (rel >= 0) && (rel < 128) && ((qb > 0) || (kj >= 128));
                    sc[i][r] = ok ? sc[i][r] : -INFINITY; mx = fmaxf(mx, sc[i][r]); }
            mx = fmaxf(mx, __shfl_xor(mx, 32));
            float sum = 0.f;
#pragma unroll
            for (int i = 0; i < 5; ++i)
#pragma unroll
                for (int r = 0; r < 16; ++r) { const float p = __expf(sc[i][r] - mx); sc[i][r] = p; sum += p; }
            sum += __shfl_xor(sum, 32);
            const float inv = 1.0f / (sum + __expf(sink - mx));
            f32x16 oa[2];
#pragma unroll
            for (int dt = 0; dt < 2; ++dt)
#pragma unroll
                for (int r = 0; r < 16; ++r) oa[dt][r] = 0.f;
#pragma unroll
            for (int i = 0; i < 5; ++i)
#pragma unroll
                for (int s2 = 0; s2 < 2; ++s2) { v4u pw; pw.x = pk2(sc[i][8 * s2], sc[i][8 * s2 + 1]); pw.y = pk2(sc[i][8 * s2 + 2], sc[i][8 * s2 + 3]); pw.z = pk2(sc[i][8 * s2 + 4], sc[i][8 * s2 + 5]); pw.w = pk2(sc[i][8 * s2 + 6], sc[i][8 * s2 + 7]);
                    const bf16x8 pb = __builtin_bit_cast(bf16x8, pw);
#pragma unroll
                    for (int dt = 0; dt < 2; ++dt) { const LAS unsigned char* vp = Vt + (q + 32 * dt) * VT_PITCH + (32 * (kt0 + i) + 16 * s2 + 4 * hi) * 2;
                        const v2u lo = *(const LAS v2u*)vp, hh = *(const LAS v2u*)(vp + 16); v4u vw; vw.x = lo.x; vw.y = lo.y; vw.z = hh.x; vw.w = hh.y;
                        oa[dt] = __builtin_amdgcn_mfma_f32_32x32x16_bf16(__builtin_bit_cast(bf16x8, vw), pb, oa[dt], 0, 0, 0); } }
            bf16* op = O + (size_t)token * 1024 + hq * 64 + 4 * hi;
#pragma unroll
            for (int dt = 0; dt < 2; ++dt)
#pragma unroll
                for (int rg = 0; rg < 4; ++rg) { v2u w; w.x = pk2(oa[dt][4 * rg] * inv, oa[dt][4 * rg + 1] * inv); w.y = pk2(oa[dt][4 * rg + 2] * inv, oa[dt][4 * rg + 3] * inv);
                    *(v2u*)(op + 32 * dt + 8 * rg) = w; }
#pragma unroll
            for (int ks = 0; ks < 4; ++ks) qcur[ks] = qnext[ks];
        }
        __syncthreads();
    }
}

__device__ __forceinline__ void p8_prep2(const Args& a, LAS unsigned char* lds, int lane, int wave, int vb, int nb) {
    const CAS char* kp_ = kargs_ptr();
    LAS float* scr = (LAS float*)(lds + wave * 16384);
    const int gw = vb * NWAVES + wave, NGW = nb * NWAVES;
    transpose_mat(KIN(I_WUP), D, UW, (bf16*)(KWS + WS_WUP0), scr, gw, NGW, lane, KIN(I_FNG), 1);
}
__device__ __forceinline__ void tail_g10(const Args& a, LAS unsigned char* lds, int lane, int wave, int vb, int nb) {
    const CAS char* kp_ = kargs_ptr();
    LAS float* scr = (LAS float*)(lds + wave * 16384);
    const int gw = vb * NWAVES + wave, NGW = nb * NWAVES;
    transpose_mat(KIN(I_WDN), DFF, D, (bf16*)(KWS + WS_WDN0), scr, gw, NGW, lane);
    transpose_mat(KIN(I_WQKV), D, QKVW, (bf16*)(KWS + WS_WQKV), scr, gw, NGW, lane, KIN(I_ATG));
    transpose_mat(KIN(I_WO), D, D, (bf16*)(KWS + WS_WO), scr, gw, NGW, lane);
}
__device__ __forceinline__ void tail_g14(const Args& a, LAS unsigned char* lds, int lane, int wave, int vb, int nb) {
    const CAS char* kp_ = kargs_ptr();
    LAS float* scr = (LAS float*)(lds + wave * 16384);
    const int gw = vb * NWAVES + wave, NGW = nb * NWAVES;
    transpose_mat(KIN(I_WUP) + (size_t)D * UW, D, UW, (bf16*)(KWS + WS_WUP1), scr, gw, NGW, lane, KIN(I_FNG) + D, 1);
    transpose_mat(KIN(I_WDN) + (size_t)DFF * D, DFF, D, (bf16*)(KWS + WS_WDN1), scr, gw, NGW, lane);
}
__device__ __forceinline__ void tail_g1(const Args& a, LAS unsigned char* lds, int tid, int lane, int wave, int vb, int nb) {
    const CAS char* kp_ = kargs_ptr();
    LAS float* scr = (LAS float*)(lds + wave * 16384);
    const int gw = vb * NWAVES + wave, NGW = nb * NWAVES, gt = vb * NTHR + tid, NGT = nb * NTHR;
    transpose_mat(KIN(I_WOUT), D, D, (bf16*)(KWS + WS_WOUT), scr, gw, NGW, lane);
    {
        bf16* WL = (bf16*)(KWS + WS_WL);
        for (int i = gt; i < LOW * LINW; i += NGT) { const int n = i >> 8, k = i & 255; float v = 0.f;
            if (n < 512) { if (k < 64) v = KIN(I_W2)[k * 512 + n]; }
            else if (n < 1024) { if (k >= 64 && k < 128) v = KIN(I_A2)[(k - 64) * 512 + (n - 512)]; }
            else { if (k >= 128) v = KIN(I_G2)[(k - 128) * 512 + (n - 1024)]; }
            WL[i] = (bf16)f2bf(v); }
    }
    { float* ssz = (float*)(KWS + WS_SS); for (int i = gt; i < 3 * M; i += NGT) ssz[i] = 0.f; }
    {
        float* tab = (float*)(KWS + WS_ROPE); const int* pos = (const int*)KIN(I_POS);
        for (int i = gt; i < M * 8; i += NGT) { const int m = i >> 3, f = i & 7;
            double inv;
            switch (f) { case 0: inv = 1.0; break; case 1: inv = 0.19392274474868576; break; case 2: inv = 0.03760603093086393; break; case 3: inv = 0.007292664737217109; break;
                         case 4: inv = 0.001414213562373095; break; case 5: inv = 0.0002742481756762073; break; case 6: inv = 5.318295896944988e-05; break; default: inv = 1.031338537721246e-05; break; }
            const double rev = (double)pos[m] * inv * 0.15915494309189535; const float fr = (float)(rev - __builtin_rint(rev));
            tab[m * 16 + f] = __builtin_amdgcn_cosf(fr); tab[m * 16 + 8 + f] = __builtin_amdgcn_sinf(fr); }
    }
}

#define XB_TMO      128
#define XB_XCNT(j)  (256  + 64 * (j))
#define XB_XSUB(j)  (1280 + 64 * (j))
#define XB_XGEN(j)  (2304 + 64 * (j))
#define XB_TOP      3328
#define XB_TOPGEN   3392
#define XCD_BAR_WORDS 3456
#define XB_SPIN_CAP (1u << 18)

__device__ __forceinline__ unsigned xb_ld(unsigned* p)              { return __hip_atomic_load(p, __ATOMIC_RELAXED, __HIP_MEMORY_SCOPE_AGENT); }
__device__ __forceinline__ unsigned xb_add(unsigned* p, unsigned v) { return __hip_atomic_fetch_add(p, v, __ATOMIC_RELAXED, __HIP_MEMORY_SCOPE_AGENT); }
__device__ __forceinline__ unsigned xb_xcc_id() { return (unsigned)__builtin_amdgcn_s_getreg((3 << 11) | 20) & 0xFu; }
#define XB_SPIN(cond, bar) do { unsigned _sp = 0; while (cond) { __builtin_amdgcn_s_sleep(1); \
    if ((++_sp & 255u) == 0u) { if (xb_ld(&(bar)[XB_TMO])) break; if (_sp > XB_SPIN_CAP) { atomicAdd(&(bar)[XB_TMO], 1u); break; } } } } while (0)

struct XcdBarrier {
    unsigned* bar; unsigned x;
    volatile LAS unsigned* st;
};

__device__ __forceinline__ XcdBarrier xcd_barrier_post(unsigned* bar, volatile LAS unsigned* st) {
    XcdBarrier b; b.bar = bar; b.x = xb_xcc_id(); b.st = st;
    if (threadIdx.x == 0) (void)xb_add(&bar[XB_XCNT(b.x)], 1u);
    return b;
}
__device__ __forceinline__ void xcd_barrier_complete(unsigned* bar, unsigned x, unsigned& nloc, unsigned& nx) {
    const unsigned G = gridDim.x * gridDim.y * gridDim.z;
    unsigned sum, cnt, mine, sp = 0u;
    for (;;) {
        sum = 0u; cnt = 0u; mine = 0u;
#pragma unroll
        for (unsigned j = 0; j < 16; ++j) { const unsigned c = xb_ld(&bar[XB_XCNT(j)]); sum += c; cnt += (c > 0u) ? 1u : 0u; mine = (j == x) ? c : mine; }
        if (sum == G) break;
        __builtin_amdgcn_s_sleep(1);
        if ((++sp & 255u) == 0u) { if (xb_ld(&bar[XB_TMO])) break; if (sp > XB_SPIN_CAP) { atomicAdd(&bar[XB_TMO], 1u); break; } }
    }
    nloc = mine > 0u ? mine : 1u; nx = cnt > 0u ? cnt : 1u;
}

__device__ __forceinline__ void xcd_barrier(const XcdBarrier& b) {
    asm volatile("s_waitcnt vmcnt(0)" ::: "memory");
    __syncthreads();
    if (threadIdx.x == 0) {
        unsigned* bar = b.bar;
        __builtin_amdgcn_s_waitcnt(0);
        unsigned nloc = b.st[0], nx = b.st[1];
        if (nloc == 0u) { xcd_barrier_complete(bar, b.x, nloc, nx); b.st[0] = nloc; b.st[1] = nx; }
        const unsigned old = xb_add(&bar[XB_XSUB(b.x)], 1u);
        const unsigned gen = old / nloc;
        if (old + 1u == (gen + 1u) * nloc) {
            __builtin_amdgcn_fence(__ATOMIC_RELEASE, "agent");
            asm volatile("s_waitcnt vmcnt(0)" ::: "memory");
            const unsigned og = xb_add(&bar[XB_TOP], 1u);
            const unsigned tg = og / nx;
            if (og + 1u == (tg + 1u) * nx) xb_add(&bar[XB_TOPGEN], 1u);
            else XB_SPIN(xb_ld(&bar[XB_TOPGEN]) == tg, bar);
            __builtin_amdgcn_fence(__ATOMIC_ACQUIRE, "agent");
            xb_add(&bar[XB_XGEN(b.x)], 1u);
            asm volatile("s_waitcnt vmcnt(0)" ::: "memory");
        } else {
            XB_SPIN(xb_ld(&bar[XB_XGEN(b.x)]) == gen, bar);
            __builtin_amdgcn_fence(__ATOMIC_ACQUIRE, "agent");
            asm volatile("s_waitcnt vmcnt(0)" ::: "memory");
        }
    }
    __syncthreads();
}

constexpr int NPHASE = 21;
__global__ void __launch_bounds__(NTHR, 2) fwd_kernel(Args a) {
    extern __shared__ __attribute__((aligned(16))) unsigned char lds_raw[];
    LAS unsigned char* lds = (LAS unsigned char*)lds_raw;
    cg::grid_group grid = cg::this_grid();
    const int tid = threadIdx.x, lane = tid & 63, wave = __builtin_amdgcn_readfirstlane(tid >> 6);
    const int G = gridDim.x, gw = blockIdx.x * NWAVES + wave, NGW = G * NWAVES;
    const int lo = a.ph_lo, hi = a.ph_hi;
    volatile LAS unsigned* MISC = (volatile LAS unsigned*)(lds + LDS_BYTES - 256);
    if (tid < 32) MISC[tid] = 0u;
    __syncthreads();
    XcdBarrier bar = xcd_barrier_post((unsigned*)a.ws, MISC + 8);
    if (hi < 0) grid.sync();
#define PH_BEGIN(k) if (lo <= (k) && (k) < hi) { const CAS char* kp_ = kargs_ptr(); unsigned char* const ws = KWS; (void)ws;
#define PH_END(k) if ((k) + 1 < hi) xcd_barrier(bar); }
#define GEMM_BF(k, Aptr, lda_, Bptr, N_, K_, O0, ld0, O1, ld1, split, bias, segw, segstride, ssp, tail_) PH_BEGIN(k) { pg8::Gemm g{(const bf16*)(Aptr), (const bf16*)(Bptr), M, N_, K_, lda_}; pg8::EpiBf16X e{(bf16*)(O0), ld0, (bf16*)(O1), ld1, split, bias, segw, segstride, ssp}; \
        pg8::StaticOrder S; S.init(M, N_, G, (int)blockIdx.x); pg8::gemm_phase<pg8::EpiBf16X, pg8::StaticOrder, true, true>(lds, g, S, e); { tail_; } } PH_END(k)
#define GEMM_GLU(k, Aptr, Bptr, layer, ssp, tail_) PH_BEGIN(k) { pg8::Gemm g{(const bf16*)(Aptr), (const bf16*)(Bptr), M, UW, D, D}; \
        pg8::EpiGlu e{(bf16*)(ws + WS_H), KIN(I_FCW) + (size_t)(layer) * 3 * DFF, KIN(I_FCB) + (size_t)(layer) * DFF, (float*)(ws + WS_HG), (float*)(ws + WS_HV), (float*)(ws + WS_TG), ssp}; \
        pg8::StaticOrder S; S.init(M, UW, G, (int)blockIdx.x); pg8::gemm_phase<pg8::EpiGlu, pg8::StaticOrder, true, true>(lds, g, S, e); { tail_; } } PH_END(k)
#define GEMM_RES(k, Aptr, lda_, Bptr, N_, K_, base, bias, xbp, ssp) PH_BEGIN(k) { pg8::Gemm g{(const bf16*)(Aptr), (const bf16*)(Bptr), M, N_, K_, lda_}; pg8::EpiRes e{base, KOUT, D, bias, (bf16*)(xbp), ssp}; \
        pg8::StaticOrder S; S.init(M, N_, G, (int)blockIdx.x); pg8::gemm_phase<pg8::EpiRes, pg8::StaticOrder, true, true>(lds, g, S, e); } PH_END(k)
    PH_BEGIN(0) p0_prologue(a, lds, tid, lane, wave); PH_END(0)
    GEMM_BF(1, ws + WS_XN1, D, ws + WS_WIN, ABIN, D, ws + WS_PC, 1024, (unsigned char*)KOUT + DO_PR, PRW, 1024, (const float*)(ws + WS_BIASP), PRW, 0, nullptr, if (G == 256 && blockIdx.x >= 192) tail_g1(a, lds, tid, lane, wave, (int)blockIdx.x - 192, 64); else if (G != 256) tail_g1(a, lds, tid, lane, wave, (int)blockIdx.x, G))
    PH_BEGIN(2) p2_prep(a, lds, tid, lane, wave); PH_END(2)
    GEMM_BF(3, ws + WS_LIN, LINW, ws + WS_WL, LOW, LINW, ws + WS_LOW, 512, ws + WS_LOW, 512, 0, nullptr, 512, (size_t)M * 512, nullptr, (void)0)
    PH_BEGIN(4) p4_rwkv_prep(a, lane, wave); PH_END(4)
    PH_BEGIN(5) scan_pass1(a, lds, lane, wave); PH_END(5)
    PH_BEGIN(6) comb_a(a, lds, tid, lane, wave); if (G == 256 && blockIdx.x >= 128) p8_prep2(a, lds, lane, wave, (int)blockIdx.x - 128, 128); else if (G != 256) p8_prep2(a, lds, lane, wave, (int)blockIdx.x, G); PH_END(6)
    PH_BEGIN(6) comb_b(a, lds, tid, lane, wave); PH_END(6)
    PH_BEGIN(6) comb_c(a, lds, tid, lane, wave); PH_END(6)
    PH_BEGIN(7) scan_pass2(a, lds, lane, wave); PH_END(7)
    GEMM_RES(8, ws + WS_CAT, D, ws + WS_WOUT, D, D, KIN(I_X), nullptr, ws + WS_XB, (float*)(ws + WS_SS))
    GEMM_GLU(10, ws + WS_XB, ws + WS_WUP0, 0, (float*)(ws + WS_SS), if (G == 256 && blockIdx.x >= 128) tail_g10(a, lds, lane, wave, (int)blockIdx.x - 128, 128); else if (G != 256) tail_g10(a, lds, lane, wave, (int)blockIdx.x, G))
    PH_BEGIN(11) glu_fixup(a, 0, tid); PH_END(11)
    GEMM_RES(12, ws + WS_H, DFF, ws + WS_WDN0, D, DFF, KOUT, nullptr, ws + WS_XB, (float*)(ws + WS_SS) + M)
    GEMM_BF(14, ws + WS_XB, D, ws + WS_WQKV, QKVW, D, ws + WS_QKV, QKVW, ws + WS_QKV, QKVW, 1 << 30, KIN(I_BQKV), 256, 0, (float*)(ws + WS_SS) + M, if (G == 256 && blockIdx.x >= 128) tail_g14(a, lds, lane, wave, (int)blockIdx.x - 128, 128); else if (G != 256) tail_g14(a, lds, lane, wave, (int)blockIdx.x, G))
    PH_BEGIN(15) p14_attn(a, lds, tid, lane, wave); PH_END(15)
    GEMM_RES(16, ws + WS_O, D, ws + WS_WO, D, D, KOUT, KIN(I_BO), ws + WS_XB, (float*)(ws + WS_SS) + 2 * M)
    GEMM_GLU(18, ws + WS_XB, ws + WS_WUP1, 1, (float*)(ws + WS_SS) + 2 * M, (void)0)
    PH_BEGIN(19) glu_fixup(a, 1, tid); PH_END(19)
    GEMM_RES(20, ws + WS_H, DFF, ws + WS_WDN1, D, DFF, KOUT, nullptr, nullptr, nullptr)
}

#ifndef N_LAUNCH_MODE
#define N_LAUNCH_MODE 1
#endif
extern "C" void kernel_launch(void* const* d_in, const int* in_sizes, int n_in, void* d_out, int out_size, void* d_ws, size_t ws_size, hipStream_t stream) {
    static int grid = 0;
    if (grid == 0) {
        if (n_in != 34 || out_size != M * D || ws_size < WS_END) { fprintf(stderr, "kernel_launch: unexpected shapes n_in %d out %d ws %zu\n", n_in, out_size, ws_size); grid = -1; return; }
        int dev = 0, cus = 0, per_cu = 0;
        hipGetDevice(&dev); hipDeviceGetAttribute(&cus, hipDeviceAttributeMultiprocessorCount, dev);
        if (hipFuncSetAttribute((const void*)fwd_kernel, hipFuncAttributeMaxDynamicSharedMemorySize, LDS_BYTES) != hipSuccess) { fprintf(stderr, "kernel_launch: hipFuncSetAttribute failed\n"); grid = -1; return; }
        if (hipOccupancyMaxActiveBlocksPerMultiprocessor(&per_cu, (const void*)fwd_kernel, NTHR, LDS_BYTES) != hipSuccess || per_cu < 1) { fprintf(stderr, "kernel_launch: occupancy query says %d\n", per_cu); per_cu = 1; }
        (void)hipGetLastError();
        grid = cus * 1;
    }
    if (grid < 0) return;
    if (hipMemsetAsync(d_ws, 0, 16384, stream) != hipSuccess) { fprintf(stderr, "kernel_launch: memset of the barrier words failed\n"); return; }
    Args a{};
    for (int i = 0; i < 34; ++i) a.in[i] = (const float*)d_in[i];
    a.out = (float*)d_out; a.ws = (unsigned char*)d_ws;
#if N_LAUNCH_MODE == 1
    a.ph_lo = 0; a.ph_hi = NPHASE;
    { void* args[] = {&a}; hipError_t e = hipLaunchCooperativeKernel((const void*)fwd_kernel, dim3(grid), dim3(NTHR), args, LDS_BYTES, stream);
      if (e != hipSuccess) fprintf(stderr, "cooperative launch failed: %s (grid %d)\n", hipGetErrorString(e), grid); }
#else
    for (int ph = 0; ph < NPHASE; ++ph) { a.ph_lo = ph; a.ph_hi = ph + 1; void* args[] = {&a};
        hipError_t e = hipLaunchCooperativeKernel((const void*)fwd_kernel, dim3(grid), dim3(NTHR), args, LDS_BYTES, stream);
        if (e != hipSuccess) { fprintf(stderr, "launch %d failed: %s\n", ph, hipGetErrorString(e)); break; } }
#endif
}
```

```cpp
#include <hip/hip_runtime.h>
#include <hip/hip_cooperative_groups.h>
#include <cstdio>
#include <cstdint>
namespace cg = cooperative_groups;
namespace pg8 {
#define PG8_LAS __attribute__((address_space(3)))
typedef unsigned short bf16_t;
typedef short bf16x8 __attribute__((ext_vector_type(8)));
typedef float f32x4 __attribute__((ext_vector_type(4)));
typedef unsigned u32x4 __attribute__((ext_vector_type(4)));
constexpr int BM = 256, BK = 64, HALF = 128, HTB = HALF * BK * 2  , STAGE_BYTES = 8 * HTB, NXCD = 8, WGM = 8;

__host__ __device__ __forceinline__ int lds_byte(int r, int c) { const int st = (r >> 4) * 2 + (c >> 5), rr = r & 15, cc = c & 31, ob = rr * 64 + cc * 2; return st * 1024 + (ob ^ (((ob >> 9) & 1) << 5)); }
__host__ __device__ __forceinline__ void stage_rc(int b, int& R, int& C) { const int st = b / 1024, sb = b % 1024, swz = sb ^ (((sb >> 9) & 1) << 5); R = (st >> 1) * 16 + swz / 64; C = (st & 1) * 32 + (swz % 64) / 2; }
__host__ __device__ __forceinline__ int perm32(int rho) { const int n = rho >> 4, i = rho & 15; return 8 * (i >> 2) + 4 * n + (i & 3); }

struct Unit { int pm, pn; };
struct Gemm { const bf16_t* A; const bf16_t* Bt; int M, N, K, lda; };

struct StaticOrder {
    int nM, nN, nwg, G, c;
    __host__ __device__ void init(int M, int N, int G_, int c_) { nM = M / BM; nN = N / BM; nwg = nM * nN; G = G_; c = c_; }
    __host__ __device__ bool next(int i, Unit& u) const {
        const long L = (long)i * G + c; if (L >= nwg) return false;
        int wgid = (int)L; { const int q = nwg / NXCD, r = nwg % NXCD, xcd = wgid % NXCD, off = wgid / NXCD; wgid = (xcd < r ? xcd * (q + 1) : r * (q + 1) + (xcd - r) * q) + off; }
        const int nig = WGM * nN, gid = wgid / nig, fm = gid * WGM, gsz = (nM - fm) < WGM ? (nM - fm) : WGM;
        u.pm = fm + ((wgid % nig) % gsz); u.pn = (wgid % nig) / gsz; return true;
    }
    __device__ __forceinline__ void a_ready(const Unit&) const {}
    __device__ __forceinline__ void done(const Unit&) const {}
};

__device__ __forceinline__ unsigned cvt_pk_bf16(float lo, float hi) { unsigned r; asm volatile("v_cvt_pk_bf16_f32 %0, %1, %2" : "=v"(r) : "v"(lo), "v"(hi)); return r; }
typedef float f32x2 __attribute__((ext_vector_type(2)));

template <class Epi, class Sched, bool ALIGN_EPI = false, bool SP2 = false>
__device__ __forceinline__ void gemm_phase(PG8_LAS unsigned char* lds, const Gemm g, const Sched& S, const Epi& E) {
    const int tid = threadIdx.x, wid = __builtin_amdgcn_readfirstlane(tid >> 6), lane = tid & 63, wr = wid >> 2, wc = wid & 3, fr = lane & 15, fq = lane >> 4;
    const int K = g.K, nt = K / BK;
    unsigned voffA[2], voffB[2];
#pragma unroll
    for (int i = 0; i < 2; ++i) { int R, C; stage_rc(tid * 16 + i * 8192, R, C); const int Rb = Epi::PERM ? ((R & ~31) + perm32(R & 31)) : R;
        voffA[i] = (unsigned)(R * g.lda + C) * 2u; voffB[i] = (unsigned)(Rb * K + C) * 2u; }
    const size_t kstep = (size_t)(BK * 2);
    const size_t hstep = (size_t)HALF * K * 2;
    const size_t tstep = 2 * hstep; const size_t hstepA = (size_t)HALF * g.lda * 2, tstepA = 2 * hstepA;
    const unsigned ldsw = (unsigned)wid * 1024u;
    const int aoff = lds_byte(wr * 64 + fr, fq * 8), boff = lds_byte(wc * 32 + fr, fq * 8);
#define PG8_SA(b, h) (((b) * 2 + (h)) * HTB)
#define PG8_SB(b, h) ((4 + (b) * 2 + (h)) * HTB)
#define PG8_STAGE(bufoff, gbase, voff) do { _Pragma("unroll") for (int _i = 0; _i < 2; ++_i) \
        __builtin_amdgcn_global_load_lds((const unsigned*)((const char*)(gbase) + (voff)[_i]), (PG8_LAS unsigned*)(lds + (bufoff) + ldsw + _i * 8192), 16, 0, 0); } while (0)
#define PG8_LDA(dst, b, h) do { _Pragma("unroll") for (int m = 0; m < 4; ++m) _Pragma("unroll") for (int k = 0; k < 2; ++k) dst[m][k] = *(const PG8_LAS bf16x8*)(lds + PG8_SA(b, h) + aoff + m * 2048 + k * 1024); } while (0)
#define PG8_LDB(dst, b, h) do { _Pragma("unroll") for (int n = 0; n < 2; ++n) _Pragma("unroll") for (int k = 0; k < 2; ++k) dst[n][k] = *(const PG8_LAS bf16x8*)(lds + PG8_SB(b, h) + boff + n * 2048 + k * 1024); } while (0)
#define PG8_MMA(ai, bj, At, Bt) do { __builtin_amdgcn_s_setprio(1); _Pragma("unroll") for (int m = 0; m < 4; ++m) _Pragma("unroll") for (int n = 0; n < 2; ++n) _Pragma("unroll") for (int k = 0; k < 2; ++k) \
        acc[ai][bj][m][n] = __builtin_amdgcn_mfma_f32_16x16x32_bf16(Bt[n][k], At[m][k], acc[ai][bj][m][n], 0, 0, 0); __builtin_amdgcn_s_setprio(0); } while (0)
#define PG8_WAIT_V(n) asm volatile("s_waitcnt vmcnt(" #n ")" ::: "memory")
#define PG8_WAIT_L(n) asm volatile("s_waitcnt lgkmcnt(" #n ")" ::: "memory")
#define PG8_BAR __builtin_amdgcn_s_barrier()
#define PG8_SCHED __builtin_amdgcn_sched_barrier(0)
    Unit cur, nxt; int ui = 0;
    if (!S.next(0, cur)) return;
    f32x4 acc[2][2][4][2];
#pragma unroll
    for (int a = 0; a < 2; ++a)
#pragma unroll
        for (int b = 0; b < 2; ++b)
#pragma unroll
            for (int m = 0; m < 4; ++m)
#pragma unroll
                for (int n = 0; n < 2; ++n) acc[a][b][m][n] = (f32x4){0.f, 0.f, 0.f, 0.f};
    bf16x8 At[4][2], B0[2][2], B1[2][2];
    const char* cA = (const char*)g.A + (size_t)cur.pm * tstepA; const char* cB = (const char*)g.Bt + (size_t)cur.pn * tstep;
    S.a_ready(cur);
    if constexpr (SP2) {
        PG8_STAGE(PG8_SB(0, 0), cB, voffB); PG8_STAGE(PG8_SB(0, 1), cB + hstep, voffB); PG8_STAGE(PG8_SA(0, 0), cA, voffA); PG8_STAGE(PG8_SA(0, 1), cA + hstepA, voffA);
        if (wr == 1) PG8_BAR;
        PG8_WAIT_V(2); PG8_BAR;
        PG8_STAGE(PG8_SB(1, 0), cB + kstep, voffB); PG8_STAGE(PG8_SA(1, 0), cA + kstep, voffA); PG8_STAGE(PG8_SB(1, 1), cB + hstep + kstep, voffB);
        PG8_WAIT_V(6); PG8_BAR;
    } else {
        PG8_STAGE(PG8_SB(0, 0), cB, voffB); PG8_STAGE(PG8_SA(0, 0), cA, voffA); PG8_STAGE(PG8_SB(0, 1), cB + hstep, voffB); PG8_STAGE(PG8_SA(0, 1), cA + hstepA, voffA);
        if (wr == 1) PG8_BAR;
        PG8_WAIT_V(4); PG8_BAR;
        PG8_STAGE(PG8_SB(1, 0), cB + kstep, voffB); PG8_STAGE(PG8_SA(1, 0), cA + kstep, voffA); PG8_STAGE(PG8_SB(1, 1), cB + hstep + kstep, voffB);
        PG8_WAIT_V(6); PG8_BAR;
    }
    for (;;) {
        const bool has_next = S.next(ui + 1, nxt);
        const char* nA = has_next ? (const char*)g.A + (size_t)nxt.pm * tstepA : cA; const char* nB = has_next ? (const char*)g.Bt + (size_t)nxt.pn * tstep : cB;
        for (int t = 0; t < nt; t += 2) {
            const bool last = (t == nt - 2);
            const char* a1 = cA + (size_t)(t + 1) * kstep;
            const char* a2 = last ? nA : cA + (size_t)(t + 2) * kstep; const char* b2 = last ? nB : cB + (size_t)(t + 2) * kstep;
            const char* a3 = a2 + kstep; const char* b3 = b2 + kstep;
            if (last && has_next) S.a_ready(nxt);
            if constexpr (SP2) {
            PG8_LDB(B0, 0, 0); PG8_LDB(B1, 0, 1); PG8_SCHED; PG8_LDA(At, 0, 0); PG8_STAGE(PG8_SA(1, 1), a1 + hstepA, voffA);
            PG8_WAIT_V(8); PG8_WAIT_L(0); PG8_BAR; PG8_MMA(0, 0, At, B0); PG8_MMA(0, 1, At, B1); PG8_BAR; PG8_SCHED;
            PG8_LDA(At, 0, 1); PG8_STAGE(PG8_SB(0, 0), b2, voffB); PG8_STAGE(PG8_SB(0, 1), b2 + hstep, voffB); PG8_STAGE(PG8_SA(0, 0), a2, voffA);
            PG8_WAIT_V(8); PG8_WAIT_L(0); PG8_BAR; PG8_MMA(1, 0, At, B0); PG8_MMA(1, 1, At, B1); PG8_BAR; PG8_SCHED;
            PG8_LDB(B0, 1, 0); PG8_LDB(B1, 1, 1); PG8_SCHED; PG8_LDA(At, 1, 0); PG8_STAGE(PG8_SA(0, 1), a2 + hstepA, voffA);
            PG8_WAIT_V(8); PG8_WAIT_L(0); PG8_BAR; PG8_MMA(0, 0, At, B0); PG8_MMA(0, 1, At, B1); PG8_BAR; PG8_SCHED;
            PG8_LDA(At, 1, 1); PG8_STAGE(PG8_SB(1, 0), b3, voffB); PG8_STAGE(PG8_SB(1, 1), b3 + hstep, voffB); PG8_STAGE(PG8_SA(1, 0), a3, voffA);
            PG8_WAIT_V(8); PG8_WAIT_L(0); PG8_BAR; PG8_MMA(1, 0, At, B0); PG8_MMA(1, 1, At, B1); PG8_BAR; PG8_SCHED;
            } else {
            PG8_LDB(B0, 0, 0); PG8_SCHED; PG8_LDA(At, 0, 0); PG8_STAGE(PG8_SA(1, 1), a1 + hstepA, voffA);
            PG8_WAIT_L(8); PG8_BAR; PG8_WAIT_L(0); PG8_MMA(0, 0, At, B0); PG8_BAR; PG8_SCHED;
            PG8_LDB(B1, 0, 1); PG8_STAGE(PG8_SB(0, 0), b2, voffB);
            PG8_BAR; PG8_WAIT_L(0); PG8_MMA(0, 1, At, B1); PG8_BAR;
            PG8_LDA(At, 0, 1); PG8_STAGE(PG8_SA(0, 0), a2, voffA);
            PG8_BAR; PG8_WAIT_L(0); PG8_MMA(1, 0, At, B0); PG8_BAR; PG8_SCHED;
            PG8_STAGE(PG8_SB(0, 1), b2 + hstep, voffB);
            PG8_WAIT_V(6); PG8_BAR; PG8_MMA(1, 1, At, B1); PG8_BAR;
            PG8_LDB(B0, 1, 0); PG8_SCHED; PG8_LDA(At, 1, 0); PG8_STAGE(PG8_SA(0, 1), a2 + hstepA, voffA);
            PG8_WAIT_L(8); PG8_BAR; PG8_WAIT_L(0); PG8_MMA(0, 0, At, B0); PG8_BAR; PG8_SCHED;
            PG8_LDB(B1, 1, 1); PG8_STAGE(PG8_SB(1, 0), b3, voffB);
            PG8_BAR; PG8_WAIT_L(0); PG8_MMA(0, 1, At, B1); PG8_BAR;
            PG8_LDA(At, 1, 1); PG8_STAGE(PG8_SA(1, 0), a3, voffA);
            PG8_BAR; PG8_WAIT_L(0); PG8_MMA(1, 0, At, B0); PG8_BAR; PG8_SCHED;
            PG8_STAGE(PG8_SB(1, 1), b3 + hstep, voffB);
            PG8_WAIT_V(6); PG8_BAR; PG8_MMA(1, 1, At, B1); PG8_BAR;
            }
        }
        if constexpr (ALIGN_EPI) { if (wr == 0) PG8_BAR; }
        if constexpr (!Epi::AFTER_DRAIN) { E(acc, cur, wr, wc, fr, fq); S.done(cur); }
        if (!has_next) break;
#pragma unroll
        for (int a = 0; a < 2; ++a)
#pragma unroll
            for (int b = 0; b < 2; ++b)
#pragma unroll
                for (int m = 0; m < 4; ++m)
#pragma unroll
                    for (int n = 0; n < 2; ++n) acc[a][b][m][n] = (f32x4){0.f, 0.f, 0.f, 0.f};
        cur = nxt; cA = nA; cB = nB; ++ui;
        if constexpr (ALIGN_EPI) { if (wr == 1) PG8_BAR; }
    }
    PG8_WAIT_V(0);
    if constexpr (!ALIGN_EPI) { if (wr == 0) PG8_BAR; }
    PG8_BAR;
    if constexpr (Epi::AFTER_DRAIN) { E.fused(acc, cur, wr, wc, fr, fq, lds, wid, lane); S.done(cur); }
#undef PG8_SA
#undef PG8_SB
#undef PG8_STAGE
#undef PG8_LDA
#undef PG8_LDB
#undef PG8_MMA
#undef PG8_WAIT_V
#undef PG8_WAIT_L
#undef PG8_BAR
#undef PG8_SCHED
}
}

namespace pg8 {
struct EpiBf16X {
    static constexpr bool PERM = true, AFTER_DRAIN = false;
    bf16_t* O0; int ld0; bf16_t* O1; int ld1; int split; const float* bias; int segw; size_t segstride; const float* ss;
    __device__ __forceinline__ void operator()(const f32x4 (&acc)[2][2][4][2], const Unit& u, int wr, int wc, int fr, int fq) const {
        const int row0 = u.pm * BM + wr * 64 + fr; const int colt = u.pn * BM;
        bf16_t* base; int ldc, cb;
        if (colt < split) { base = O0; ldc = ld0; cb = colt; } else { const int rel = colt - split, sg = rel / segw; base = O1 + (size_t)sg * segstride; ldc = ld1; cb = rel - sg * segw; }
        const int col0 = cb + wc * 32 + 8 * fq, bcol0 = colt + wc * 32 + 8 * fq;
        f32x4 bv[2][2];
#pragma unroll
        for (int bj = 0; bj < 2; ++bj)
#pragma unroll
            for (int n = 0; n < 2; ++n) bv[bj][n] = bias ? *(const f32x4*)(bias + bcol0 + bj * HALF + 4 * n) : (f32x4){0.f, 0.f, 0.f, 0.f};
#pragma unroll
        for (int ai = 0; ai < 2; ++ai)
#pragma unroll
            for (int m = 0; m < 4; ++m) { bf16_t* rowp = base + (size_t)(row0 + ai * HALF + m * 16) * ldc + col0;
                const float rs = ss ? __builtin_amdgcn_rsqf(ss[row0 + ai * HALF + m * 16] * (1.f / 1024.f) + 1e-6f) : 1.f;
#pragma unroll
                for (int bj = 0; bj < 2; ++bj) { const f32x4 v0 = acc[ai][bj][m][0] * rs + bv[bj][0], v1 = acc[ai][bj][m][1] * rs + bv[bj][1];
                    u32x4 w; w.x = cvt_pk_bf16(v0[0], v0[1]); w.y = cvt_pk_bf16(v0[2], v0[3]); w.z = cvt_pk_bf16(v1[0], v1[1]); w.w = cvt_pk_bf16(v1[2], v1[3]);
                    *(u32x4*)(rowp + bj * HALF) = w; } }
    }
};
struct EpiRes {
    static constexpr bool PERM = false, AFTER_DRAIN = false;
    const float* base; float* out; int ldc; const float* bias; bf16_t* xb; float* ss;
    __device__ __forceinline__ void operator()(const f32x4 (&acc)[2][2][4][2], const Unit& u, int wr, int wc, int fr, int fq) const {
        const int col0 = u.pn * BM + wc * 32 + 4 * fq;
        f32x4 bv[2][2];
#pragma unroll
        for (int bj = 0; bj < 2; ++bj)
#pragma unroll
            for (int n = 0; n < 2; ++n) bv[bj][n] = bias ? *(const f32x4*)(bias + col0 + bj * HALF + n * 16) : (f32x4){0.f, 0.f, 0.f, 0.f};
#pragma unroll
        for (int ai = 0; ai < 2; ++ai)
#pragma unroll
            for (int m = 0; m < 4; ++m) { const int row = u.pm * BM + ai * HALF + wr * 64 + m * 16 + fr; const size_t off = (size_t)row * ldc + col0; float sq = 0.f;
#pragma unroll
                for (int bj = 0; bj < 2; ++bj)
#pragma unroll
                    for (int n = 0; n < 2; ++n) { const size_t o = off + bj * HALF + n * 16; const f32x4 bs = *(const f32x4*)(base + o);
                        const f32x4 v = bs + acc[ai][bj][m][n] + bv[bj][n]; *(f32x4*)(out + o) = v;
                        if (xb) { sq += (v[0] * v[0] + v[1] * v[1]) + (v[2] * v[2] + v[3] * v[3]);
                            typedef unsigned u32x2_ __attribute__((ext_vector_type(2))); u32x2_ w; w.x = cvt_pk_bf16(v[0], v[1]); w.y = cvt_pk_bf16(v[2], v[3]); *(u32x2_*)(xb + o) = w; } }
                if (xb) { sq += __shfl_xor(sq, 16); sq += __shfl_xor(sq, 32); if (fq == 0) atomicAdd(ss + row, sq); } }
    }
};
struct EpiGlu {
    static constexpr bool PERM = true, AFTER_DRAIN = false;
    bf16_t* H; const float* cw; const float* cb; float* HG; float* HV; float* TG; const float* ss;
    __device__ __forceinline__ void operator()(const f32x4 (&acc)[2][2][4][2], const Unit& u, int wr, int wc, int fr, int fq) const {
        constexpr int DFF_ = 2816;
        const int gc0 = u.pn * 128 + wc * 32 + 8 * fq;
        float w0[8], w1[8], w2[8], bb[8];
#pragma unroll
        for (int h = 0; h < 2; ++h) { const f32x4 a0 = *(const f32x4*)(cw + gc0 + 4 * h), a1 = *(const f32x4*)(cw + DFF_ + gc0 + 4 * h), a2 = *(const f32x4*)(cw + 2 * DFF_ + gc0 + 4 * h), a3 = *(const f32x4*)(cb + gc0 + 4 * h);
#pragma unroll
            for (int e = 0; e < 4; ++e) { w0[4 * h + e] = a0[e]; w1[4 * h + e] = a1[e]; w2[4 * h + e] = a2[e]; bb[4 * h + e] = a3[e]; } }
        const int l1 = (fq << 4) | ((fr + 15) & 15), l2 = (fq << 4) | ((fr + 14) & 15);
#pragma unroll
        for (int ai = 0; ai < 2; ++ai) {
            const int rbase = u.pm * BM + ai * HALF + wr * 64; const int blk = rbase >> 6;
            float rs[4];
#pragma unroll
            for (int m = 0; m < 4; ++m) rs[m] = __builtin_amdgcn_rsqf(ss[rbase + m * 16 + fr] * (1.f / 1024.f) + 1e-6f);
#pragma unroll
            for (int m = 0; m < 4; ++m) {
                float g[8], gp[8], vl[8], o[8];
#pragma unroll
                for (int n = 0; n < 2; ++n)
#pragma unroll
                    for (int e = 0; e < 4; ++e) { g[4 * n + e] = acc[ai][0][m][n][e] * rs[m]; vl[4 * n + e] = acc[ai][1][m][n][e] * rs[m]; gp[4 * n + e] = m > 0 ? acc[ai][0][m - 1][n][e] * rs[m - 1] : 0.f; }
#pragma unroll
                for (int e = 0; e < 8; ++e) { const float s1 = fr == 15 ? gp[e] : g[e], s2 = fr >= 14 ? gp[e] : g[e];
                    const float p1 = __shfl(s1, l1), p2 = __shfl(s2, l2);
                    const float x = w0[e] * p2 + w1[e] * p1 + w2[e] * g[e] + bb[e];
                    o[e] = x * __builtin_amdgcn_rcpf(1.f + __expf(-x)) * vl[e]; }
                const int row = rbase + m * 16 + fr;
                if (m == 0 && fr < 2) {
                    float* hg = HG + ((size_t)blk * 2 + fr) * DFF_ + gc0; float* hv = HV + ((size_t)blk * 2 + fr) * DFF_ + gc0;
                    *(f32x4*)hg = (f32x4){g[0], g[1], g[2], g[3]}; *(f32x4*)(hg + 4) = (f32x4){g[4], g[5], g[6], g[7]};
                    *(f32x4*)hv = (f32x4){vl[0], vl[1], vl[2], vl[3]}; *(f32x4*)(hv + 4) = (f32x4){vl[4], vl[5], vl[6], vl[7]};
                } else {
                    u32x4 w; w.x = cvt_pk_bf16(o[0], o[1]); w.y = cvt_pk_bf16(o[2], o[3]); w.z = cvt_pk_bf16(o[4], o[5]); w.w = cvt_pk_bf16(o[6], o[7]);
                    *(u32x4*)(H + (size_t)row * DFF_ + gc0) = w;
                }
                if (m == 3 && fr >= 14) { float* tg = TG + ((size_t)blk * 2 + (fr - 14)) * DFF_ + gc0;
                    *(f32x4*)tg = (f32x4){g[0], g[1], g[2], g[3]}; *(f32x4*)(tg + 4) = (f32x4){g[4], g[5], g[6], g[7]}; }
            }
        }
    }
};
}

constexpr int NWAVES = 8, NTHR = 512;
constexpr int BATCH = 2, T = 8192, D = 1024, M = BATCH * T;
constexpr int ABIN = 2816, PRW = 1792, DFF = 2816, UW = 5632, QKVW = 1536, LOW = 1536, LINW = 256, NH = 8;
constexpr size_t MiB = 1u << 20;
constexpr size_t WS_BON = 1 * MiB, WS_BIASP = 1 * MiB + 768 * 1024;
constexpr size_t WS_WIN = 2 * MiB, WS_WL = 8 * MiB, WS_WOUT = 254 * MiB, WS_LOW = 13 * MiB, WS_LOA = 29 * MiB, WS_LOG = 45 * MiB, WS_ST = 13 * MiB, WS_CAT = 61 * MiB, WS_SEQ = 93 * MiB;
constexpr size_t WS_XN1 = 93 * MiB, WS_PC = 125 * MiB, WS_LIN = 157 * MiB;
constexpr size_t WS_ROPE = 253 * MiB;
constexpr size_t DO_PR = 0, DO_ST = 56 * MiB;
constexpr size_t WS_WUP0 = 2 * MiB, WS_WDN0 = 13 * MiB, WS_WQKV = 19 * MiB, WS_WO = 22 * MiB, WS_WUP1 = 24 * MiB, WS_WDN1 = 35 * MiB;
constexpr size_t WS_H = 41 * MiB, WS_HG = 130 * MiB, WS_HV = 136 * MiB, WS_TG = 142 * MiB, WS_QKV = 41 * MiB, WS_O = 89 * MiB, WS_XB = 219 * MiB, WS_END = 256 * MiB;
constexpr size_t WS_SS = 1 * MiB + 512 * 1024;
constexpr int LDS_BYTES = 147456;

#define LAS __attribute__((address_space(3)))
typedef unsigned short bf16;
typedef float f32x4 __attribute__((ext_vector_type(4)));
typedef unsigned v4u __attribute__((ext_vector_type(4)));
typedef unsigned v2u __attribute__((ext_vector_type(2)));
typedef short bf16x8 __attribute__((ext_vector_type(8)));
typedef float f32x16 __attribute__((ext_vector_type(16)));
typedef float f32x2 __attribute__((ext_vector_type(2)));
#define LDS_WAIT() asm volatile("s_waitcnt lgkmcnt(0)" ::: "memory")

typedef __bf16 bf16x2_hw __attribute__((ext_vector_type(2)));
__device__ __forceinline__ unsigned pk2(float lo, float hi) { const f32x2 v = {lo, hi}; return __builtin_bit_cast(unsigned, __builtin_convertvector(v, bf16x2_hw)); }
__device__ __forceinline__ unsigned f2bf(float f) { return pk2(f, 0.f) & 0xffffu; }
__device__ __forceinline__ float bf2f(unsigned h) { return __builtin_bit_cast(float, h << 16); }
__device__ __forceinline__ float bflo(unsigned w) { return __builtin_bit_cast(float, w << 16); }
__device__ __forceinline__ float bfhi(unsigned w) { return __builtin_bit_cast(float, w & 0xffff0000u); }
template <int CTRL> __device__ __forceinline__ float dppf(float x) { return __builtin_bit_cast(float, __builtin_amdgcn_update_dpp(0, __builtin_bit_cast(int, x), CTRL, 0xf, 0xf, false)); }
template <int O> __device__ __forceinline__ float xstep(float v) {
    if constexpr (O == 1) return v + dppf<0xB1>(v);
    else if constexpr (O == 2) return v + dppf<0x4E>(v);
    else if constexpr (O == 4) return v + dppf<0x141>(v);
    else if constexpr (O == 8) return v + dppf<0x140>(v);
    else if constexpr (O == 16) return v + __builtin_bit_cast(float, __builtin_amdgcn_update_dpp(0, __builtin_bit_cast(int, v), 0x142, 0xa, 0xf, false));
    else { const float t = v + __builtin_bit_cast(float, __builtin_amdgcn_update_dpp(0, __builtin_bit_cast(int, v), 0x143, 0xc, 0xf, false));
        return __builtin_bit_cast(float, __builtin_amdgcn_readlane(__builtin_bit_cast(int, t), 63)); }
}
__device__ __forceinline__ float wave_sum(float v) {
    v = xstep<1>(v); v = xstep<2>(v); v = xstep<4>(v); v = xstep<8>(v); v = xstep<16>(v); v = xstep<32>(v);
    return v;
}
__device__ __forceinline__ float sigm(float x) { return __builtin_amdgcn_rcpf(1.f + __expf(-x)); }
__device__ __forceinline__ float tanh_fast(float x) { return 1.f - 2.f * __builtin_amdgcn_rcpf(__expf(2.f * x) + 1.f); }

struct Args { const float* in[34]; float* out; unsigned char* ws; int ph_lo, ph_hi; };
#define CAS __attribute__((address_space(4)))
__device__ __forceinline__ const CAS char* kargs_ptr() { const CAS char* kp = (const CAS char*)__builtin_amdgcn_kernarg_segment_ptr(); asm volatile("" : "+s"(kp)); return kp; }
#define KIN(i) (*(const float* const CAS*)(kp_ + 8 * (i)))
#define KOUT (*(float* const CAS*)(kp_ + 8 * 34))
#define KWS (*(unsigned char* const CAS*)(kp_ + 8 * 35))
enum { I_X = 0, I_POS, I_ABG, I_WIN, I_CINB, I_DWW, I_DWB, I_CLNG, I_CLNB, I_MU, I_W0, I_W2, I_A0, I_A2, I_G2, I_KK, I_KA, I_RK, I_RLNG, I_RLNB, I_WOUT,
       I_ATG, I_WQKV, I_BQKV, I_QNG, I_KNG, I_SINK, I_WO, I_BO, I_FNG, I_WUP, I_FCW, I_FCB, I_WDN };

__device__ __forceinline__ void transpose_item(const float* W, int K, int N, bf16* WT, LAS float* scr, int item, int lane, const float* gain, int glu) {
    const int nblk = N / 32, kb = item / nblk, nb = item % nblk, k0 = 64 * kb, n0 = 32 * nb;
#pragma unroll 8
    for (int i = 0; i < 32; ++i) { const int kk = 2 * i + (lane >> 5); const float gk = gain ? gain[k0 + kk] : 1.f; scr[kk * 33 + (lane & 31)] = W[(size_t)(k0 + kk) * N + n0 + (lane & 31)] * gk; }
    LDS_WAIT(); asm volatile("" ::: "memory");
    const int c = lane & 7;
#pragma unroll
    for (int j = 0; j < 4; ++j) { const int n = (lane >> 3) + 8 * j; const LAS float* s = scr + (8 * c) * 33 + n;
        v4u o; o.x = pk2(s[0 * 33], s[1 * 33]); o.y = pk2(s[2 * 33], s[3 * 33]); o.z = pk2(s[4 * 33], s[5 * 33]); o.w = pk2(s[6 * 33], s[7 * 33]);
        const int nn = n0 + n; const int dr = glu ? (nn < DFF ? (nn >> 7) * 256 + (nn & 127) : ((nn - DFF) >> 7) * 256 + 128 + ((nn - DFF) & 127)) : nn;
        *(v4u*)(WT + (size_t)dr * K + k0 + 8 * c) = o; }
    LDS_WAIT(); asm volatile("" ::: "memory");
}
__device__ __forceinline__ void transpose_mat(const float* W, int K, int N, bf16* WT, LAS float* scr, int gw, int NGW, int lane, const float* gain = nullptr, int glu = 0) {
    const int nitems = (K / 64) * (N / 32);
    for (int it = gw; it < nitems; it += NGW) transpose_item(W, K, N, WT, scr, it, lane, gain, glu);
}
__device__ __forceinline__ void rms_rows(const float* src, const float* g, bf16* dst, int gw, int NGW, int lane) {
    for (int m = gw; m < M; m += NGW) {
        const f32x4* xr = (const f32x4*)(src + (size_t)m * D) + lane; const f32x4* gr = (const f32x4*)g + lane;
        f32x4 v[4]; float s = 0.f;
#pragma unroll
        for (int j = 0; j < 4; ++j) { v[j] = xr[64 * j]; s += (v[j].x * v[j].x + v[j].y * v[j].y) + (v[j].z * v[j].z + v[j].w * v[j].w); }
        const float rstd = __builtin_amdgcn_rsqf(wave_sum(s) * (1.f / D) + 1e-6f);
        unsigned long long* o8 = (unsigned long long*)(dst + (size_t)m * D) + lane;
#pragma unroll
        for (int j = 0; j < 4; ++j) { const f32x4 gg = gr[64 * j];
            o8[64 * j] = (unsigned long long)pk2(v[j].x * rstd * gg.x, v[j].y * rstd * gg.y) | ((unsigned long long)pk2(v[j].z * rstd * gg.z, v[j].w * rstd * gg.w) << 32); }
    }
}

__device__ __forceinline__ void p0_prologue(const Args& a, LAS unsigned char* lds, int tid, int lane, int wave) {
    const CAS char* kp_ = kargs_ptr();
    LAS float* scr = (LAS float*)(lds + wave * 16384);
    const int G = gridDim.x, gw = blockIdx.x * NWAVES + wave, NGW = G * NWAVES, gt = blockIdx.x * NTHR + tid, NGT = G * NTHR;
    transpose_mat(KIN(I_WIN), D, ABIN, (bf16*)(KWS + WS_WIN), scr, gw, NGW, lane);
    { float* bp = (float*)(KWS + WS_BIASP); for (int i = gt; i < ABIN; i += NGT) bp[i] = i < 1024 ? KIN(I_CINB)[i] : 0.f; }
    rms_rows(KIN(I_X), KIN(I_ABG), (bf16*)(KWS + WS_XN1), gw, NGW, lane);
}

__device__ __forceinline__ void p2_prep(const Args& a, LAS unsigned char* lds, int tid, int lane, int wave) {
    const CAS char* kp_ = kargs_ptr();
    const bf16* PC = (const bf16*)(KWS + WS_PC); const bf16* PR = (const bf16*)((unsigned char*)KOUT + DO_PR);
    bf16* CAT = (bf16*)(KWS + WS_CAT); bf16* LIN = (bf16*)(KWS + WS_LIN);
    LAS float* ybuf = (LAS float*)lds;
    const int c = tid;
    float wv[31];
#pragma unroll
    for (int j = 0; j < 31; ++j) wv[j] = KIN(I_DWW)[j * 512 + c];
    const float bc = KIN(I_DWB)[c];
    for (int tile = blockIdx.x; tile < M / 32; tile += gridDim.x) {
        const int b = tile / (T / 32), tt0 = (tile % (T / 32)) * 32;
        float g[62];
        if (tt0 >= 30) {
            const bf16* rowp = PC + (size_t)(b * T + tt0 - 30) * 1024 + c;
#pragma unroll
            for (int i = 0; i < 62; ++i) { const float x1 = bf2f(rowp[i * 1024]), x2 = bf2f(rowp[i * 1024 + 512]); g[i] = x1 * sigm(x2); }
        } else {
            const bf16* rowp = PC + (size_t)(b * T) * 1024 + c;
#pragma unroll
            for (int i = 0; i < 30; ++i) g[i] = 0.f;
#pragma unroll
            for (int i = 30; i < 62; ++i) { const float x1 = bf2f(rowp[(i - 30) * 1024]), x2 = bf2f(rowp[(i - 30) * 1024 + 512]); g[i] = x1 * sigm(x2); }
        }
#pragma unroll
        for (int tt = 0; tt < 32; ++tt) { float y = bc;
#pragma unroll
            for (int j = 0; j < 31; ++j) y += wv[j] * g[tt + j];
            ybuf[tt * 512 + c] = y; }
        __syncthreads();
#pragma unroll
        for (int q = 0; q < 4; ++q) { const int tt = wave * 4 + q; const LAS f32x4* yr = (const LAS f32x4*)(ybuf + tt * 512 + lane * 8);
            const f32x4 y0 = yr[0], y1 = yr[1];
            const float mean = wave_sum((y0.x + y0.y) + (y0.z + y0.w) + (y1.x + y1.y) + (y1.z + y1.w)) * (1.f / 512.f);
            const f32x4 d0 = y0 - mean, d1 = y1 - mean;
            const float var = wave_sum((d0.x * d0.x + d0.y * d0.y) + (d0.z * d0.z + d0.w * d0.w) + (d1.x * d1.x + d1.y * d1.y) + (d1.z * d1.z + d1.w * d1.w)) * (1.f / 512.f);
            const float rstd = __builtin_amdgcn_rsqf(var + 1e-5f);
            const f32x4 g0 = *(const f32x4*)(KIN(I_CLNG) + lane * 8), g1 = *(const f32x4*)(KIN(I_CLNG) + lane * 8 + 4);
            const f32x4 b0 = *(const f32x4*)(KIN(I_CLNB) + lane * 8), b1 = *(const f32x4*)(KIN(I_CLNB) + lane * 8 + 4);
            f32x4 o0 = d0 * rstd * g0 + b0, o1 = d1 * rstd * g1 + b1;
            o0.x *= sigm(o0.x); o0.y *= sigm(o0.y); o0.z *= sigm(o0.z); o0.w *= sigm(o0.w); o1.x *= sigm(o1.x); o1.y *= sigm(o1.y); o1.z *= sigm(o1.z); o1.w *= sigm(o1.w);
            v4u w; w.x = pk2(o0.x, o0.y); w.y = pk2(o0.z, o0.w); w.z = pk2(o1.x, o1.y); w.w = pk2(o1.z, o1.w);
            *(v4u*)(CAT + (size_t)(b * T + tt0 + tt) * 1024 + lane * 8) = w; }
        __syncthreads();
    }
    const int gt = blockIdx.x * NTHR + tid, NGT = gridDim.x * NTHR;
    for (int w = gt; w < (M / 32) * LINW; w += NGT) { const int j = w & 255, m_start = (w >> 8) * 32;
        const bf16* p = PR + (size_t)m_start * PRW + 1536 + j; bf16* o = LIN + (size_t)m_start * LINW + j;
        const float mu = KIN(I_MU)[1536 + j];
        float prev = (m_start & (T - 1)) != 0 ? bf2f(p[-PRW]) : 0.f;
#pragma unroll 8
        for (int i = 0; i < 32; ++i) { const float p1 = bf2f(p[i * PRW]); const float xs = p1 + (prev - p1) * mu; prev = p1;
            const float v = j < 64 ? tanh_fast(xs) : (j < 128 ? xs : sigm(xs));
            o[i * LINW] = (bf16)f2bf(v); }
    }
}

constexpr int SLABB = 2048, RUNL = 64;
constexpr size_t WS_WLC = 256 * 1024;
struct SlabRegs { v4u p1, p2; };
__device__ __forceinline__ void slab_load(SlabRegs& r, const unsigned char* slab, int lane) {
    r.p1 = *(const v4u*)(slab + lane * 16); r.p2 = *(const v4u*)(slab + 1024 + lane * 16);
}
__device__ __forceinline__ void slab_piece(const v4u q, LAS float* dst, int p) {
    LAS float* d = dst + (p >> 5) * 256 + ((p >> 3) & 3) * 64 + (p & 7) * 8;
    *(LAS f32x4*)d = (f32x4){bflo(q.x), bfhi(q.x), bflo(q.y), bfhi(q.y)}; *(LAS f32x4*)(d + 4) = (f32x4){bflo(q.z), bfhi(q.z), bflo(q.w), bfhi(q.w)};
}
__device__ __forceinline__ void slab_store(const SlabRegs& r, LAS float* dst, int lane) { slab_piece(r.p1, dst, lane); slab_piece(r.p2, dst, lane + 64); }
__device__ __forceinline__ void p4_rwkv_prep(const Args& a, int lane, int wave) {
    const CAS char* kp_ = kargs_ptr();
    const bf16* PR = (const bf16*)((unsigned char*)KOUT + DO_PR); const bf16* LOWp = (const bf16*)(KWS + WS_LOW); const bf16* LOAp = (const bf16*)(KWS + WS_LOA);
    unsigned char* SEQ = KWS + WS_SEQ; float* BON = (float*)(KWS + WS_BON); float* WLC = (float*)(KWS + WS_WLC);
    const int gw = blockIdx.x * NWAVES + wave, NGW = gridDim.x * NWAVES;
    constexpr int RUN = 64, U = 4;
    for (int run = gw; run < (M / RUN) * NH; run += NGW) { const int h = run & 7, mbase = (run >> 3) * RUN, c = h * 64 + lane, b = mbase / T;
        const float mur = KIN(I_MU)[c], muk = KIN(I_MU)[512 + c], w0 = KIN(I_W0)[c], a0 = KIN(I_A0)[c], kkc = KIN(I_KK)[c], kac = KIN(I_KA)[c], rkc = KIN(I_RK)[c];
        float rp = 0.f, kp_ = 0.f, Wc = 1.f;
        if ((mbase & (T - 1)) != 0) { rp = bf2f(PR[(size_t)(mbase - 1) * PRW + c]); kp_ = bf2f(PR[(size_t)(mbase - 1) * PRW + 512 + c]); }
        for (int i0 = 0; i0 < RUN; i0 += U) {
            float r1[U], k1[U], lw[U], la[U];
#pragma unroll
            for (int u = 0; u < U; ++u) { const size_t m = (size_t)(mbase + i0 + u); r1[u] = bf2f(PR[m * PRW + c]); k1[u] = bf2f(PR[m * PRW + 512 + c]); lw[u] = bf2f(LOWp[m * 512 + c]); la[u] = bf2f(LOAp[m * 512 + c]); }
            float kkr[U], kpv[U], rr[U], dec[U], agv[U], n2[U], bn[U];
#pragma unroll
            for (int u = 0; u < U; ++u) {
                const float r = r1[u] + (rp - r1[u]) * mur, k = k1[u] + (kp_ - k1[u]) * muk; rp = r1[u]; kp_ = k1[u];
                const float z = -(w0 + lw[u]);
                const float sp = fmaxf(z, 0.f) + __logf(1.f + __expf(-fabsf(z)));
                dec[u] = __expf(-__expf(-sp - 0.5f));
                const float ag = sigm(a0 + la[u]); agv[u] = ag;
                kkr[u] = k * kkc; n2[u] = kkr[u] * kkr[u];
                kpv[u] = k * (1.f + (ag - 1.f) * kac); rr[u] = r; bn[u] = r * kpv[u] * rkc; }
#define P4_STEP(O) _Pragma("unroll") for (int u = 0; u < U; ++u) { n2[u] = xstep<O>(n2[u]); bn[u] = xstep<O>(bn[u]); }
            P4_STEP(1) P4_STEP(2) P4_STEP(4) P4_STEP(8) P4_STEP(16) P4_STEP(32)
#undef P4_STEP
#pragma unroll
            for (int u = 0; u < U; ++u) { const int m = mbase + i0 + u, t = m & (T - 1);
                const float kk = kkr[u] * __builtin_amdgcn_rsqf(fmaxf(n2[u], 1e-24f));
                unsigned char* sl_ = SEQ + ((size_t)(b * NH + h) * (T / 4) + (t >> 2)) * SLABB; const int st_ = t & 3;
                const float ap = -kk * Wc; Wc *= dec[u]; const float iW = __builtin_amdgcn_rcpf(Wc);
                bf16* hb = (bf16*)(sl_ + st_ * 512) + lane;
                hb[0] = (bf16)f2bf(ap); hb[64] = (bf16)f2bf(kk * agv[u] * iW); hb[128] = (bf16)f2bf(kpv[u] * iW); hb[192] = (bf16)f2bf(rr[u] * Wc);
                if (lane == 0) BON[(size_t)m * NH + h] = bn[u]; }
        }
        WLC[((size_t)(b * NH + h) * (T / RUNL) + (mbase & (T - 1)) / RUNL) * 64 + lane] = Wc;
    }
}

__device__ __forceinline__ int crow(int r, int hi) { return (r & 3) + 8 * (r >> 2) + 4 * hi; }
constexpr int SLAB = 4, SLABF = SLAB * 256;
constexpr int NCH = 64, CL = T / NCH;
template <int MODE>
__device__ __forceinline__ void scan_task(const Args& a, LAS float* wl, int lane, int chain, int ck) {
    const CAS char* kp_ = kargs_ptr();
    const bf16* PR = (const bf16*)((unsigned char*)KOUT + DO_PR); const bf16* LOGp = (const bf16*)(KWS + WS_LOG);
    const unsigned char* SEQ = KWS + WS_SEQ; const float* BON = (const float*)(KWS + WS_BON); bf16* CAT = (bf16*)(KWS + WS_CAT);
    float* ST = (float*)(KWS + WS_ST);
    const int b = chain >> 3, h = chain & 7, c = h * 64 + lane, t0 = ck * CL;
    const float muv = KIN(I_MU)[1024 + c];
    float lng = 0.f, lnb = 0.f;
    if constexpr (MODE == 2) { lng = KIN(I_RLNG)[c]; lnb = KIN(I_RLNB)[c]; }
    f32x2 S[32];
#pragma unroll
    for (int j = 0; j < 32; ++j) S[j] = (f32x2){0.f, 0.f};
    if constexpr (MODE == 3) {
#pragma unroll
        for (int j = 0; j < 32; ++j) S[j] = (f32x2){lane == 2 * j ? 1.f : 0.f, lane == 2 * j + 1 ? 1.f : 0.f};
    }
    if constexpr (MODE == 2) {
        if (ck > 0) { const f32x4* sp = (const f32x4*)(ST + ((size_t)(chain * NCH + ck - 1) * 2) * 4096 + lane * 64);
#pragma unroll
            for (int j = 0; j < 16; ++j) { const f32x4 q = sp[j]; S[2 * j] = q.xy; S[2 * j + 1] = q.zw; } }
    }
    const unsigned char* sq = SEQ + ((size_t)chain * (T / SLAB) + t0 / SLAB) * SLABB;
    const size_t m0 = (size_t)b * T + t0;
    float pprev = 0.f;
    if constexpr (MODE != 3) pprev = t0 > 0 ? bf2f(PR[(m0 - 1) * PRW + 1024 + c]) : 0.f;
    SlabRegs pre; unsigned pvn[SLAB], gtn[SLAB]; float bnn[SLAB];
    slab_load(pre, sq, lane);
#pragma unroll
    for (int s = 0; s < SLAB; ++s) { const size_t m = m0 + s; if constexpr (MODE != 3) pvn[s] = PR[m * PRW + 1024 + c]; if constexpr (MODE == 2) { gtn[s] = LOGp[m * 512 + c]; bnn[s] = BON[m * NH + h]; } }
    slab_store(pre, wl, lane);
    for (int sl = 0; sl < CL / SLAB; ++sl) {
        const int buf = sl & 1; const LAS float* ob = wl + buf * SLABF;
        if (sl == RUNL / SLAB) {
            const f32x4* wq = (const f32x4*)((const float*)(KWS + WS_WLC) + ((size_t)chain * (T / RUNL) + t0 / RUNL) * 64);
#pragma unroll
            for (int j = 0; j < 16; ++j) { const f32x4 q = wq[j]; S[2 * j] *= q.xy; S[2 * j + 1] *= q.zw; } }
        unsigned pvc[SLAB], gtc[SLAB]; float bnc[SLAB];
#pragma unroll
        for (int s = 0; s < SLAB; ++s) { if constexpr (MODE != 3) pvc[s] = pvn[s]; if constexpr (MODE == 2) { gtc[s] = gtn[s]; bnc[s] = bnn[s]; } }
        const int sn = (sl + 1 < CL / SLAB) ? sl + 1 : sl;
        slab_load(pre, sq + (size_t)sn * SLABB, lane);
#pragma unroll
        for (int s = 0; s < SLAB; ++s) { const size_t m = m0 + (size_t)sn * SLAB + s; if constexpr (MODE != 3) pvn[s] = PR[m * PRW + 1024 + c]; if constexpr (MODE == 2) { gtn[s] = LOGp[m * 512 + c]; bnn[s] = BON[m * NH + h]; } }
        __builtin_amdgcn_sched_barrier(0);
        float ys[SLAB], vs[SLAB];
        constexpr int NIT = 20, NQ = (MODE == 2 ? 3 : (MODE == 1 ? 2 : 1));
        f32x4 ring[8][4];
        const LAS f32x4* o4b = (const LAS f32x4*)ob;
#define SCAN_LD(it_) do { const int st_ = (it_) / NIT, lc_ = (it_) % NIT; const LAS f32x4* o4_ = o4b + st_ * 64; \
            if (lc_ < 4) { _Pragma("unroll") for (int q_ = 0; q_ < 4; ++q_) ring[(it_) & 7][q_] = o4_[4 * lc_ + q_]; } \
            else { _Pragma("unroll") for (int q_ = 0; q_ < NQ; ++q_) ring[(it_) & 7][q_] = o4_[16 * (q_ + 1) + (lc_ - 4)]; } } while (0)
        SCAN_LD(0); SCAN_LD(1); SCAN_LD(2); SCAN_LD(3); SCAN_LD(4); SCAN_LD(5);
        f32x2 sa0 = {0.f, 0.f}, sa1 = {0.f, 0.f}, y0 = {0.f, 0.f}, y1 = {0.f, 0.f}, sav = {0.f, 0.f}, vv = {0.f, 0.f};
#pragma unroll
        for (int it = 0; it < SLAB * NIT; ++it) {
            const int st = it / NIT, lc = it % NIT;
            if (it + 6 < SLAB * NIT) SCAN_LD(it + 6);
            if (lc == 0) { float v = 0.f;
                if constexpr (MODE != 3) { const float pv = bf2f(pvc[st]); v = pv + (pprev - pv) * muv; pprev = pv; }
                vs[st] = v; vv = (f32x2){v, v}; sa0 = (f32x2){0.f, 0.f}; sa1 = (f32x2){0.f, 0.f}; y0 = (f32x2){0.f, 0.f}; y1 = (f32x2){0.f, 0.f}; }
            if (lc < 4) {
#pragma unroll
                for (int q = 0; q < 4; ++q) { const f32x4 a4 = ring[it & 7][q]; sa0 += S[8 * lc + 2 * q] * a4.xy; sa1 += S[8 * lc + 2 * q + 1] * a4.zw; }
                if (lc == 3) { const float sa = (sa0.x + sa0.y) + (sa1.x + sa1.y); sav = (f32x2){sa, sa}; }
            } else { const int j = lc - 4; const f32x4 b4 = ring[it & 7][0];
                f32x2 n0 = S[2 * j] + sav * b4.xy, n1 = S[2 * j + 1] + sav * b4.zw;
                if constexpr (MODE != 3) { const f32x4 k4 = ring[it & 7][1]; n0 += vv * k4.xy; n1 += vv * k4.zw; }
                S[2 * j] = n0; S[2 * j + 1] = n1;
                if constexpr (MODE == 2) { const f32x4 r4 = ring[it & 7][2]; y0 += n0 * r4.xy; y1 += n1 * r4.zw; if (lc == NIT - 1) ys[st] = (y0.x + y0.y) + (y1.x + y1.y); }
            }
            __builtin_amdgcn_sched_barrier(0);
        }
#undef SCAN_LD
        if constexpr (MODE == 2) {
            float mu4[SLAB], d4[SLAB], q4[SLAB];
#pragma unroll
            for (int s = 0; s < SLAB; ++s) mu4[s] = ys[s];
#define GN_STEP(A_, O) _Pragma("unroll") for (int s = 0; s < SLAB; ++s) A_[s] = xstep<O>(A_[s]);
            GN_STEP(mu4, 1) GN_STEP(mu4, 2) GN_STEP(mu4, 4) GN_STEP(mu4, 8) GN_STEP(mu4, 16) GN_STEP(mu4, 32)
#pragma unroll
            for (int s = 0; s < SLAB; ++s) { d4[s] = ys[s] - mu4[s] * (1.f / 64.f); q4[s] = d4[s] * d4[s]; }
            GN_STEP(q4, 1) GN_STEP(q4, 2) GN_STEP(q4, 4) GN_STEP(q4, 8) GN_STEP(q4, 16) GN_STEP(q4, 32)
#undef GN_STEP
#pragma unroll
            for (int s = 0; s < SLAB; ++s) { float yn = d4[s] * __builtin_amdgcn_rsqf(q4[s] * (1.f / 64.f) + 64e-5f) * lng + lnb;
                yn += bnc[s] * vs[s]; yn *= bf2f(gtc[s]);
                CAT[(m0 + (size_t)sl * SLAB + s) * 1024 + 512 + c] = (bf16)f2bf(yn); }
        }
        slab_store(pre, wl + (buf ^ 1) * SLABF, lane);
    }
    if constexpr (MODE != 2) {
        f32x4* dm = (f32x4*)(ST + ((size_t)(chain * NCH + ck) * 2 + (MODE == 1 ? 1 : 0)) * 4096 + lane * 64);
#pragma unroll
        for (int j = 0; j < 16; ++j) { f32x4 q; q.xy = S[2 * j]; q.zw = S[2 * j + 1]; dm[j] = q; }
    }
}
__device__ __forceinline__ void scan_task_p1(const Args& a, LAS float* wl, int lane, int chain, int ck, int rh) {
    const CAS char* kp_ = kargs_ptr();
    const bf16* PR = (const bf16*)((unsigned char*)KOUT + DO_PR); const unsigned char* SEQ = KWS + WS_SEQ; float* ST = (float*)(KWS + WS_ST);
    const int b = chain >> 3, h = chain & 7, r32 = lane >> 1, kh = lane & 1, row = 32 * rh + r32, c = h * 64 + row, t0 = ck * CL;
    const float muv = KIN(I_MU)[1024 + c];
    f32x2 Sn[16], Sm[16];
#pragma unroll
    for (int j = 0; j < 16; ++j) { Sn[j] = (f32x2){0.f, 0.f}; Sm[j] = (f32x2){row == 32 * kh + 2 * j ? 1.f : 0.f, row == 32 * kh + 2 * j + 1 ? 1.f : 0.f}; }
    const unsigned char* sq = SEQ + ((size_t)chain * (T / SLAB) + t0 / SLAB) * SLABB;
    const size_t m0 = (size_t)b * T + t0;
    float pprev = t0 > 0 ? bf2f(PR[(m0 - 1) * PRW + 1024 + c]) : 0.f;
    SlabRegs pre; unsigned pvn[SLAB];
    slab_load(pre, sq, lane);
#pragma unroll
    for (int s = 0; s < SLAB; ++s) pvn[s] = PR[(m0 + s) * PRW + 1024 + c];
    slab_store(pre, wl, lane);
    for (int sl = 0; sl < CL / SLAB; ++sl) {
        const int buf = sl & 1; const LAS float* ob = wl + buf * SLABF;
        if (sl == RUNL / SLAB) {
            const f32x4* wq = (const f32x4*)((const float*)(KWS + WS_WLC) + ((size_t)chain * (T / RUNL) + t0 / RUNL) * 64 + 32 * kh);
#pragma unroll
            for (int j = 0; j < 8; ++j) { const f32x4 q = wq[j]; Sn[2 * j] *= q.xy; Sn[2 * j + 1] *= q.zw; Sm[2 * j] *= q.xy; Sm[2 * j + 1] *= q.zw; } }
        unsigned pvc[SLAB];
#pragma unroll
        for (int s = 0; s < SLAB; ++s) pvc[s] = pvn[s];
        const int sn = (sl + 1 < CL / SLAB) ? sl + 1 : sl;
        slab_load(pre, sq + (size_t)sn * SLABB, lane);
#pragma unroll
        for (int s = 0; s < SLAB; ++s) pvn[s] = PR[(m0 + (size_t)sn * SLAB + s) * PRW + 1024 + c];
        __builtin_amdgcn_sched_barrier(0);
        constexpr int NIT = 10;
        f32x4 ring[4][4];
        const LAS f32x4* o4b = (const LAS f32x4*)ob + 8 * kh;
#define P1_LD(it_) do { const int st_ = (it_) / NIT, lc_ = (it_) % NIT; const LAS f32x4* o4_ = o4b + st_ * 64; \
            if (lc_ < 2) { _Pragma("unroll") for (int q_ = 0; q_ < 4; ++q_) ring[(it_) & 3][q_] = o4_[4 * lc_ + q_]; } \
            else { _Pragma("unroll") for (int q_ = 0; q_ < 2; ++q_) ring[(it_) & 3][q_] = o4_[16 * (q_ + 1) + (lc_ - 2)]; } } while (0)
        P1_LD(0); P1_LD(1); P1_LD(2);
        f32x2 an0 = {0.f, 0.f}, an1 = {0.f, 0.f}, am0 = {0.f, 0.f}, am1 = {0.f, 0.f}, sanv = {0.f, 0.f}, samv = {0.f, 0.f}, vv = {0.f, 0.f};
#pragma unroll
        for (int it = 0; it < SLAB * NIT; ++it) {
            const int st = it / NIT, lc = it % NIT;
            if (it + 3 < SLAB * NIT) P1_LD(it + 3);
            if (lc == 0) { const float pv = bf2f(pvc[st]); const float v = pv + (pprev - pv) * muv; pprev = pv; vv = (f32x2){v, v};
                an0 = (f32x2){0.f, 0.f}; an1 = (f32x2){0.f, 0.f}; am0 = (f32x2){0.f, 0.f}; am1 = (f32x2){0.f, 0.f}; }
            if (lc < 2) {
#pragma unroll
                for (int q = 0; q < 4; ++q) { const f32x4 a4 = ring[it & 3][q];
                    an0 += Sn[8 * lc + 2 * q] * a4.xy; an1 += Sn[8 * lc + 2 * q + 1] * a4.zw; am0 += Sm[8 * lc + 2 * q] * a4.xy; am1 += Sm[8 * lc + 2 * q + 1] * a4.zw; }
                if (lc == 1) { float san = (an0.x + an0.y) + (an1.x + an1.y), sam = (am0.x + am0.y) + (am1.x + am1.y);
                    san = xstep<1>(san); sam = xstep<1>(sam); sanv = (f32x2){san, san}; samv = (f32x2){sam, sam}; }
            } else { const int j = lc - 2; const f32x4 b4 = ring[it & 3][0], k4 = ring[it & 3][1];
                Sn[2 * j] = Sn[2 * j] + sanv * b4.xy + vv * k4.xy; Sn[2 * j + 1] = Sn[2 * j + 1] + sanv * b4.zw + vv * k4.zw;
                Sm[2 * j] = Sm[2 * j] + samv * b4.xy;              Sm[2 * j + 1] = Sm[2 * j + 1] + samv * b4.zw;
            }
            __builtin_amdgcn_sched_barrier(0);
        }
#undef P1_LD
        slab_store(pre, wl + (buf ^ 1) * SLABF, lane);
    }
    f32x4* dm = (f32x4*)(ST + ((size_t)(chain * NCH + ck) * 2) * 4096 + row * 64 + 32 * kh); f32x4* dn = dm + 1024;
    const f32x4* wq = (const f32x4*)((const float*)(KWS + WS_WLC) + ((size_t)chain * (T / RUNL) + t0 / RUNL + 1) * 64 + 32 * kh);
#pragma unroll
    for (int j = 0; j < 8; ++j) { const f32x4 w4 = wq[j]; f32x4 q; q.xy = Sm[2 * j] * w4.xy; q.zw = Sm[2 * j + 1] * w4.zw; dm[j] = q; f32x4 p; p.xy = Sn[2 * j] * w4.xy; p.zw = Sn[2 * j + 1] * w4.zw; dn[j] = p; }
}
__device__ __forceinline__ void scan_pass1(const Args& a, LAS unsigned char* lds, int lane, int wave) {
    LAS float* wl = (LAS float*)(lds + wave * (2 * SLABF * 4));
    const int ntask = 2 * BATCH * NH * (NCH - 1);
    for (int wk = wave * gridDim.x + blockIdx.x; wk < ntask; wk += NWAVES * gridDim.x) {
        const int rh = wk & 1, chain = (wk >> 1) & 15, ck = wk >> 5;
        scan_task_p1(a, wl, lane, chain, ck, rh);
    }
}
__device__ __forceinline__ void scan_pass2(const Args& a, LAS unsigned char* lds, int lane, int wave) {
    LAS float* wl = (LAS float*)(lds + wave * (2 * SLABF * 4));
    for (int wk = wave * gridDim.x + blockIdx.x; wk < BATCH * NH * NCH; wk += NWAVES * gridDim.x) scan_task<2>(a, wl, lane, wk & 15, wk >> 4);
}
constexpr int GS = 8, NG = NCH / GS;
__device__ __forceinline__ f32x16 mm_acc(const LAS float* X, const LAS float* Mm, f32x16 acc, int ti, int tn, int kh, int l31, int hi) {
    const LAS float* sb = X + (32 * ti + l31) * 65 + 32 * kh + hi;
    const LAS float* mb = Mm + (32 * kh + hi) * 64 + 32 * tn + l31;
#pragma unroll
    for (int kk = 0; kk < 16; ++kk) acc = __builtin_amdgcn_mfma_f32_32x32x2f32(sb[2 * kk], mb[2 * kk * 64], acc, 0, 0, 0);
    return acc;
}
__device__ __forceinline__ void comb_a(const Args& a, LAS unsigned char* lds, int tid, int lane, int wave) {
    const CAS char* kp_ = kargs_ptr();
    if (blockIdx.x >= BATCH * NH * NG) return;
    const int chain = blockIdx.x & 15, g = blockIdx.x >> 4, c0 = g * GS;
    float* ST = (float*)(KWS + WS_ST);
    LAS float* XM = (LAS float*)lds;
    LAS float* XN = XM + 2 * 4160;
    LAS float* Mb = XN + 2 * 4160;
    LAS float* Nb = Mb + 4096;
    LAS float* Pb = Nb + 4096;
    const int l31 = lane & 31, hi = lane >> 5, tile = wave & 3, ti = tile >> 1, tn = tile & 1, kh = wave >> 2;
    const int jmax = (c0 + GS - 1 <= NCH - 2) ? GS - 1 : NCH - 2 - c0;
    f32x4 rq[4];
    { const f32x4* gm = (const f32x4*)(ST + ((size_t)(chain * NCH + c0) * 2) * 4096);
#pragma unroll
      for (int e = 0; e < 2; ++e) { const int idx = tid + 512 * e; const f32x4 m = gm[idx], n = gm[1024 + idx]; const int r = idx >> 4, cc = (idx & 15) * 4;
#pragma unroll
          for (int q = 0; q < 4; ++q) { XM[r * 65 + cc + q] = m[q]; XN[r * 65 + cc + q] = n[q]; } }
      const f32x4* g1 = gm + 2048;
      rq[0] = g1[tid]; rq[1] = g1[tid + 512]; rq[2] = g1[1024 + tid]; rq[3] = g1[1024 + tid + 512]; }
    int cur = 0;
    for (int j = 1; j <= jmax; ++j) {
#pragma unroll
        for (int e = 0; e < 2; ++e) { const int idx = tid + 512 * e; *(LAS f32x4*)(Mb + idx * 4) = rq[e]; *(LAS f32x4*)(Nb + idx * 4) = rq[2 + e]; }
        { const int cn = (j + 1 <= jmax) ? c0 + j + 1 : c0 + j; const f32x4* gm = (const f32x4*)(ST + ((size_t)(chain * NCH + cn) * 2) * 4096);
          rq[0] = gm[tid]; rq[1] = gm[tid + 512]; rq[2] = gm[1024 + tid]; rq[3] = gm[1024 + tid + 512]; }
        __syncthreads();
        f32x16 am, an;
#pragma unroll
        for (int r = 0; r < 16; ++r) { am[r] = 0.f; an[r] = kh == 0 ? Nb[(32 * ti + crow(r, hi)) * 64 + 32 * tn + l31] : 0.f; }
        am = mm_acc(XM + cur * 4160, Mb, am, ti, tn, kh, l31, hi);
        an = mm_acc(XN + cur * 4160, Mb, an, ti, tn, kh, l31, hi);
        if (kh == 1) {
#pragma unroll
            for (int r = 0; r < 16; ++r) { Pb[(tile * 16 + r) * 64 + lane] = am[r]; Pb[4096 + (tile * 16 + r) * 64 + lane] = an[r]; }
        }
        __syncthreads();
        if (kh == 0) {
            float* gs = ST + ((size_t)(chain * NCH + c0 + j) * 2) * 4096;
#pragma unroll
            for (int r = 0; r < 16; ++r) { const float vm = am[r] + Pb[(tile * 16 + r) * 64 + lane], vn = an[r] + Pb[4096 + (tile * 16 + r) * 64 + lane]; const int row = 32 * ti + crow(r, hi), col = 32 * tn + l31;
                XM[(cur ^ 1) * 4160 + row * 65 + col] = vm; XN[(cur ^ 1) * 4160 + row * 65 + col] = vn; gs[row * 64 + col] = vm; gs[4096 + row * 64 + col] = vn; }
        }
        cur ^= 1;
    }
}
__device__ __forceinline__ void comb_b(const Args& a, LAS unsigned char* lds, int tid, int lane, int wave) {
    const CAS char* kp_ = kargs_ptr();
    if (blockIdx.x >= BATCH * NH) return;
    const int chain = blockIdx.x;
    float* ST = (float*)(KWS + WS_ST);
    LAS float* Sb = (LAS float*)lds;
    LAS float* Mb = Sb + 2 * 4160;
    LAS float* Nb = Mb + 4096;
    LAS float* Pb = Nb + 4096;
    const int l31 = lane & 31, hi = lane >> 5, tile = wave & 3, ti = tile >> 1, tn = tile & 1, kh = wave >> 2;
    for (int i = tid; i < 2 * 4160; i += NTHR) Sb[i] = 0.f;
    f32x4 rq[4];
    { const f32x4* gm = (const f32x4*)(ST + ((size_t)(chain * NCH + GS - 1) * 2) * 4096); rq[0] = gm[tid]; rq[1] = gm[tid + 512]; rq[2] = gm[1024 + tid]; rq[3] = gm[1024 + tid + 512]; }
    int cur = 0;
    for (int g = 0; g < NG - 1; ++g) {
        const int c = g * GS + GS - 1;
#pragma unroll
        for (int e = 0; e < 2; ++e) { const int idx = tid + 512 * e; *(LAS f32x4*)(Mb + idx * 4) = rq[e]; *(LAS f32x4*)(Nb + idx * 4) = rq[2 + e]; }
        { const int cn = (g + 1 < NG - 1) ? c + GS : c; const f32x4* gm = (const f32x4*)(ST + ((size_t)(chain * NCH + cn) * 2) * 4096);
          rq[0] = gm[tid]; rq[1] = gm[tid + 512]; rq[2] = gm[1024 + tid]; rq[3] = gm[1024 + tid + 512]; }
        __syncthreads();
        f32x16 acc;
#pragma unroll
        for (int r = 0; r < 16; ++r) acc[r] = kh == 0 ? Nb[(32 * ti + crow(r, hi)) * 64 + 32 * tn + l31] : 0.f;
        acc = mm_acc(Sb + cur * 4160, Mb, acc, ti, tn, kh, l31, hi);
        if (kh == 1) {
#pragma unroll
            for (int r = 0; r < 16; ++r) Pb[(tile * 16 + r) * 64 + lane] = acc[r];
        }
        __syncthreads();
        if (kh == 0) {
            float* gs = ST + ((size_t)(chain * NCH + c) * 2) * 4096;
#pragma unroll
            for (int r = 0; r < 16; ++r) { const float v = acc[r] + Pb[(tile * 16 + r) * 64 + lane]; const int row = 32 * ti + crow(r, hi), col = 32 * tn + l31;
                Sb[(cur ^ 1) * 4160 + row * 65 + col] = v; gs[row * 64 + col] = v; }
        }
        cur ^= 1;
    }
}
__device__ __forceinline__ void comb_c(const Args& a, LAS unsigned char* lds, int tid, int lane, int wave) {
    const CAS char* kp_ = kargs_ptr();
    float* ST = (float*)(KWS + WS_ST);
    LAS float* Sb = (LAS float*)lds;
    LAS float* Mb = Sb + 4160;
    LAS float* Nb = Mb + 4096;
    LAS float* Pb = Nb + 4096;
    const int l31 = lane & 31, hi = lane >> 5, tile = wave & 3, ti = tile >> 1, tn = tile & 1, kh = wave >> 2;
    for (int task = blockIdx.x; task < BATCH * NH * NG * (GS - 1); task += gridDim.x) {
        const int chain = task & 15, g = (task >> 4) & (NG - 1), j = task >> 7, c = g * GS + j;
        { const f32x4* gm = (const f32x4*)(ST + ((size_t)(chain * NCH + c) * 2) * 4096);
          const f32x4* gx = (const f32x4*)(ST + ((size_t)(chain * NCH + (g > 0 ? (g * GS - 1) : 0)) * 2) * 4096);
#pragma unroll
          for (int e = 0; e < 2; ++e) { const int idx = tid + 512 * e; *(LAS f32x4*)(Mb + idx * 4) = gm[idx]; *(LAS f32x4*)(Nb + idx * 4) = gm[1024 + idx];
              const f32x4 x = g > 0 ? gx[idx] : (f32x4){0.f, 0.f, 0.f, 0.f}; const int r = idx >> 4, cc = (idx & 15) * 4;
#pragma unroll
              for (int q = 0; q < 4; ++q) Sb[r * 65 + cc + q] = x[q]; } }
        __syncthreads();
        f32x16 acc;
#pragma unroll
        for (int r = 0; r < 16; ++r) acc[r] = kh == 0 ? Nb[(32 * ti + crow(r, hi)) * 64 + 32 * tn + l31] : 0.f;
        acc = mm_acc(Sb, Mb, acc, ti, tn, kh, l31, hi);
        if (kh == 1) {
#pragma unroll
            for (int r = 0; r < 16; ++r) Pb[(tile * 16 + r) * 64 + lane] = acc[r];
        }
        __syncthreads();
        if (kh == 0) {
            float* gs = ST + ((size_t)(chain * NCH + c) * 2) * 4096;
#pragma unroll
            for (int r = 0; r < 16; ++r) gs[(32 * ti + crow(r, hi)) * 64 + 32 * tn + l31] = acc[r] + Pb[(tile * 16 + r) * 64 + lane];
        }
        __syncthreads();
    }
}

__device__ __forceinline__ void glu_fixup(const Args& a, int layer, int tid) {
    const CAS char* kp_ = kargs_ptr();
    bf16* H = (bf16*)(KWS + WS_H); const float* HG = (const float*)(KWS + WS_HG); const float* HV = (const float*)(KWS + WS_HV); const float* TG = (const float*)(KWS + WS_TG);
    const float* cw = KIN(I_FCW) + (size_t)layer * 3 * DFF; const float* cb = KIN(I_FCB) + (size_t)layer * DFF;
    const int gt = blockIdx.x * NTHR + tid, NGT = gridDim.x * NTHR;
    for (int i = gt; i < (M / 64) * 2 * DFF; i += NGT) { const int c = i % DFF, bj = i / DFF, j = bj & 1, blk = bj >> 1;
        const bool first = (blk & (T / 64 - 1)) == 0;
        const float g2 = HG[(size_t)bj * DFF + c];
        const float t1 = first ? 0.f : TG[((size_t)(blk - 1) * 2 + 1) * DFF + c], t0 = first ? 0.f : TG[((size_t)(blk - 1) * 2) * DFF + c];
        const float g1 = j == 1 ? HG[((size_t)blk * 2) * DFF + c] : t1, g0 = j == 1 ? t1 : t0;
        const float x = cw[c] * g0 + cw[DFF + c] * g1 + cw[2 * DFF + c] * g2 + cb[c];
        H[(size_t)(blk * 64 + j) * DFF + c] = (bf16)f2bf(x * sigm(x) * HV[(size_t)bj * DFF + c]); }
}

constexpr int KS_PITCH = 144, VT_PITCH = 528, KS_BYTES = 256 * KS_PITCH;
__device__ __forceinline__ void p14_attn(const Args& a, LAS unsigned char* lds, int tid, int lane, int wave) {
    const CAS char* kp_ = kargs_ptr();
    const bf16* QKV = (const bf16*)(KWS + WS_QKV); bf16* O = (bf16*)(KWS + WS_O); const float* TAB = (const float*)(KWS + WS_ROPE);
    LAS unsigned char* Ks = lds; LAS unsigned char* Vt = lds + KS_BYTES;
    const int q = lane & 31, hi = lane >> 5;
    for (int u = blockIdx.x; u < BATCH * (T / 128) * 4; u += gridDim.x) {
        const int g = u & 3, qb = (u >> 2) & 63, b = u >> 8; const int tok0 = b * T + qb * 128;
        const int hq = g * 4 + (wave >> 1);
        v4u qcur[4];
        { const bf16* qp = QKV + (size_t)(tok0 + 64 * (wave & 1) + q) * QKVW + hq * 64 + 8 * hi;
#pragma unroll
          for (int ks = 0; ks < 4; ++ks) qcur[ks] = *(const v4u*)(qp + 16 * ks); }
        if (tid < 256) {
            const int kj = tid; const bool valid = (qb > 0) || (kj >= 128); const int token = tok0 - 128 + kj;
            float x[64];
            if (valid) { const v4u* src = (const v4u*)(QKV + (size_t)token * QKVW + 1024 + g * 64);
#pragma unroll
                for (int s = 0; s < 8; ++s) { const v4u w = src[s]; x[8 * s] = bflo(w.x); x[8 * s + 1] = bfhi(w.x); x[8 * s + 2] = bflo(w.y); x[8 * s + 3] = bfhi(w.y); x[8 * s + 4] = bflo(w.z); x[8 * s + 5] = bfhi(w.z); x[8 * s + 6] = bflo(w.w); x[8 * s + 7] = bfhi(w.w); }
                float ss = 0.f;
#pragma unroll
                for (int d = 0; d < 64; ++d) ss += x[d] * x[d];
                const float rstd = 1.0f / sqrtf(ss * (1.f / 64.f) + 1e-6f);
#pragma unroll
                for (int d = 0; d < 64; ++d) x[d] = x[d] * rstd * KIN(I_KNG)[d];
#pragma unroll
                for (int i = 0; i < 8; ++i) { const float cs = TAB[(size_t)token * 16 + i], sn = TAB[(size_t)token * 16 + 8 + i]; const float x1 = x[i], x2 = x[i + 8]; x[i] = x1 * cs - x2 * sn; x[i + 8] = x2 * cs + x1 * sn; }
            } else {
#pragma unroll
                for (int d = 0; d < 64; ++d) x[d] = 0.f;
            }
#pragma unroll
            for (int s = 0; s < 8; ++s) { v4u w; w.x = pk2(x[8 * s], x[8 * s + 1]); w.y = pk2(x[8 * s + 2], x[8 * s + 3]); w.z = pk2(x[8 * s + 4], x[8 * s + 5]); w.w = pk2(x[8 * s + 6], x[8 * s + 7]);
                *(LAS v4u*)(Ks + kj * KS_PITCH + s * 16) = w; }
        } else {
            const int tv = tid - 256;
#pragma unroll
            for (int rep = 0; rep < 4; ++rep) { const int item = tv + 256 * rep, kp = item >> 3, seg = item & 7; const int k0 = 2 * kp; const bool valid = (qb > 0) || (k0 >= 128);
                v4u w0 = {0, 0, 0, 0}, w1 = {0, 0, 0, 0};
                if (valid) { const size_t o = (size_t)(tok0 - 128 + k0) * QKVW + 1280 + g * 64 + seg * 8; w0 = *(const v4u*)(QKV + o); w1 = *(const v4u*)(QKV + o + QKVW); }
                const unsigned e0[4] = {w0.x, w0.y, w0.z, w0.w}, e1[4] = {w1.x, w1.y, w1.z, w1.w};
#pragma unroll
                for (int p = 0; p < 4; ++p) { const int d = seg * 8 + 2 * p;
                    *(LAS unsigned*)(Vt + d * VT_PITCH + k0 * 2) = (e0[p] & 0xffffu) | (e1[p] << 16);
                    *(LAS unsigned*)(Vt + (d + 1) * VT_PITCH + k0 * 2) = (e0[p] >> 16) | (e1[p] & 0xffff0000u); }
            }
        }
        __syncthreads();
        const float sink = KIN(I_SINK)[hq];
#pragma unroll 1
        for (int sb = 0; sb < 2; ++sb) {
            v4u qnext[4];
            { const bf16* qp = QKV + (size_t)(tok0 + 64 * (wave & 1) + 32 + q) * QKVW + hq * 64 + 8 * hi;
#pragma unroll
              for (int ks = 0; ks < 4; ++ks) qnext[ks] = *(const v4u*)(qp + 16 * ks); }
            const int qi0 = 64 * (wave & 1) + 32 * sb; const int token = tok0 + qi0 + q;
            float qv[4][8];
            { float ss = 0.f;
#pragma unroll
              for (int ks = 0; ks < 4; ++ks) { const v4u w = qcur[ks];
                  qv[ks][0] = bflo(w.x); qv[ks][1] = bfhi(w.x); qv[ks][2] = bflo(w.y); qv[ks][3] = bfhi(w.y); qv[ks][4] = bflo(w.z); qv[ks][5] = bfhi(w.z); qv[ks][6] = bflo(w.w); qv[ks][7] = bfhi(w.w);
#pragma unroll
                  for (int j = 0; j < 8; ++j) ss += qv[ks][j] * qv[ks][j]; }
              ss += __shfl_xor(ss, 32);
              const float rstd = 1.0f / sqrtf(ss * (1.f / 64.f) + 1e-6f);
#pragma unroll
              for (int ks = 0; ks < 4; ++ks)
#pragma unroll
                  for (int j = 0; j < 8; ++j) qv[ks][j] = qv[ks][j] * rstd * KIN(I_QNG)[16 * ks + 8 * hi + j];
#pragma unroll
              for (int j = 0; j < 8; ++j) { const float other = __shfl_xor(qv[0][j], 32); const float cs = TAB[(size_t)token * 16 + j], sn = TAB[(size_t)token * 16 + 8 + j];
                  qv[0][j] = hi == 0 ? qv[0][j] * cs - other * sn : qv[0][j] * cs + other * sn; }
            }
            bf16x8 qf[4];
#pragma unroll
            for (int ks = 0; ks < 4; ++ks) { v4u w; w.x = pk2(qv[ks][0] * 0.125f, qv[ks][1] * 0.125f); w.y = pk2(qv[ks][2] * 0.125f, qv[ks][3] * 0.125f); w.z = pk2(qv[ks][4] * 0.125f, qv[ks][5] * 0.125f); w.w = pk2(qv[ks][6] * 0.125f, qv[ks][7] * 0.125f);
                qf[ks] = __builtin_bit_cast(bf16x8, w); }
            const int kt0 = qi0 >> 5;
            f32x16 sc[5];
#pragma unroll
            for (int i = 0; i < 5; ++i) {
#pragma unroll
                for (int r = 0; r < 16; ++r) sc[i][r] = 0.f;
#pragma unroll
                for (int ks = 0; ks < 4; ++ks) { const bf16x8 kf = *(const LAS bf16x8*)(Ks + (32 * (kt0 + i) + q) * KS_PITCH + (16 * ks + 8 * hi) * 2);
                    sc[i] = __builtin_amdgcn_mfma_f32_32x32x16_bf16(kf, qf[ks], sc[i], 0, 0, 0); }
            }
            const int qi = qi0 + q; float mx = sink;
#pragma unroll
            for (int i = 0; i < 5; ++i)
#pragma unroll
                for (int r = 0; r < 16; ++r) { const int kj = 32 * (kt0 + i) + crow(r, hi); const int rel = qi + 128 - kj; const bool ok = (rel >= 0) && (rel < 128) && ((qb > 0) || (kj >= 128));
                    sc[i][r] = ok ? sc[i][r] : -INFINITY; mx = fmaxf(mx, sc[i][r]); }
            mx = fmaxf(mx, __shfl_xor(mx, 32));
            float sum = 0.f;
#pragma unroll
            for (int i = 0; i < 5; ++i)
#pragma unroll
                for (int r = 0; r < 16; ++r) { const float p = __expf(sc[i][r] - mx); sc[i][r] = p; sum += p; }
            sum += __shfl_xor(sum, 32);
            const float inv = 1.0f / (sum + __expf(sink - mx));
            f32x16 oa[2];
#pragma unroll
            for (int dt = 0; dt < 2; ++dt)
#pragma unroll
                for (int r = 0; r < 16; ++r) oa[dt][r] = 0.f;
#pragma unroll
            for (int i = 0; i < 5; ++i)
#pragma unroll
                for (int s2 = 0; s2 < 2; ++s2) { v4u pw; pw.x = pk2(sc[i][8 * s2], sc[i][8 * s2 + 1]); pw.y = pk2(sc[i][8 * s2 + 2], sc[i][8 * s2 + 3]); pw.z = pk2(sc[i][8 * s2 + 4], sc[i][8 * s2 + 5]); pw.w = pk2(sc[i][8 * s2 + 6], sc[i][8 * s2 + 7]);
                    const bf16x8 pb = __builtin_bit_cast(bf16x8, pw);
#pragma unroll
                    for (int dt = 0; dt < 2; ++dt) { const LAS unsigned char* vp = Vt + (q + 32 * dt) * VT_PITCH + (32 * (kt0 + i) + 16 * s2 + 4 * hi) * 2;
                        const v2u lo = *(const LAS v2u*)vp, hh = *(const LAS v2u*)(vp + 16); v4u vw; vw.x = lo.x; vw.y = lo.y; vw.z = hh.x; vw.w = hh.y;
                        oa[dt] = __builtin_amdgcn_mfma_f32_32x32x16_bf16(__builtin_bit_cast(bf16x8, vw), pb, oa[dt], 0, 0, 0); } }
            bf16* op = O + (size_t)token * 1024 + hq * 64 + 4 * hi;
#pragma unroll
            for (int dt = 0; dt < 2; ++dt)
#pragma unroll
                for (int rg = 0; rg < 4; ++rg) { v2u w; w.x = pk2(oa[dt][4 * rg] * inv, oa[dt][4 * rg + 1] * inv); w.y = pk2(oa[dt][4 * rg + 2] * inv, oa[dt][4 * rg + 3] * inv);
                    *(v2u*)(op + 32 * dt + 8 * rg) = w; }
#pragma unroll
            for (int ks = 0; ks < 4; ++ks) qcur[ks] = qnext[ks];
        }
        __syncthreads();
    }
}

__device__ __forceinline__ void p8_prep2(const Args& a, LAS unsigned char* lds, int lane, int wave, int vb, int nb) {
    const CAS char* kp_ = kargs_ptr();
    LAS float* scr = (LAS float*)(lds + wave * 16384);
    const int gw = vb * NWAVES + wave, NGW = nb * NWAVES;
    transpose_mat(KIN(I_WUP), D, UW, (bf16*)(KWS + WS_WUP0), scr, gw, NGW, lane, KIN(I_FNG), 1);
}
__device__ __forceinline__ void tail_g10(const Args& a, LAS unsigned char* lds, int lane, int wave, int vb, int nb) {
    const CAS char* kp_ = kargs_ptr();
    LAS float* scr = (LAS float*)(lds + wave * 16384);
    const int gw = vb * NWAVES + wave, NGW = nb * NWAVES;
    transpose_mat(KIN(I_WDN), DFF, D, (bf16*)(KWS + WS_WDN0), scr, gw, NGW, lane);
    transpose_mat(KIN(I_WQKV), D, QKVW, (bf16*)(KWS + WS_WQKV), scr, gw, NGW, lane, KIN(I_ATG));
    transpose_mat(KIN(I_WO), D, D, (bf16*)(KWS + WS_WO), scr, gw, NGW, lane);
}
__device__ __forceinline__ void tail_g14(const Args& a, LAS unsigned char* lds, int lane, int wave, int vb, int nb) {
    const CAS char* kp_ = kargs_ptr();
    LAS float* scr = (LAS float*)(lds + wave * 16384);
    const int gw = vb * NWAVES + wave, NGW = nb * NWAVES;
    transpose_mat(KIN(I_WUP) + (size_t)D * UW, D, UW, (bf16*)(KWS + WS_WUP1), scr, gw, NGW, lane, KIN(I_FNG) + D, 1);
    transpose_mat(KIN(I_WDN) + (size_t)DFF * D, DFF, D, (bf16*)(KWS + WS_WDN1), scr, gw, NGW, lane);
}
__device__ __forceinline__ void tail_g1(const Args& a, LAS unsigned char* lds, int tid, int lane, int wave, int vb, int nb) {
    const CAS char* kp_ = kargs_ptr();
    LAS float* scr = (LAS float*)(lds + wave * 16384);
    const int gw = vb * NWAVES + wave, NGW = nb * NWAVES, gt = vb * NTHR + tid, NGT = nb * NTHR;
    transpose_mat(KIN(I_WOUT), D, D, (bf16*)(KWS + WS_WOUT), scr, gw, NGW, lane);
    {
        bf16* WL = (bf16*)(KWS + WS_WL);
        for (int i = gt; i < LOW * LINW; i += NGT) { const int n = i >> 8, k = i & 255; float v = 0.f;
            if (n < 512) { if (k < 64) v = KIN(I_W2)[k * 512 + n]; }
            else if (n < 1024) { if (k >= 64 && k < 128) v = KIN(I_A2)[(k - 64) * 512 + (n - 512)]; }
            else { if (k >= 128) v = KIN(I_G2)[(k - 128) * 512 + (n - 1024)]; }
            WL[i] = (bf16)f2bf(v); }
    }
    { float* ssz = (float*)(KWS + WS_SS); for (int i = gt; i < 3 * M; i += NGT) ssz[i] = 0.f; }
    {
        float* tab = (float*)(KWS + WS_ROPE); const int* pos = (const int*)KIN(I_POS);
        for (int i = gt; i < M * 8; i += NGT) { const int m = i >> 3, f = i & 7;
            double inv;
            switch (f) { case 0: inv = 1.0; break; case 1: inv = 0.19392274474868576; break; case 2: inv = 0.03760603093086393; break; case 3: inv = 0.007292664737217109; break;
                         case 4: inv = 0.001414213562373095; break; case 5: inv = 0.0002742481756762073; break; case 6: inv = 5.318295896944988e-05; break; default: inv = 1.031338537721246e-05; break; }
            const double rev = (double)pos[m] * inv * 0.15915494309189535; const float fr = (float)(rev - __builtin_rint(rev));
            tab[m * 16 + f] = __builtin_amdgcn_cosf(fr); tab[m * 16 + 8 + f] = __builtin_amdgcn_sinf(fr); }
    }
}

#define XB_TMO      128
#define XB_XCNT(j)  (256  + 64 * (j))
#define XB_XSUB(j)  (1280 + 64 * (j))
#define XB_XGEN(j)  (2304 + 64 * (j))
#define XB_TOP      3328
#define XB_TOPGEN   3392
#define XCD_BAR_WORDS 3456
#define XB_SPIN_CAP (1u << 18)

__device__ __forceinline__ unsigned xb_ld(unsigned* p)              { return __hip_atomic_load(p, __ATOMIC_RELAXED, __HIP_MEMORY_SCOPE_AGENT); }
__device__ __forceinline__ unsigned xb_add(unsigned* p, unsigned v) { return __hip_atomic_fetch_add(p, v, __ATOMIC_RELAXED, __HIP_MEMORY_SCOPE_AGENT); }
__device__ __forceinline__ unsigned xb_xcc_id() { return (unsigned)__builtin_amdgcn_s_getreg((3 << 11) | 20) & 0xFu; }
#define XB_SPIN(cond, bar) do { unsigned _sp = 0; while (cond) { __builtin_amdgcn_s_sleep(1); \
    if ((++_sp & 255u) == 0u) { if (xb_ld(&(bar)[XB_TMO])) break; if (_sp > XB_SPIN_CAP) { atomicAdd(&(bar)[XB_TMO], 1u); break; } } } } while (0)

struct XcdBarrier {
    unsigned* bar; unsigned x;
    volatile LAS unsigned* st;
};

__device__ __forceinline__ XcdBarrier xcd_barrier_post(unsigned* bar, volatile LAS unsigned* st) {
    XcdBarrier b; b.bar = bar; b.x = xb_xcc_id(); b.st = st;
    if (threadIdx.x == 0) (void)xb_add(&bar[XB_XCNT(b.x)], 1u);
    return b;
}
__device__ __forceinline__ void xcd_barrier_complete(unsigned* bar, unsigned x, unsigned& nloc, unsigned& nx) {
    const unsigned G = gridDim.x * gridDim.y * gridDim.z;
    unsigned sum, cnt, mine, sp = 0u;
    for (;;) {
        sum = 0u; cnt = 0u; mine = 0u;
#pragma unroll
        for (unsigned j = 0; j < 16; ++j) { const unsigned c = xb_ld(&bar[XB_XCNT(j)]); sum += c; cnt += (c > 0u) ? 1u : 0u; mine = (j == x) ? c : mine; }
        if (sum == G) break;
        __builtin_amdgcn_s_sleep(1);
        if ((++sp & 255u) == 0u) { if (xb_ld(&bar[XB_TMO])) break; if (sp > XB_SPIN_CAP) { atomicAdd(&bar[XB_TMO], 1u); break; } }
    }
    nloc = mine > 0u ? mine : 1u; nx = cnt > 0u ? cnt : 1u;
}

__device__ __forceinline__ void xcd_barrier(const XcdBarrier& b) {
    asm volatile("s_waitcnt vmcnt(0)" ::: "memory");
    __syncthreads();
    if (threadIdx.x == 0) {
        unsigned* bar = b.bar;
        __builtin_amdgcn_s_waitcnt(0);
        unsigned nloc = b.st[0], nx = b.st[1];
        if (nloc == 0u) { xcd_barrier_complete(bar, b.x, nloc, nx); b.st[0] = nloc; b.st[1] = nx; }
        const unsigned old = xb_add(&bar[XB_XSUB(b.x)], 1u);
        const unsigned gen = old / nloc;
        if (old + 1u == (gen + 1u) * nloc) {
            __builtin_amdgcn_fence(__ATOMIC_RELEASE, "agent");
            asm volatile("s_waitcnt vmcnt(0)" ::: "memory");
            const unsigned og = xb_add(&bar[XB_TOP], 1u);
            const unsigned tg = og / nx;
            if (og + 1u == (tg + 1u) * nx) xb_add(&bar[XB_TOPGEN], 1u);
            else XB_SPIN(xb_ld(&bar[XB_TOPGEN]) == tg, bar);
            __builtin_amdgcn_fence(__ATOMIC_ACQUIRE, "agent");
            xb_add(&bar[XB_XGEN(b.x)], 1u);
            asm volatile("s_waitcnt vmcnt(0)" ::: "memory");
        } else {
            XB_SPIN(xb_ld(&bar[XB_XGEN(b.x)]) == gen, bar);
            __builtin_amdgcn_fence(__ATOMIC_ACQUIRE, "agent");
            asm volatile("s_waitcnt vmcnt(0)" ::: "memory");
        }
    }
    __syncthreads();
}

constexpr int NPHASE = 21;
__global__ void __launch_bounds__(NTHR, 2) fwd_kernel(Args a) {
    extern __shared__ __attribute__((aligned(16))) unsigned char lds_raw[];
    LAS unsigned char* lds = (LAS unsigned char*)lds_raw;
    cg::grid_group grid = cg::this_grid();
    const int tid = threadIdx.x, lane = tid & 63, wave = __builtin_amdgcn_readfirstlane(tid >> 6);
    const int G = gridDim.x, gw = blockIdx.x * NWAVES + wave, NGW = G * NWAVES;
    const int lo = a.ph_lo, hi = a.ph_hi;
    volatile LAS unsigned* MISC = (volatile LAS unsigned*)(lds + LDS_BYTES - 256);
    if (tid < 32) MISC[tid] = 0u;
    __syncthreads();
    XcdBarrier bar = xcd_barrier_post((unsigned*)a.ws, MISC + 8);
    if (hi < 0) grid.sync();
#define PH_BEGIN(k) if (lo <= (k) && (k) < hi) { const CAS char* kp_ = kargs_ptr(); unsigned char* const ws = KWS; (void)ws;
#define PH_END(k) if ((k) + 1 < hi) xcd_barrier(bar); }
#define GEMM_BF(k, Aptr, lda_, Bptr, N_, K_, O0, ld0, O1, ld1, split, bias, segw, segstride, ssp, tail_) PH_BEGIN(k) { pg8::Gemm g{(const bf16*)(Aptr), (const bf16*)(Bptr), M, N_, K_, lda_}; pg8::EpiBf16X e{(bf16*)(O0), ld0, (bf16*)(O1), ld1, split, bias, segw, segstride, ssp}; \
        pg8::StaticOrder S; S.init(M, N_, G, (int)blockIdx.x); pg8::gemm_phase<pg8::EpiBf16X, pg8::StaticOrder, true, true>(lds, g, S, e); { tail_; } } PH_END(k)
#define GEMM_GLU(k, Aptr, Bptr, layer, ssp, tail_) PH_BEGIN(k) { pg8::Gemm g{(const bf16*)(Aptr), (const bf16*)(Bptr), M, UW, D, D}; \
        pg8::EpiGlu e{(bf16*)(ws + WS_H), KIN(I_FCW) + (size_t)(layer) * 3 * DFF, KIN(I_FCB) + (size_t)(layer) * DFF, (float*)(ws + WS_HG), (float*)(ws + WS_HV), (float*)(ws + WS_TG), ssp}; \
        pg8::StaticOrder S; S.init(M, UW, G, (int)blockIdx.x); pg8::gemm_phase<pg8::EpiGlu, pg8::StaticOrder, true, true>(lds, g, S, e); { tail_; } } PH_END(k)
#define GEMM_RES(k, Aptr, lda_, Bptr, N_, K_, base, bias, xbp, ssp) PH_BEGIN(k) { pg8::Gemm g{(const bf16*)(Aptr), (const bf16*)(Bptr), M, N_, K_, lda_}; pg8::EpiRes e{base, KOUT, D, bias, (bf16*)(xbp), ssp}; \
        pg8::StaticOrder S; S.init(M, N_, G, (int)blockIdx.x); pg8::gemm_phase<pg8::EpiRes, pg8::StaticOrder, true, true>(lds, g, S, e); } PH_END(k)
    PH_BEGIN(0) p0_prologue(a, lds, tid, lane, wave); PH_END(0)
    GEMM_BF(1, ws + WS_XN1, D, ws + WS_WIN, ABIN, D, ws + WS_PC, 1024, (unsigned char*)KOUT + DO_PR, PRW, 1024, (const float*)(ws + WS_BIASP), PRW, 0, nullptr, if (G == 256 && blockIdx.x >= 192) tail_g1(a, lds, tid, lane, wave, (int)blockIdx.x - 192, 64); else if (G != 256) tail_g1(a, lds, tid, lane, wave, (int)blockIdx.x, G))
    PH_BEGIN(2) p2_prep(a, lds, tid, lane, wave); PH_END(2)
    GEMM_BF(3, ws + WS_LIN, LINW, ws + WS_WL, LOW, LINW, ws + WS_LOW, 512, ws + WS_LOW, 512, 0, nullptr, 512, (size_t)M * 512, nullptr, (void)0)
    PH_BEGIN(4) p4_rwkv_prep(a, lane, wave); PH_END(4)
    PH_BEGIN(5) scan_pass1(a, lds, lane, wave); PH_END(5)
    PH_BEGIN(6) comb_a(a, lds, tid, lane, wave); if (G == 256 && blockIdx.x >= 128) p8_prep2(a, lds, lane, wave, (int)blockIdx.x - 128, 128); else if (G != 256) p8_prep2(a, lds, lane, wave, (int)blockIdx.x, G); PH_END(6)
    PH_BEGIN(6) comb_b(a, lds, tid, lane, wave); PH_END(6)
    PH_BEGIN(6) comb_c(a, lds, tid, lane, wave); PH_END(6)
    PH_BEGIN(7) scan_pass2(a, lds, lane, wave); PH_END(7)
    GEMM_RES(8, ws + WS_CAT, D, ws + WS_WOUT, D, D, KIN(I_X), nullptr, ws + WS_XB, (float*)(ws + WS_SS))
    GEMM_GLU(10, ws + WS_XB, ws + WS_WUP0, 0, (float*)(ws + WS_SS), if (G == 256 && blockIdx.x >= 128) tail_g10(a, lds, lane, wave, (int)blockIdx.x - 128, 128); else if (G != 256) tail_g10(a, lds, lane, wave, (int)blockIdx.x, G))
    PH_BEGIN(11) glu_fixup(a, 0, tid); PH_END(11)
    GEMM_RES(12, ws + WS_H, DFF, ws + WS_WDN0, D, DFF, KOUT, nullptr, ws + WS_XB, (float*)(ws + WS_SS) + M)
    GEMM_BF(14, ws + WS_XB, D, ws + WS_WQKV, QKVW, D, ws + WS_QKV, QKVW, ws + WS_QKV, QKVW, 1 << 30, KIN(I_BQKV), 256, 0, (float*)(ws + WS_SS) + M, if (G == 256 && blockIdx.x >= 128) tail_g14(a, lds, lane, wave, (int)blockIdx.x - 128, 128); else if (G != 256) tail_g14(a, lds, lane, wave, (int)blockIdx.x, G))
    PH_BEGIN(15) p14_attn(a, lds, tid, lane, wave); PH_END(15)
    GEMM_RES(16, ws + WS_O, D, ws + WS_WO, D, D, KOUT, KIN(I_BO), ws + WS_XB, (float*)(ws + WS_SS) + 2 * M)
    GEMM_GLU(18, ws + WS_XB, ws + WS_WUP1, 1, (float*)(ws + WS_SS) + 2 * M, (void)0)
    PH_BEGIN(19) glu_fixup(a, 1, tid); PH_END(19)
    GEMM_RES(20, ws + WS_H, DFF, ws + WS_WDN1, D, DFF, KOUT, nullptr, nullptr, nullptr)
}

#ifndef N_LAUNCH_MODE
#define N_LAUNCH_MODE 1
#endif
extern "C" void kernel_launch(void* const* d_in, const int* in_sizes, int n_in, void* d_out, int out_size, void* d_ws, size_t ws_size, hipStream_t stream) {
    static int grid = 0;
    if (grid == 0) {
        if (n_in != 34 || out_size != M * D || ws_size < WS_END) { fprintf(stderr, "kernel_launch: unexpected shapes n_in %d out %d ws %zu\n", n_in, out_size, ws_size); grid = -1; return; }
        int dev = 0, cus = 0, per_cu = 0;
        hipGetDevice(&dev); hipDeviceGetAttribute(&cus, hipDeviceAttributeMultiprocessorCount, dev);
        if (hipFuncSetAttribute((const void*)fwd_kernel, hipFuncAttributeMaxDynamicSharedMemorySize, LDS_BYTES) != hipSuccess) { fprintf(stderr, "kernel_launch: hipFuncSetAttribute failed\n"); grid = -1; return; }
        if (hipOccupancyMaxActiveBlocksPerMultiprocessor(&per_cu, (const void*)fwd_kernel, NTHR, LDS_BYTES) != hipSuccess || per_cu < 1) { fprintf(stderr, "kernel_launch: occupancy query says %d\n", per_cu); per_cu = 1; }
        (void)hipGetLastError();
        grid = cus * 1;
    }
    if (grid < 0) return;
    if (hipMemsetAsync(d_ws, 0, 16384, stream) != hipSuccess) { fprintf(stderr, "kernel_launch: memset of the barrier words failed\n"); return; }
    Args a{};
    for (int i = 0; i < 34; ++i) a.in[i] = (const float*)d_in[i];
    a.out = (float*)d_out; a.ws = (unsigned char*)d_ws;
#if N_LAUNCH_MODE == 1
    a.ph_lo = 0; a.ph_hi = NPHASE;
    { void* args[] = {&a}; hipError_t e = hipLaunchCooperativeKernel((const void*)fwd_kernel, dim3(grid), dim3(NTHR), args, LDS_BYTES, stream);
      if (e != hipSuccess) fprintf(stderr, "cooperative launch failed: %s (grid %d)\n", hipGetErrorString(e), grid); }
#else
    for (int ph = 0; ph < NPHASE; ++ph) { a.ph_lo = ph; a.ph_hi = ph + 1; void* args[] = {&a};
        hipError_t e = hipLaunchCooperativeKernel((const void*)fwd_kernel, dim3(grid), dim3(NTHR), args, LDS_BYTES, stream);
        if (e != hipSuccess) { fprintf(stderr, "launch %d failed: %s\n", ph, hipGetErrorString(e)); break; } }
#endif
}
```
